# Optimizing an MI355X kernel written in HIP

```python
import math
import jax, jax.numpy as jnp
from jax import lax
import numpy as np


D_MODEL = 1024
BATCH = 2
SEQ = 8192
DEPTH = 2

GRID_W = 64
EPS = 1e-6
Q_BLOCK = 128
ROPE_THETA = 10000.0
NEG_INF = -1e30

N_GROUPS = 4
GROUP_WIDTH = D_MODEL // N_GROUPS
MIX_WIDTH = N_GROUPS * GROUP_WIDTH
D_FF = 256 * ((8 * D_MODEL // 3 + 255) // 256)

NA_HEAD_DIM = 64
NA_HEADS = GROUP_WIDTH // NA_HEAD_DIM
NA_KH = 8
NA_KW = 16
MLA_HEADS = 4
MLA_V = GROUP_WIDTH // MLA_HEADS
MLA_NOPE = 64
MLA_ROPE = 32
MLA_Q_RANK = D_MODEL // 4
MLA_KV_RANK = D_MODEL // 8
DIFF_HEADS = 4
DIFF_V = GROUP_WIDTH // DIFF_HEADS
DIFF_QK = DIFF_V // 2
GQA_HEADS = 4
GQA_KV_HEADS = 2
GQA_DIM = GROUP_WIDTH // GQA_HEADS
T5_BUCKETS = 32
T5_MAX_DIST = 128

A_IN = 3 * NA_HEADS * NA_HEAD_DIM
B_IN = MLA_Q_RANK + MLA_KV_RANK + MLA_ROPE
C_IN = 3 * DIFF_HEADS * DIFF_V
D_IN = (GQA_HEADS + 2 * GQA_KV_HEADS) * GQA_DIM
IN_WIDTH = A_IN + B_IN + C_IN + D_IN
IN_SPLITS = [A_IN, A_IN + B_IN, A_IN + B_IN + C_IN]

kernel_name = 'hybrid_parallel_heads_encoder'


def rms_norm(x, g):
    xf = x.astype(jnp.float32)
    y = xf * lax.rsqrt(jnp.mean(xf * xf, axis=-1, keepdims=True) + EPS)
    return (y * g.astype(jnp.float32)).astype(x.dtype)


def swiglu(h, w_gate, w_up, w_down):
    return (jax.nn.silu(h @ w_gate) * (h @ w_up)) @ w_down


def rope_angles(pos, dim):
    inv = jnp.exp(-math.log(ROPE_THETA) * jnp.arange(0, dim, 2, dtype=jnp.float32) / dim)
    return pos.astype(jnp.float32)[:, None] * inv[None, :]


def apply_rope(x, ang):
    half = x.shape[-1] // 2
    xf = x.astype(jnp.float32)
    x1, x2 = xf[..., :half], xf[..., half:]
    cos, sin = jnp.cos(ang), jnp.sin(ang)
    return jnp.concatenate([x1 * cos - x2 * sin, x1 * sin + x2 * cos], axis=-1).astype(x.dtype)


def axial_rope(x, ang_row, ang_col):
    half = x.shape[-1] // 2
    return jnp.concatenate([apply_rope(x[..., :half], ang_row), apply_rope(x[..., half:], ang_col)], axis=-1)


def t5_bucket(rel):
    half = T5_BUCKETS // 2
    max_exact = half // 2
    n = jnp.abs(rel)
    large = max_exact + (jnp.log(jnp.maximum(n, 1).astype(jnp.float32) / max_exact)
                         / math.log(T5_MAX_DIST / max_exact) * (half - max_exact)).astype(jnp.int32)
    large = jnp.minimum(large, half - 1)
    return jnp.where(rel > 0, half, 0) + jnp.where(n < max_exact, n, large)


def sweep_query_blocks(block_fn, *q_arrays):
    b, s = q_arrays[0].shape[:2]
    nb = s // Q_BLOCK
    blocks = tuple(jnp.swapaxes(a.reshape((b, nb, Q_BLOCK) + a.shape[2:]), 0, 1) for a in q_arrays)
    out = lax.map(lambda a: block_fn(*a), (jnp.arange(nb, dtype=jnp.int32),) + blocks)
    out = jnp.swapaxes(out, 0, 1)
    return out.reshape((b, s) + out.shape[3:])


def neighbourhood_attention(q, k, v, rpb):
    b, s, h, d = q.shape
    rows = s // GRID_W
    kh = min(NA_KH, rows)
    n_cb = GRID_W // NA_KW
    kb = 2 * NA_KW
    r = jnp.arange(rows)
    row_idx = jnp.clip(r - kh // 2, 0, rows - kh)[:, None] + jnp.arange(kh)[None, :]
    cb_start = jnp.clip(jnp.arange(n_cb) * NA_KW - NA_KW // 2, 0, GRID_W - kb)
    col_idx = cb_start[:, None] + jnp.arange(kb)[None, :]
    q_col = jnp.arange(GRID_W).reshape(n_cb, NA_KW)
    q_start = jnp.clip(q_col - NA_KW // 2, 0, GRID_W - NA_KW)
    kc = col_idx[:, None, :]
    valid = (kc >= q_start[..., None]) & (kc < q_start[..., None] + NA_KW)
    dr = row_idx - r[:, None] + NA_KH - 1
    dc = jnp.clip(kc - q_col[..., None] + NA_KW - 1, 0, 2 * NA_KW - 2)
    bias = rpb[:, dr[:, :, None, None, None], dc[None, None]]
    bias = jnp.transpose(bias, (1, 3, 4, 0, 2, 5)).astype(jnp.float32)
    qg = q.reshape(b, rows, n_cb, NA_KW, h, d)
    kg = k.reshape(b, rows, GRID_W, h, d)[:, row_idx][:, :, :, col_idx]
    vg = v.reshape(b, rows, GRID_W, h, d)[:, row_idx][:, :, :, col_idx]
    logits = jnp.einsum('brcqhd,brkcjhd->brcqhkj', qg, kg,
                        preferred_element_type=jnp.float32) * (d ** -0.5) + bias
    logits = jnp.where(valid[:, :, None, None, :], logits, NEG_INF)
    p = jax.nn.softmax(logits.reshape(logits.shape[:-2] + (kh * kb,)), axis=-1)
    p = p.reshape(logits.shape).astype(v.dtype)
    out = jnp.einsum('brcqhkj,brkcjhd->brcqhd', p, vg)
    return out.reshape(b, s, h, d)


def dense_attention(q, k, v):
    scale = q.shape[-1] ** -0.5

    def block(i, qb):
        logits = jnp.einsum('bqhd,bkhd->bhqk', qb, k, preferred_element_type=jnp.float32) * scale
        p = jax.nn.softmax(logits, axis=-1).astype(v.dtype)
        return jnp.einsum('bhqk,bkhd->bqhd', p, v)

    return sweep_query_blocks(block, q)


def gqa_attention(q, k, v):
    b, s, hq, d = q.shape
    hkv = k.shape[2]
    qg = q.reshape(b, s, hkv, hq // hkv, d)
    scale = d ** -0.5

    def block(i, qb):
        logits = jnp.einsum('bqngd,bknd->bngqk', qb, k, preferred_element_type=jnp.float32) * scale
        p = jax.nn.softmax(logits, axis=-1).astype(v.dtype)
        return jnp.einsum('bngqk,bknd->bqngd', p, v)

    return sweep_query_blocks(block, qg).reshape(b, s, hq, d)


def diff_attention(q, k, v, lam, t5_table):
    s = q.shape[1]
    scale = q.shape[-1] ** -0.5
    kpos = jnp.arange(s, dtype=jnp.int32)

    def block(i, qb):
        qpos = i * Q_BLOCK + jnp.arange(Q_BLOCK, dtype=jnp.int32)
        bias = t5_table[t5_bucket(kpos[None, :] - qpos[:, None])]
        bias = jnp.transpose(bias, (2, 0, 1)).astype(jnp.float32)
        logits = jnp.einsum('bqhmd,bkhmd->bhmqk', qb, k,
                            preferred_element_type=jnp.float32) * scale + bias[None, :, None]
        p = jax.nn.softmax(logits, axis=-1)
        w = (p[:, :, 0] - lam * p[:, :, 1]).astype(v.dtype)
        return jnp.einsum('bhqk,bkhd->bqhd', w, v)

    return sweep_query_blocks(block, q)


def neighbourhood_mixer(p, q_norm, k_norm, rpb, beta):
    b, s, _ = p.shape
    p = p.reshape(b, s, 3, NA_HEADS, NA_HEAD_DIM)
    q = rms_norm(p[:, :, 0], q_norm)
    k = rms_norm(p[:, :, 1], k_norm)
    y = neighbourhood_attention(q, k, p[:, :, 2], rpb)
    return rms_norm(y.reshape(b, s, GROUP_WIDTH), beta)


def mla_mixer(p, q_lat_norm, w_uq, kv_lat_norm, w_ukv, q_norm, k_norm, beta, ang):
    b, s, _ = p.shape
    c_q, c_kv, k_rope = jnp.split(p, [MLA_Q_RANK, MLA_Q_RANK + MLA_KV_RANK], axis=-1)
    q = (rms_norm(c_q, q_lat_norm) @ w_uq).reshape(b, s, MLA_HEADS, MLA_NOPE + MLA_ROPE)
    kv = (rms_norm(c_kv, kv_lat_norm) @ w_ukv).reshape(b, s, MLA_HEADS, MLA_NOPE + MLA_V)
    k_nope, v = kv[..., :MLA_NOPE], kv[..., MLA_NOPE:]
    k_rope = jnp.broadcast_to(k_rope[:, :, None, :], (b, s, MLA_HEADS, MLA_ROPE))
    k = jnp.concatenate([k_nope, k_rope], axis=-1)
    q = rms_norm(q, q_norm)
    k = rms_norm(k, k_norm)
    q = jnp.concatenate([q[..., :MLA_NOPE], apply_rope(q[..., MLA_NOPE:], ang)], axis=-1)
    k = jnp.concatenate([k[..., :MLA_NOPE], apply_rope(k[..., MLA_NOPE:], ang)], axis=-1)
    y = dense_attention(q, k, v)
    return rms_norm(y.reshape(b, s, GROUP_WIDTH), beta)


def diff_mixer(p, q_norm, k_norm, lam_params, subln, t5_table, lambda_init):
    b, s, _ = p.shape
    pq, pk, pv = jnp.split(p, 3, axis=-1)
    q = rms_norm(pq.reshape(b, s, DIFF_HEADS, 2, DIFF_QK), q_norm)
    k = rms_norm(pk.reshape(b, s, DIFF_HEADS, 2, DIFF_QK), k_norm)
    v = pv.reshape(b, s, DIFF_HEADS, DIFF_V)
    lp = lam_params.astype(jnp.float32)
    lam = jnp.exp(jnp.sum(lp[0] * lp[1])) - jnp.exp(jnp.sum(lp[2] * lp[3])) + lambda_init
    y = diff_attention(q, k, v, lam, t5_table)
    y = rms_norm(y, subln) * (1.0 - lambda_init)
    return y.reshape(b, s, GROUP_WIDTH)


def gqa_mixer(p, q_norm, k_norm, beta, ang_row, ang_col):
    b, s, _ = p.shape
    nq = GQA_HEADS * GQA_DIM
    nk = GQA_KV_HEADS * GQA_DIM
    pq, pk, pv = jnp.split(p, [nq, nq + nk], axis=-1)
    q = rms_norm(pq.reshape(b, s, GQA_HEADS, GQA_DIM), q_norm)
    k = rms_norm(pk.reshape(b, s, GQA_KV_HEADS, GQA_DIM), k_norm)
    v = pv.reshape(b, s, GQA_KV_HEADS, GQA_DIM)
    q = axial_rope(q, ang_row, ang_col)
    k = axial_rope(k, ang_row, ang_col)
    y = gqa_attention(q, k, v)
    return rms_norm(y.reshape(b, s, GROUP_WIDTH), beta)


def diff_lambda_init(layer):
    return 0.8 - 0.6 * math.exp(-0.3 * layer)


def setup_inputs(seed: int = 0) -> dict:
    key = jax.random.key(seed)
    ks = iter(jax.random.split(key, 64))
    L = DEPTH

    def nrm(shape, scale):
        return scale * jax.random.normal(next(ks), shape, jnp.float32)

    def gain(shape):
        return 1.0 + nrm(shape, 0.05)

    return {
        'x': nrm((BATCH, SEQ, D_MODEL), 1.0),
        'ffn1_norm': gain((L, D_MODEL)),
        'ffn1_w_gate': nrm((L, D_MODEL, D_FF), D_MODEL ** -0.5),
        'ffn1_w_up': nrm((L, D_MODEL, D_FF), D_MODEL ** -0.5),
        'ffn1_w_down': nrm((L, D_FF, D_MODEL), D_FF ** -0.5),
        'mix_norm': gain((L, D_MODEL)),
        'w_in': nrm((L, D_MODEL, IN_WIDTH), D_MODEL ** -0.5),
        'na_q_norm': gain((L, NA_HEAD_DIM)),
        'na_k_norm': gain((L, NA_HEAD_DIM)),
        'na_rpb': nrm((L, NA_HEADS, 2 * NA_KH - 1, 2 * NA_KW - 1), 0.1),
        'na_beta': gain((L, GROUP_WIDTH)),
        'mla_q_lat_norm': gain((L, MLA_Q_RANK)),
        'mla_w_uq': nrm((L, MLA_Q_RANK, MLA_HEADS * (MLA_NOPE + MLA_ROPE)), MLA_Q_RANK ** -0.5),
        'mla_kv_lat_norm': gain((L, MLA_KV_RANK)),
        'mla_w_ukv': nrm((L, MLA_KV_RANK, MLA_HEADS * (MLA_NOPE + MLA_V)), MLA_KV_RANK ** -0.5),
        'mla_q_norm': gain((L, MLA_NOPE + MLA_ROPE)),
        'mla_k_norm': gain((L, MLA_NOPE + MLA_ROPE)),
        'mla_beta': gain((L, GROUP_WIDTH)),
        'diff_q_norm': gain((L, DIFF_QK)),
        'diff_k_norm': gain((L, DIFF_QK)),
        'diff_lambda': nrm((L, 4, DIFF_QK), 0.1),
        'diff_subln': gain((L, DIFF_V)),
        'gqa_q_norm': gain((L, GQA_DIM)),
        'gqa_k_norm': gain((L, GQA_DIM)),
        'gqa_beta': gain((L, GROUP_WIDTH)),
        'w_out': nrm((L, MIX_WIDTH, D_MODEL), MIX_WIDTH ** -0.5),
        'ffn2_norm': gain((L, D_MODEL)),
        'ffn2_w_gate': nrm((L, D_MODEL, D_FF), D_MODEL ** -0.5),
        'ffn2_w_up': nrm((L, D_MODEL, D_FF), D_MODEL ** -0.5),
        'ffn2_w_down': nrm((L, D_FF, D_MODEL), D_FF ** -0.5),
        'final_norm': gain((L, D_MODEL)),
        't5_bias': nrm((T5_BUCKETS, DIFF_HEADS), 0.1),
    }


def reference(x, ffn1_norm, ffn1_w_gate, ffn1_w_up, ffn1_w_down, mix_norm, w_in,
              na_q_norm, na_k_norm, na_rpb, na_beta,
              mla_q_lat_norm, mla_w_uq, mla_kv_lat_norm, mla_w_ukv, mla_q_norm, mla_k_norm, mla_beta,
              diff_q_norm, diff_k_norm, diff_lambda, diff_subln,
              gqa_q_norm, gqa_k_norm, gqa_beta, w_out,
              ffn2_norm, ffn2_w_gate, ffn2_w_up, ffn2_w_down, final_norm, t5_bias):
    s = x.shape[1]
    t = jnp.arange(s, dtype=jnp.int32)
    ang_seq = rope_angles(t, MLA_ROPE)[None, :, None, :]
    ang_row = rope_angles(t // GRID_W, GQA_DIM // 2)[None, :, None, :]
    ang_col = rope_angles(t % GRID_W, GQA_DIM // 2)[None, :, None, :]
    for l in range(DEPTH):
        x = x + 0.5 * swiglu(rms_norm(x, ffn1_norm[l]), ffn1_w_gate[l], ffn1_w_up[l], ffn1_w_down[l])
        h = rms_norm(x, mix_norm[l])
        pa, pb, pc, pd = jnp.split(h @ w_in[l], IN_SPLITS, axis=-1)
        ya = neighbourhood_mixer(pa, na_q_norm[l], na_k_norm[l], na_rpb[l], na_beta[l])
        yb = mla_mixer(pb, mla_q_lat_norm[l], mla_w_uq[l], mla_kv_lat_norm[l], mla_w_ukv[l],
                       mla_q_norm[l], mla_k_norm[l], mla_beta[l], ang_seq)
        yc = diff_mixer(pc, diff_q_norm[l], diff_k_norm[l], diff_lambda[l], diff_subln[l],
                        t5_bias, diff_lambda_init(l))
        yd = gqa_mixer(pd, gqa_q_norm[l], gqa_k_norm[l], gqa_beta[l], ang_row, ang_col)
        x = x + jnp.concatenate([ya, yb, yc, yd], axis=-1) @ w_out[l]
        x = x + 0.5 * swiglu(rms_norm(x, ffn2_norm[l]), ffn2_w_gate[l], ffn2_w_up[l], ffn2_w_down[l])
        x = rms_norm(x, final_norm[l])
    return x
```

```cpp
#include <hip/hip_runtime.h>
#include <hip/hip_cooperative_groups.h>
#include <cstdio>
#include <cstdint>
namespace cg = cooperative_groups;

#ifndef MK_ENABLE
#define MK_ENABLE 0xFFFFFF
#endif
#define EN(k) ((MK_ENABLE >> (k)) & 1)
#ifndef MK_SPLIT
#define MK_SPLIT 0
#endif

#define LAS __attribute__((address_space(3)))
typedef unsigned short bf16_t;
typedef short bf16x8 __attribute__((ext_vector_type(8)));
typedef float f32x4 __attribute__((ext_vector_type(4)));
typedef float f32x16 __attribute__((ext_vector_type(16)));
typedef unsigned u32x4 __attribute__((ext_vector_type(4)));
typedef unsigned u32x2 __attribute__((ext_vector_type(2)));
typedef float f32x2_t __attribute__((ext_vector_type(2)));
typedef __bf16 bf16x2_t __attribute__((ext_vector_type(2)));

constexpr int BATCH = 2, SEQ = 8192, DM = 1024, MROWS = BATCH * SEQ, DFF = 2816, NIN = 2560, NTILE = SEQ / 64, DEPTH = 2;
constexpr float EPS = 1e-6f;
constexpr float LOG2E = 1.4426950408889634f;
constexpr int NWAVES = 8, NTHREADS = 512;

constexpr size_t MiB = 1u << 20;
constexpr size_t WS_SS0 = 65536;
constexpr size_t WS_SSP = 252 * MiB;
constexpr size_t WS_TAB = 1 * MiB;
constexpr size_t WS_WGU1 = 3 * MiB, WS_WD1 = 14 * MiB, WS_WIN = 19 * MiB + 512 * 1024, WS_WOUT = 24 * MiB + 512 * 1024, WS_WGU2 = 26 * MiB + 512 * 1024, WS_WD2 = 37 * MiB + 512 * 1024;
constexpr size_t WS_WUQ = 43 * MiB, WS_WUKV = 43 * MiB + 256 * 1024;
constexpr size_t WS_XB = 44 * MiB;
constexpr size_t WS_R = 76 * MiB;
constexpr size_t WS_QA = 156 * MiB, WS_KA = 164 * MiB, WS_VA = 172 * MiB, WS_QB = 180 * MiB, WS_KB = 192 * MiB, WS_VB = 204 * MiB;
constexpr size_t WS_QC = 212 * MiB, WS_KC = 220 * MiB, WS_VC = 228 * MiB, WS_QD = 236 * MiB, WS_KD = 244 * MiB, WS_VD = 248 * MiB, WS_END = 256 * MiB;
constexpr int LDS_BYTES = 147456;

__device__ __forceinline__ unsigned pk2(float lo, float hi) { f32x2_t v = {lo, hi}; bf16x2_t b = __builtin_convertvector(v, bf16x2_t); return __builtin_bit_cast(unsigned, b); }
__device__ __forceinline__ float bf2f(unsigned short u) { return __uint_as_float(((unsigned)u) << 16); }
__device__ __forceinline__ void unpack8(const u32x4 u, float* v) {
    v[0] = __uint_as_float(u.x << 16); v[1] = __uint_as_float(u.x & 0xffff0000u); v[2] = __uint_as_float(u.y << 16); v[3] = __uint_as_float(u.y & 0xffff0000u);
    v[4] = __uint_as_float(u.z << 16); v[5] = __uint_as_float(u.z & 0xffff0000u); v[6] = __uint_as_float(u.w << 16); v[7] = __uint_as_float(u.w & 0xffff0000u);
}
__device__ __forceinline__ u32x4 pack8(const float* v) { u32x4 u; u.x = pk2(v[0], v[1]); u.y = pk2(v[2], v[3]); u.z = pk2(v[4], v[5]); u.w = pk2(v[6], v[7]); return u; }
__device__ __forceinline__ float wave_sum(float v) {
#pragma unroll
    for (int o = 1; o < 64; o <<= 1) v += __shfl_xor(v, o);
    return v;
}

namespace pg8 {
constexpr int BM = 256, BK = 64, HALF = 128, HTB = HALF * BK * 2, STAGE_BYTES = 8 * HTB, NXCD = 8, WGM = 8;
__host__ __device__ __forceinline__ int lds_byte(int r, int c) { const int st = (r >> 4) * 2 + (c >> 5), rr = r & 15, cc = c & 31, ob = rr * 64 + cc * 2; return st * 1024 + (ob ^ (((ob >> 9) & 1) << 5)); }
__host__ __device__ __forceinline__ void stage_rc(int b, int& R, int& C) { const int st = b / 1024, sb = b % 1024, swz = sb ^ (((sb >> 9) & 1) << 5); R = (st >> 1) * 16 + swz / 64; C = (st & 1) * 32 + (swz % 64) / 2; }
__host__ __device__ __forceinline__ int perm32(int rho) { const int n = rho >> 4, i = rho & 15; return 8 * (i >> 2) + 4 * n + (i & 3); }
struct Unit { int pm, pn; };
struct Gemm { const bf16_t* A; const bf16_t* Bt; int M, N, K; };
struct StaticOrder {
    int nM, nN, nwg, G, c;
    __host__ __device__ void init(int M, int N, int G_, int c_) { nM = M / BM; nN = N / BM; nwg = nM * nN; G = G_; c = c_; }
    __host__ __device__ bool next(int i, Unit& u) const {
        const long L = (long)i * G + c; if (L >= nwg) return false;
        int wgid = (int)L; { const int q = nwg / NXCD, r = nwg % NXCD, xcd = wgid % NXCD, off = wgid / NXCD; wgid = (xcd < r ? xcd * (q + 1) : r * (q + 1) + (xcd - r) * q) + off; }
        const int nig = WGM * nN, gid = wgid / nig, fm = gid * WGM, gsz = (nM - fm) < WGM ? (nM - fm) : WGM;
        u.pm = fm + ((wgid % nig) % gsz); u.pn = (wgid % nig) / gsz; return true;
    }
    __device__ __forceinline__ void a_ready(const Unit&) const {}
    __device__ __forceinline__ void done(const Unit&) const {}
};

__device__ __forceinline__ float sum16(const float* p) {
    const f32x4 a = *(const f32x4*)p, b = *(const f32x4*)(p + 4), c = *(const f32x4*)(p + 8), d = *(const f32x4*)(p + 12);
    return (((a[0] + a[1]) + (a[2] + a[3])) + ((b[0] + b[1]) + (b[2] + b[3]))) + (((c[0] + c[1]) + (c[2] + c[3])) + ((d[0] + d[1]) + (d[2] + d[3])));
}
struct RowScale {
    const float* ss1; const float* ssp; const float* ssgp;
    __device__ __forceinline__ float get(int row) const {
        const float s = ss1 ? ss1[row] : sum16(ssp + (size_t)row * 16);
        float rs = 1.0f / sqrtf(s * (1.0f / DM) + EPS);
        if (ssgp) { const float rsn = 1.0f / sqrtf(rs * rs * sum16(ssgp + (size_t)row * 16) * (1.0f / DM) + EPS); rs *= rsn; }
        return rs;
    }
};

struct EpiSwiGLU {
    static constexpr bool PERM = true, AFTER_DRAIN = false;
    bf16_t* O; RowScale rsc;
    __device__ __forceinline__ void operator()(const f32x4 (&acc)[2][2][4][2], const Unit& u, int wr, int wc, int fr, int fq) const {
        const int row0 = u.pm * BM + wr * 64 + fr, col0 = u.pn * HALF + wc * 32 + 8 * fq;
#pragma unroll
        for (int ai = 0; ai < 2; ++ai)
#pragma unroll
            for (int m = 0; m < 4; ++m) {
                const int row = row0 + ai * HALF + m * 16; const float rs = rsc.get(row);
                float a[8];
#pragma unroll
                for (int n = 0; n < 2; ++n)
#pragma unroll
                    for (int i = 0; i < 4; ++i) {
                        const float g = acc[ai][0][m][n][i] * rs, up = acc[ai][1][m][n][i] * rs;
                        const float sg = g * __builtin_amdgcn_rcpf(1.0f + __builtin_amdgcn_exp2f(-g * LOG2E));
                        a[n * 4 + i] = sg * up;
                    }
                *(u32x4*)(O + (size_t)row * DFF + col0) = pack8(a);
            }
    }
};
struct EpiScaleBf16 {
    static constexpr bool PERM = true, AFTER_DRAIN = false;
    bf16_t* O; int ldo; RowScale rsc;
    __device__ __forceinline__ void operator()(const f32x4 (&acc)[2][2][4][2], const Unit& u, int wr, int wc, int fr, int fq) const {
        const int row0 = u.pm * BM + wr * 64 + fr, col0 = u.pn * BM + wc * 32 + 8 * fq;
#pragma unroll
        for (int ai = 0; ai < 2; ++ai)
#pragma unroll
            for (int m = 0; m < 4; ++m) {
                const int row = row0 + ai * HALF + m * 16; const float rs = rsc.get(row);
#pragma unroll
                for (int bj = 0; bj < 2; ++bj) {
                    float a[8];
#pragma unroll
                    for (int n = 0; n < 2; ++n)
#pragma unroll
                        for (int i = 0; i < 4; ++i) a[n * 4 + i] = acc[ai][bj][m][n][i] * rs;
                    *(u32x4*)(O + (size_t)row * ldo + col0 + bj * HALF) = pack8(a);
                }
            }
    }
};
struct EpiResid {
    static constexpr bool PERM = false, AFTER_DRAIN = false;
    const float* base; const float* bss; const float* bg; float alpha; float* out; bf16_t* outb; float* ss_out; const float* gf; float* ssg_out;
    __device__ __forceinline__ void operator()(const f32x4 (&acc)[2][2][4][2], const Unit& u, int wr, int wc, int fr, int fq) const {
        const int row0 = u.pm * BM + wr * 64 + fr, col0 = u.pn * BM + wc * 32 + 4 * fq;
#pragma unroll
        for (int ai = 0; ai < 2; ++ai)
#pragma unroll
            for (int m = 0; m < 4; ++m) {
                const int row = row0 + ai * HALF + m * 16; const size_t off = (size_t)row * DM + col0;
                float brs = 1.0f; if (bss) brs = 1.0f / sqrtf(sum16(bss + (size_t)row * 16) * (1.0f / DM) + EPS);
                float s = 0.f, sg = 0.f;
#pragma unroll
                for (int bj = 0; bj < 2; ++bj)
#pragma unroll
                    for (int n = 0; n < 2; ++n) {
                        const int co = bj * HALF + n * 16;
                        f32x4 b = *(const f32x4*)(base + off + co);
                        if (bss) { const f32x4 g = *(const f32x4*)(bg + col0 + co); b = b * g * brs; }
                        const f32x4 v = b + acc[ai][bj][m][n] * alpha;
                        *(f32x4*)(out + off + co) = v;
                        u32x2 w; w.x = pk2(v[0], v[1]); w.y = pk2(v[2], v[3]); *(u32x2*)(outb + off + co) = w;
                        s += (v[0] * v[0] + v[1] * v[1]) + (v[2] * v[2] + v[3] * v[3]);
                        if (gf) { const f32x4 g2 = *(const f32x4*)(gf + col0 + co); const f32x4 t = v * g2; sg += (t[0] * t[0] + t[1] * t[1]) + (t[2] * t[2] + t[3] * t[3]); }
                    }
                s += __shfl_xor(s, 16); s += __shfl_xor(s, 32);
                if (fq == 0) ss_out[(size_t)row * 16 + u.pn * 4 + wc] = s;
                if (gf) { sg += __shfl_xor(sg, 16); sg += __shfl_xor(sg, 32); if (fq == 0) ssg_out[(size_t)row * 16 + u.pn * 4 + wc] = sg; }
            }
    }
};

template <class Epi, class Sched, bool ALIGN_EPI = false, bool SP2 = false>
__device__ __forceinline__ void gemm_phase(LAS unsigned char* lds, const Gemm g, const Sched& S, const Epi& E, const int tid) {
    const int wid = __builtin_amdgcn_readfirstlane(tid >> 6), lane = tid & 63, wr = wid >> 2, wc = wid & 3, fr = lane & 15, fq = lane >> 4;
    const int K = g.K, nt = K / BK;
    unsigned voffA[2], voffB[2];
#pragma unroll
    for (int i = 0; i < 2; ++i) { int R, C; stage_rc(tid * 16 + i * 8192, R, C); const int Rb = Epi::PERM ? ((R & ~31) + perm32(R & 31)) : R;
        voffA[i] = (unsigned)(R * K + C) * 2u; voffB[i] = (unsigned)(Rb * K + C) * 2u; }
    const size_t kstep = (size_t)(BK * 2);
    const size_t hstep = (size_t)HALF * K * 2;
    const size_t tstep = 2 * hstep;
    const unsigned ldsw = (unsigned)wid * 1024u;
    const int aoff = lds_byte(wr * 64 + fr, fq * 8), boff = lds_byte(wc * 32 + fr, fq * 8);
#define PG8_SA(b, h) (((b) * 2 + (h)) * HTB)
#define PG8_SB(b, h) ((4 + (b) * 2 + (h)) * HTB)
#define PG8_STAGE(bufoff, gbase, voff) do { _Pragma("unroll") for (int _i = 0; _i < 2; ++_i) \
        __builtin_amdgcn_global_load_lds((const unsigned*)((const char*)(gbase) + (voff)[_i]), (LAS unsigned*)(lds + (bufoff) + ldsw + _i * 8192), 16, 0, 0); } while (0)
#define PG8_LDA(dst, b, h) do { _Pragma("unroll") for (int m = 0; m < 4; ++m) _Pragma("unroll") for (int k = 0; k < 2; ++k) dst[m][k] = *(const LAS bf16x8*)(lds + PG8_SA(b, h) + aoff + m * 2048 + k * 1024); } while (0)
#define PG8_LDB(dst, b, h) do { _Pragma("unroll") for (int n = 0; n < 2; ++n) _Pragma("unroll") for (int k = 0; k < 2; ++k) dst[n][k] = *(const LAS bf16x8*)(lds + PG8_SB(b, h) + boff + n * 2048 + k * 1024); } while (0)
#define PG8_MMA(ai, bj, At, Bt) do { __builtin_amdgcn_s_setprio(1); _Pragma("unroll") for (int m = 0; m < 4; ++m) _Pragma("unroll") for (int n = 0; n < 2; ++n) _Pragma("unroll") for (int k = 0; k < 2; ++k) \
        acc[ai][bj][m][n] = __builtin_amdgcn_mfma_f32_16x16x32_bf16(Bt[n][k], At[m][k], acc[ai][bj][m][n], 0, 0, 0); __builtin_amdgcn_s_setprio(0); } while (0)
#define PG8_WAIT_V(n) asm volatile("s_waitcnt vmcnt(" #n ")" ::: "memory")
#define PG8_WAIT_L(n) asm volatile("s_waitcnt lgkmcnt(" #n ")" ::: "memory")
#define PG8_BAR __builtin_amdgcn_s_barrier()
#define PG8_SCHED __builtin_amdgcn_sched_barrier(0)
    Unit cur, nxt; int ui = 0;
    if (!S.next(0, cur)) return;
    f32x4 acc[2][2][4][2];
#pragma unroll
    for (int a = 0; a < 2; ++a)
#pragma unroll
        for (int b = 0; b < 2; ++b)
#pragma unroll
            for (int m = 0; m < 4; ++m)
#pragma unroll
                for (int n = 0; n < 2; ++n) acc[a][b][m][n] = (f32x4){0.f, 0.f, 0.f, 0.f};
    bf16x8 At[4][2], B0[2][2], B1[2][2];
    const char* cA = (const char*)g.A + (size_t)cur.pm * tstep; const char* cB = (const char*)g.Bt + (size_t)cur.pn * tstep;
    S.a_ready(cur);
    if constexpr (SP2) {
        PG8_STAGE(PG8_SB(0, 0), cB, voffB); PG8_STAGE(PG8_SB(0, 1), cB + hstep, voffB); PG8_STAGE(PG8_SA(0, 0), cA, voffA); PG8_STAGE(PG8_SA(0, 1), cA + hstep, voffA);
        if (wr == 1) PG8_BAR;
        PG8_WAIT_V(2); PG8_BAR;
        PG8_STAGE(PG8_SB(1, 0), cB + kstep, voffB); PG8_STAGE(PG8_SA(1, 0), cA + kstep, voffA); PG8_STAGE(PG8_SB(1, 1), cB + hstep + kstep, voffB);
        PG8_WAIT_V(6); PG8_BAR;
    } else {
        PG8_STAGE(PG8_SB(0, 0), cB, voffB); PG8_STAGE(PG8_SA(0, 0), cA, voffA); PG8_STAGE(PG8_SB(0, 1), cB + hstep, voffB); PG8_STAGE(PG8_SA(0, 1), cA + hstep, voffA);
        if (wr == 1) PG8_BAR;
        PG8_WAIT_V(4); PG8_BAR;
        PG8_STAGE(PG8_SB(1, 0), cB + kstep, voffB); PG8_STAGE(PG8_SA(1, 0), cA + kstep, voffA); PG8_STAGE(PG8_SB(1, 1), cB + hstep + kstep, voffB);
        PG8_WAIT_V(6); PG8_BAR;
    }
    for (;;) {
        const bool has_next = S.next(ui + 1, nxt);
        const char* nA = has_next ? (const char*)g.A + (size_t)nxt.pm * tstep : cA; const char* nB = has_next ? (const char*)g.Bt + (size_t)nxt.pn * tstep : cB;
        for (int t = 0; t < nt; t += 2) {
            const bool last = (t == nt - 2);
            const char* a1 = cA + (size_t)(t + 1) * kstep;
            const char* a2 = last ? nA : cA + (size_t)(t + 2) * kstep; const char* b2 = last ? nB : cB + (size_t)(t + 2) * kstep;
            const char* a3 = a2 + kstep; const char* b3 = b2 + kstep;
            if (last && has_next) S.a_ready(nxt);
            if constexpr (SP2) {
            PG8_LDB(B0, 0, 0); PG8_LDB(B1, 0, 1); PG8_SCHED; PG8_LDA(At, 0, 0); PG8_STAGE(PG8_SA(1, 1), a1 + hstep, voffA);
            PG8_WAIT_V(8); PG8_WAIT_L(0); PG8_BAR; PG8_MMA(0, 0, At, B0); PG8_MMA(0, 1, At, B1); PG8_BAR; PG8_SCHED;
            PG8_LDA(At, 0, 1); PG8_STAGE(PG8_SB(0, 0), b2, voffB); PG8_STAGE(PG8_SB(0, 1), b2 + hstep, voffB); PG8_STAGE(PG8_SA(0, 0), a2, voffA);
            PG8_WAIT_V(8); PG8_WAIT_L(0); PG8_BAR; PG8_MMA(1, 0, At, B0); PG8_MMA(1, 1, At, B1); PG8_BAR; PG8_SCHED;
            PG8_LDB(B0, 1, 0); PG8_LDB(B1, 1, 1); PG8_SCHED; PG8_LDA(At, 1, 0); PG8_STAGE(PG8_SA(0, 1), a2 + hstep, voffA);
            PG8_WAIT_V(8); PG8_WAIT_L(0); PG8_BAR; PG8_MMA(0, 0, At, B0); PG8_MMA(0, 1, At, B1); PG8_BAR; PG8_SCHED;
            PG8_LDA(At, 1, 1); PG8_STAGE(PG8_SB(1, 0), b3, voffB); PG8_STAGE(PG8_SB(1, 1), b3 + hstep, voffB); PG8_STAGE(PG8_SA(1, 0), a3, voffA);
            PG8_WAIT_V(8); PG8_WAIT_L(0); PG8_BAR; PG8_MMA(1, 0, At, B0); PG8_MMA(1, 1, At, B1); PG8_BAR; PG8_SCHED;
            } else {
            PG8_LDB(B0, 0, 0); PG8_SCHED; PG8_LDA(At, 0, 0); PG8_STAGE(PG8_SA(1, 1), a1 + hstep, voffA);
            PG8_WAIT_L(8); PG8_BAR; PG8_WAIT_L(0); PG8_MMA(0, 0, At, B0); PG8_BAR; PG8_SCHED;
            PG8_LDB(B1, 0, 1); PG8_STAGE(PG8_SB(0, 0), b2, voffB);
            PG8_BAR; PG8_WAIT_L(0); PG8_MMA(0, 1, At, B1); PG8_BAR;
            PG8_LDA(At, 0, 1); PG8_STAGE(PG8_SA(0, 0), a2, voffA);
            PG8_BAR; PG8_WAIT_L(0); PG8_MMA(1, 0, At, B0); PG8_BAR; PG8_SCHED;
            PG8_STAGE(PG8_SB(0, 1), b2 + hstep, voffB);
            PG8_WAIT_V(6); PG8_BAR; PG8_MMA(1, 1, At, B1); PG8_BAR;
            PG8_LDB(B0, 1, 0); PG8_SCHED; PG8_LDA(At, 1, 0); PG8_STAGE(PG8_SA(0, 1), a2 + hstep, voffA);
            PG8_WAIT_L(8); PG8_BAR; PG8_WAIT_L(0); PG8_MMA(0, 0, At, B0); PG8_BAR; PG8_SCHED;
            PG8_LDB(B1, 1, 1); PG8_STAGE(PG8_SB(1, 0), b3, voffB);
            PG8_BAR; PG8_WAIT_L(0); PG8_MMA(0, 1, At, B1); PG8_BAR;
            PG8_LDA(At, 1, 1); PG8_STAGE(PG8_SA(1, 0), a3, voffA);
            PG8_BAR; PG8_WAIT_L(0); PG8_MMA(1, 0, At, B0); PG8_BAR; PG8_SCHED;
            PG8_STAGE(PG8_SB(1, 1), b3 + hstep, voffB);
            PG8_WAIT_V(6); PG8_BAR; PG8_MMA(1, 1, At, B1); PG8_BAR;
            }
        }
        if constexpr (ALIGN_EPI) { if (wr == 0) PG8_BAR; }
        if constexpr (!Epi::AFTER_DRAIN) { E(acc, cur, wr, wc, fr, fq); S.done(cur); }
        if (!has_next) break;
#pragma unroll
        for (int a = 0; a < 2; ++a)
#pragma unroll
            for (int b = 0; b < 2; ++b)
#pragma unroll
                for (int m = 0; m < 4; ++m)
#pragma unroll
                    for (int n = 0; n < 2; ++n) acc[a][b][m][n] = (f32x4){0.f, 0.f, 0.f, 0.f};
        cur = nxt; cA = nA; cB = nB; ++ui;
        if constexpr (ALIGN_EPI) { if (wr == 1) PG8_BAR; }
    }
    PG8_WAIT_V(0);
    if constexpr (!ALIGN_EPI) { if (wr == 0) PG8_BAR; }
    PG8_BAR;
#undef PG8_SA
#undef PG8_SB
#undef PG8_STAGE
#undef PG8_LDA
#undef PG8_LDB
#undef PG8_MMA
#undef PG8_WAIT_V
#undef PG8_WAIT_L
#undef PG8_BAR
#undef PG8_SCHED
}
}

struct Params { const float* in[32]; float* out; unsigned char* ws; int ph_lo, ph_hi; };
enum { I_X = 0, I_F1N, I_F1G, I_F1U, I_F1D, I_MIXN, I_WIN, I_NAQN, I_NAKN, I_NARPB, I_NABETA, I_MLAQLN, I_MLAWUQ, I_MLAKVLN, I_MLAWUKV, I_MLAQN, I_MLAKN, I_MLABETA,
       I_DQN, I_DKN, I_DLAM, I_DSUBLN, I_GQN, I_GKN, I_GBETA, I_WOUT, I_F2N, I_F2G, I_F2U, I_F2D, I_FINN, I_T5 };
__host__ __device__ __forceinline__ float lambda_init(int l) { return l == 0 ? 0.2f : 0.35550906f; }

typedef const __attribute__((address_space(4))) Params* KParams;
typedef const float* const __attribute__((address_space(4)))* InPtr;
struct Ctx {
    KParams kp; LAS unsigned char* lds; int tid, lane, wave, G, bid;
    __device__ __forceinline__ float* ssp(int k) const { return (float*)(kp->ws + WS_SSP + (size_t)k * MiB); }
    __device__ __forceinline__ float* ss0() const { return (float*)(kp->ws + WS_SS0); }
    __device__ __forceinline__ bf16_t* wsb(size_t off) const { return (bf16_t*)(kp->ws + off); }
};

__device__ __forceinline__ float gain_for(const Ctx& c, int job, int l, int k) {
    InPtr in = c.kp->in;
    switch (job) {
        case 0: { float g = in[I_F1N][l * DM + k]; if (l > 0) g *= in[I_FINN][(l - 1) * DM + k]; return g; }
        case 2: return in[I_MIXN][l * DM + k];
        case 3: { const int gidx = k >> 8, kk = k & 255;
                  if (gidx == 0) return in[I_NABETA][l * 256 + kk];
                  if (gidx == 1) return in[I_MLABETA][l * 256 + kk];
                  if (gidx == 2) return in[I_DSUBLN][l * 64 + (kk & 63)] * (1.0f - lambda_init(l));
                  return in[I_GBETA][l * 256 + kk]; }
        case 4: return in[I_F2N][l * DM + k];
        case 6: return in[I_MLAQLN][l * 256 + k];
        case 7: return in[I_MLAKVLN][l * 128 + k];
        default: return 1.0f;
    }
}
__device__ __forceinline__ void tr_item(const Ctx& c, const float* W, int Nsrc, int sc0, bf16_t* WT, int K, int n0, int k0, int job, int l, LAS float* scr) {
    const int lane = c.lane;
#pragma unroll 8
    for (int i = 0; i < 32; ++i) { const int kk = 2 * i + (lane >> 5);
        float v = 0.f; if (W) v = W[(size_t)(k0 + kk) * Nsrc + sc0 + (lane & 31)] * gain_for(c, job, l, k0 + kk);
        scr[kk * 33 + (lane & 31)] = v; }
    asm volatile("s_waitcnt lgkmcnt(0)" ::: "memory");
    const int ch = lane & 7;
#pragma unroll
    for (int j = 0; j < 4; ++j) { const int n = (lane >> 3) + 8 * j; const LAS float* s = scr + (8 * ch) * 33 + n;
        u32x4 o; o.x = pk2(s[0 * 33], s[1 * 33]); o.y = pk2(s[2 * 33], s[3 * 33]); o.z = pk2(s[4 * 33], s[5 * 33]); o.w = pk2(s[6 * 33], s[7 * 33]);
        *(u32x4*)(WT + (size_t)(n0 + n) * K + k0 + 8 * ch) = o; }
    asm volatile("s_waitcnt lgkmcnt(0)" ::: "memory");
}
__device__ __forceinline__ void wconv_layer(const Ctx& c, int l) {
    LAS float* scr = (LAS float*)(c.lds + c.wave * 16384);
    const int gw = c.bid * NWAVES + c.wave, NGW = c.G * NWAVES;
    constexpr int C0 = 16 * 176, C1 = 44 * 32, C2 = 16 * 80, C3 = 16 * 32, C6 = 4 * 12, C7 = 2 * 16;
    constexpr int NITEMS = 2 * C0 + 2 * C1 + C2 + C3 + C6 + C7;
    InPtr in = c.kp->in;
    for (int it = gw; it < NITEMS; it += NGW) {
        int r = it;
        if (r < C0 || (r >= C0 + C1 + C2 + C3 && r < 2 * C0 + C1 + C2 + C3)) {
            const bool second = r >= C0; if (second) r -= C0 + C1 + C2 + C3;
            const int nblk = 176, kb = r / nblk, nb = r % nblk, pn = nb >> 3, blk = nb & 7;
            const float* Wg = second ? in[I_F2G] : in[I_F1G]; const float* Wu = second ? in[I_F2U] : in[I_F1U];
            const float* W = (blk < 4 ? Wg : Wu) + (size_t)l * DM * DFF;
            tr_item(c, W, DFF, 128 * pn + 32 * (blk & 3), c.wsb(second ? WS_WGU2 : WS_WGU1), DM, 32 * nb, 64 * kb, second ? 4 : 0, l, scr);
            continue;
        }
        r -= C0;
        if (r < C1) { const int kb = r / 32, nb = r % 32; tr_item(c, in[I_F1D] + (size_t)l * DFF * DM, DM, 32 * nb, c.wsb(WS_WD1), DFF, 32 * nb, 64 * kb, 1, l, scr); continue; }
        r -= C1;
        if (r < C2) { const int kb = r / 80, nb = r % 80, n0 = 32 * nb;
            const float* W = in[I_WIN] + (size_t)l * DM * 2464; int sc0 = n0;
            if (n0 >= 1184 && n0 < 1280) W = nullptr; else if (n0 >= 1280) sc0 = n0 - 96;
            tr_item(c, W, 2464, sc0, c.wsb(WS_WIN), DM, n0, 64 * kb, 2, l, scr); continue; }
        r -= C2;
        if (r < C3) { const int kb = r / 32, nb = r % 32; tr_item(c, in[I_WOUT] + (size_t)l * DM * DM, DM, 32 * nb, c.wsb(WS_WOUT), DM, 32 * nb, 64 * kb, 3, l, scr); continue; }
        r -= C3; r -= C0;
        if (r < C1) { const int kb = r / 32, nb = r % 32; tr_item(c, in[I_F2D] + (size_t)l * DFF * DM, DM, 32 * nb, c.wsb(WS_WD2), DFF, 32 * nb, 64 * kb, 5, l, scr); continue; }
        r -= C1;
        if (r < C6) { const int kb = r / 12, nb = r % 12; tr_item(c, in[I_MLAWUQ] + (size_t)l * 256 * 384, 384, 32 * nb, c.wsb(WS_WUQ), 256, 32 * nb, 64 * kb, 6, l, scr); continue; }
        r -= C6;
        { const int kb = r / 16, nb = r % 16; tr_item(c, in[I_MLAWUKV] + (size_t)l * 128 * 512, 512, 32 * nb, c.wsb(WS_WUKV), 128, 32 * nb, 64 * kb, 7, l, scr); }
    }
}
__device__ __forceinline__ void prologue(const Ctx& c) {
    const int gt = c.bid * NTHREADS + c.tid, NGT = c.G * NTHREADS;
    for (int i = gt; i < SEQ * 16; i += NGT) {
        const int pos = i >> 4, fi = i & 15;
        const float inv = expf(-9.210340371976184f * (float)(2 * fi) / 32.0f);
        const float ang = (float)pos * inv;
        const double a = (double)ang * 0.15915494309189535;
        const double fr = a - rint(a);
        const float f = (float)fr;
        float2 cs; cs.x = __builtin_amdgcn_cosf(f); cs.y = __builtin_amdgcn_sinf(f);
        ((float2*)(c.kp->ws + WS_TAB))[i] = cs;
    }
    const int gw = c.bid * NWAVES + c.wave, NGW = c.G * NWAVES;
    const float* x = c.kp->in[I_X]; bf16_t* xb = c.wsb(WS_XB); float* ss0 = c.ss0();
    for (int row = gw; row < MROWS; row += NGW) {
        const f32x4* xr = (const f32x4*)(x + (size_t)row * DM) + c.lane; float s = 0.f;
#pragma unroll
        for (int j = 0; j < 4; ++j) { const f32x4 v = xr[64 * j]; s += (v[0] * v[0] + v[1] * v[1]) + (v[2] * v[2] + v[3] * v[3]);
            u32x2 w; w.x = pk2(v[0], v[1]); w.y = pk2(v[2], v[3]); *((u32x2*)(xb + (size_t)row * DM) + c.lane + 64 * j) = w; }
        s = wave_sum(s); if (c.lane == 0) ss0[row] = s;
    }
    wconv_layer(c, 0);
}

constexpr int PL_VS = 0, PL_CQ = 36864, PL_CKV = 70656, PL_KR = 88064, PL_RSQ = 96256, PL_RSKV = 96512;
__device__ __forceinline__ void vt_write(const Ctx& c, int nh, bf16_t* Vbase, int kvh0, int tt) {
    const LAS bf16_t* VS = (const LAS bf16_t*)(c.lds + PL_VS);
    const int kc = c.tid >> 6, d = c.tid & 63;
    for (int h = 0; h < nh; ++h) {
        unsigned short e[8];
#pragma unroll
        for (int j = 0; j < 8; ++j) { const int key = 16 * (kc >> 1) + 8 * (j >> 2) + 4 * (kc & 1) + (j & 3); e[j] = VS[(h * 64 + key) * 72 + d]; }
        u32x4 o; o.x = e[0] | ((unsigned)e[1] << 16); o.y = e[2] | ((unsigned)e[3] << 16); o.z = e[4] | ((unsigned)e[5] << 16); o.w = e[6] | ((unsigned)e[7] << 16);
        *(u32x4*)(Vbase + ((size_t)(kvh0 + h) * NTILE + tt) * 4096 + (kc * 64 + d) * 8) = o;
    }
}
__device__ __forceinline__ void prep_unit(const Ctx& c, int l, int T) {
    InPtr in = c.kp->in;
    const int tid = c.tid, tok = tid >> 3, sub = tid & 7, b = T >> 7, tt = T & 127, t = tt * 64 + tok;
    const bf16_t* prow = c.wsb(WS_R) + (size_t)(T * 64 + tok) * NIN;
    LAS bf16_t* VS = (LAS bf16_t*)(c.lds + PL_VS);
    LAS bf16_t* CQ = (LAS bf16_t*)(c.lds + PL_CQ);
    LAS bf16_t* CKV = (LAS bf16_t*)(c.lds + PL_CKV);
    LAS float* KR = (LAS float*)(c.lds + PL_KR);
    LAS float* RSQ = (LAS float*)(c.lds + PL_RSQ);
    LAS float* RSKV = (LAS float*)(c.lds + PL_RSKV);
    const float2* tab = (const float2*)(c.kp->ws + WS_TAB);
    {
        float ssq = 0.f;
#pragma unroll
        for (int i = 0; i < 4; ++i) { const u32x4 u = *(const u32x4*)(prow + 768 + 64 * i + 8 * sub); float v[8]; unpack8(u, v);
#pragma unroll
            for (int j = 0; j < 8; ++j) ssq += v[j] * v[j];
            *(LAS u32x4*)(CQ + tok * 264 + 64 * i + 8 * sub) = u; }
        ssq += __shfl_xor(ssq, 1); ssq += __shfl_xor(ssq, 2); ssq += __shfl_xor(ssq, 4);
        if (sub == 0) RSQ[tok] = 1.0f / sqrtf(ssq * (1.0f / 256.0f) + EPS);
        float ssk = 0.f;
#pragma unroll
        for (int i = 0; i < 2; ++i) { const u32x4 u = *(const u32x4*)(prow + 1024 + 64 * i + 8 * sub); float v[8]; unpack8(u, v);
#pragma unroll
            for (int j = 0; j < 8; ++j) ssk += v[j] * v[j];
            *(LAS u32x4*)(CKV + tok * 136 + 64 * i + 8 * sub) = u; }
        ssk += __shfl_xor(ssk, 1); ssk += __shfl_xor(ssk, 2); ssk += __shfl_xor(ssk, 4);
        if (sub == 0) RSKV[tok] = 1.0f / sqrtf(ssk * (1.0f / 128.0f) + EPS);
        if (sub < 4) { const u32x4 u = *(const u32x4*)(prow + 1152 + 8 * sub); float v[8]; unpack8(u, v);
#pragma unroll
            for (int j = 0; j < 8; ++j) KR[tok * 32 + 8 * sub + j] = v[j]; }
    }
    {
        const float* qg = in[I_NAQN] + l * 64 + sub * 8; const float* kg = in[I_NAKN] + l * 64 + sub * 8;
        bf16_t* QA = c.wsb(WS_QA); bf16_t* KA = c.wsb(WS_KA);
#pragma unroll
        for (int h = 0; h < 4; ++h) {
            float v[8], o[8]; unpack8(*(const u32x4*)(prow + h * 64 + sub * 8), v);
            float s = 0.f;
#pragma unroll
            for (int j = 0; j < 8; ++j) s += v[j] * v[j];
            s += __shfl_xor(s, 1); s += __shfl_xor(s, 2); s += __shfl_xor(s, 4);
            float rs = (1.0f / sqrtf(s * (1.0f / 64.0f) + EPS)) * (0.125f * LOG2E);
#pragma unroll
            for (int j = 0; j < 8; ++j) o[j] = v[j] * rs * qg[j];
            *(u32x4*)(QA + ((size_t)(b * 4 + h) * SEQ + t) * 64 + sub * 8) = pack8(o);
            unpack8(*(const u32x4*)(prow + 256 + h * 64 + sub * 8), v);
            s = 0.f;
#pragma unroll
            for (int j = 0; j < 8; ++j) s += v[j] * v[j];
            s += __shfl_xor(s, 1); s += __shfl_xor(s, 2); s += __shfl_xor(s, 4);
            rs = 1.0f / sqrtf(s * (1.0f / 64.0f) + EPS);
#pragma unroll
            for (int j = 0; j < 8; ++j) o[j] = v[j] * rs * kg[j];
            *(u32x4*)(KA + ((size_t)(b * 4 + h) * NTILE + tt) * 4096 + (sub * 64 + tok) * 8) = pack8(o);
            *(LAS u32x4*)(VS + (h * 64 + tok) * 72 + sub * 8) = *(const u32x4*)(prow + 512 + h * 64 + sub * 8);
        }
    }
    __syncthreads();
    vt_write(c, 4, c.wsb(WS_VA), b * 4, tt);
    __syncthreads();
    {
        const int lane = c.lane, l15 = lane & 15, fq = lane >> 4;
        const bf16_t* Wuq = c.wsb(WS_WUQ); const bf16_t* Wukv = c.wsb(WS_WUKV);
        for (int it = 0; it < 4; ++it) {
            const int task = c.wave + 8 * it;
            if (task < 16) {
                const int mt = task & 3, h = task >> 2, tokl = 16 * mt + l15, tq = tt * 64 + tokl, bh = b * 4 + h;
                f32x4 acc[6];
#pragma unroll
                for (int nt = 0; nt < 6; ++nt) acc[nt] = (f32x4){0.f, 0.f, 0.f, 0.f};
#pragma unroll
                for (int ks = 0; ks < 8; ++ks) {
                    const bf16x8 bfrag = *(const LAS bf16x8*)(CQ + tokl * 264 + 32 * ks + 8 * fq);
#pragma unroll
                    for (int nt = 0; nt < 6; ++nt) {
                        const bf16x8 afrag = *(const bf16x8*)(Wuq + (size_t)(h * 96 + 16 * nt + l15) * 256 + 32 * ks + 8 * fq);
                        acc[nt] = __builtin_amdgcn_mfma_f32_16x16x32_bf16(afrag, bfrag, acc[nt], 0, 0, 0);
                    }
                }
                const float rsq = RSQ[tokl]; float s = 0.f;
#pragma unroll
                for (int nt = 0; nt < 6; ++nt) { acc[nt] = acc[nt] * rsq; s += (acc[nt][0] * acc[nt][0] + acc[nt][1] * acc[nt][1]) + (acc[nt][2] * acc[nt][2] + acc[nt][3] * acc[nt][3]); }
                s += __shfl_xor(s, 16); s += __shfl_xor(s, 32);
                const float rh = 1.0f / sqrtf(s * (1.0f / 96.0f) + EPS);
                const float* gq = in[I_MLAQN] + l * 96 + 4 * fq;
#pragma unroll
                for (int nt = 0; nt < 6; ++nt) { const f32x4 g = *(const f32x4*)(gq + 16 * nt); acc[nt] = acc[nt] * g * rh; }
#pragma unroll
                for (int r = 0; r < 4; ++r) { const float2 cs = tab[tq * 16 + 4 * fq + r]; const float x1 = acc[4][r], x2 = acc[5][r]; acc[4][r] = x1 * cs.x - x2 * cs.y; acc[5][r] = x1 * cs.y + x2 * cs.x; }
                const float sc = 0.10206207261596577f * LOG2E;
                bf16_t* qo = c.wsb(WS_QB) + ((size_t)bh * SEQ + tq) * 96 + 4 * fq;
#pragma unroll
                for (int nt = 0; nt < 6; ++nt) { u32x2 w; w.x = pk2(acc[nt][0] * sc, acc[nt][1] * sc); w.y = pk2(acc[nt][2] * sc, acc[nt][3] * sc); *(u32x2*)(qo + 16 * nt) = w; }
            } else {
                const int tk = task - 16, mt = tk & 3, h = tk >> 2, tokl = 16 * mt + l15, tq = tt * 64 + tokl, bh = b * 4 + h;
                f32x4 acc[8];
#pragma unroll
                for (int nt = 0; nt < 8; ++nt) acc[nt] = (f32x4){0.f, 0.f, 0.f, 0.f};
#pragma unroll
                for (int ks = 0; ks < 4; ++ks) {
                    const bf16x8 bfrag = *(const LAS bf16x8*)(CKV + tokl * 136 + 32 * ks + 8 * fq);
#pragma unroll
                    for (int nt = 0; nt < 8; ++nt) {
                        const bf16x8 afrag = *(const bf16x8*)(Wukv + (size_t)(h * 128 + 16 * nt + l15) * 128 + 32 * ks + 8 * fq);
                        acc[nt] = __builtin_amdgcn_mfma_f32_16x16x32_bf16(afrag, bfrag, acc[nt], 0, 0, 0);
                    }
                }
                const float rskv = RSKV[tokl];
#pragma unroll
                for (int nt = 0; nt < 8; ++nt) acc[nt] = acc[nt] * rskv;
                f32x4 kr1 = *(const LAS f32x4*)(KR + tokl * 32 + 4 * fq), kr2 = *(const LAS f32x4*)(KR + tokl * 32 + 16 + 4 * fq);
                float s = (kr1[0] * kr1[0] + kr1[1] * kr1[1]) + (kr1[2] * kr1[2] + kr1[3] * kr1[3]) + (kr2[0] * kr2[0] + kr2[1] * kr2[1]) + (kr2[2] * kr2[2] + kr2[3] * kr2[3]);
#pragma unroll
                for (int nt = 0; nt < 4; ++nt) s += (acc[nt][0] * acc[nt][0] + acc[nt][1] * acc[nt][1]) + (acc[nt][2] * acc[nt][2] + acc[nt][3] * acc[nt][3]);
                s += __shfl_xor(s, 16); s += __shfl_xor(s, 32);
                const float rh = 1.0f / sqrtf(s * (1.0f / 96.0f) + EPS);
                const float* gk = in[I_MLAKN] + l * 96 + 4 * fq;
#pragma unroll
                for (int nt = 0; nt < 4; ++nt) { const f32x4 g = *(const f32x4*)(gk + 16 * nt); acc[nt] = acc[nt] * g * rh; }
                kr1 = kr1 * *(const f32x4*)(gk + 64) * rh; kr2 = kr2 * *(const f32x4*)(gk + 80) * rh;
#pragma unroll
                for (int r = 0; r < 4; ++r) { const float2 cs = tab[tq * 16 + 4 * fq + r]; const float x1 = kr1[r], x2 = kr2[r]; kr1[r] = x1 * cs.x - x2 * cs.y; kr2[r] = x1 * cs.y + x2 * cs.x; }
                bf16_t* kt = c.wsb(WS_KB) + ((size_t)bh * NTILE + tt) * 6144 + tokl * 8 + (fq & 1) * 4;
#pragma unroll
                for (int nt = 0; nt < 4; ++nt) { u32x2 w; w.x = pk2(acc[nt][0], acc[nt][1]); w.y = pk2(acc[nt][2], acc[nt][3]); *(u32x2*)(kt + (2 * nt + (fq >> 1)) * 512) = w; }
                { u32x2 w; w.x = pk2(kr1[0], kr1[1]); w.y = pk2(kr1[2], kr1[3]); *(u32x2*)(kt + (8 + (fq >> 1)) * 512) = w;
                  w.x = pk2(kr2[0], kr2[1]); w.y = pk2(kr2[2], kr2[3]); *(u32x2*)(kt + (10 + (fq >> 1)) * 512) = w; }
#pragma unroll
                for (int nt = 4; nt < 8; ++nt) { u32x2 w; w.x = pk2(acc[nt][0], acc[nt][1]); w.y = pk2(acc[nt][2], acc[nt][3]); *(LAS u32x2*)(VS + (h * 64 + tokl) * 72 + 16 * (nt - 4) + 4 * fq) = w; }
            }
        }
    }
    __syncthreads();
    vt_write(c, 4, c.wsb(WS_VB), b * 4, tt);
    __syncthreads();
    {
        const float* qg = in[I_DQN] + l * 32 + (sub & 3) * 8; const float* kg = in[I_DKN] + l * 32 + (sub & 3) * 8;
        bf16_t* QC = c.wsb(WS_QC); bf16_t* KC = c.wsb(WS_KC);
#pragma unroll
        for (int h = 0; h < 4; ++h) {
            float v[8], o[8]; unpack8(*(const u32x4*)(prow + 1280 + h * 64 + sub * 8), v);
            float s = 0.f;
#pragma unroll
            for (int j = 0; j < 8; ++j) s += v[j] * v[j];
            s += __shfl_xor(s, 1); s += __shfl_xor(s, 2);
            float rs = (1.0f / sqrtf(s * (1.0f / 32.0f) + EPS)) * (0.17677669529663687f * LOG2E);
#pragma unroll
            for (int j = 0; j < 8; ++j) o[j] = v[j] * rs * qg[j];
            *(u32x4*)(QC + ((size_t)(b * 4 + h) * SEQ + t) * 64 + sub * 8) = pack8(o);
            unpack8(*(const u32x4*)(prow + 1280 + 256 + h * 64 + sub * 8), v);
            s = 0.f;
#pragma unroll
            for (int j = 0; j < 8; ++j) s += v[j] * v[j];
            s += __shfl_xor(s, 1); s += __shfl_xor(s, 2);
            rs = 1.0f / sqrtf(s * (1.0f / 32.0f) + EPS);
#pragma unroll
            for (int j = 0; j < 8; ++j) o[j] = v[j] * rs * kg[j];
            *(u32x4*)(KC + ((size_t)(b * 4 + h) * NTILE + tt) * 4096 + (sub * 64 + tok) * 8) = pack8(o);
            *(LAS u32x4*)(VS + (h * 64 + tok) * 72 + sub * 8) = *(const u32x4*)(prow + 1280 + 512 + h * 64 + sub * 8);
        }
    }
    __syncthreads();
    vt_write(c, 4, c.wsb(WS_VC), b * 4, tt);
    __syncthreads();
    {
        const float* qg = in[I_GQN] + l * 64 + sub * 8; const float* kg = in[I_GKN] + l * 64 + sub * 8;
        bf16_t* QD = c.wsb(WS_QD); bf16_t* KD = c.wsb(WS_KD);
        const int pos = (sub < 4) ? (t >> 6) : (t & 63); const bool first = (sub & 2) == 0;
        float cs_c[8], cs_s[8];
#pragma unroll
        for (int j = 0; j < 8; ++j) { const float2 cs = tab[pos * 16 + 8 * (sub & 1) + j]; cs_c[j] = cs.x; cs_s[j] = cs.y; }
#pragma unroll
        for (int h = 0; h < 6; ++h) {
            const bool isq = h < 4;
            float v[8], o[8]; unpack8(*(const u32x4*)(prow + 2048 + h * 64 + sub * 8), v);
            float s = 0.f;
#pragma unroll
            for (int j = 0; j < 8; ++j) s += v[j] * v[j];
            s += __shfl_xor(s, 1); s += __shfl_xor(s, 2); s += __shfl_xor(s, 4);
            const float rs = 1.0f / sqrtf(s * (1.0f / 64.0f) + EPS);
            const float* g = isq ? qg : kg;
#pragma unroll
            for (int j = 0; j < 8; ++j) v[j] = v[j] * rs * g[j];
            const float sc = isq ? 0.125f * LOG2E : 1.0f;
#pragma unroll
            for (int j = 0; j < 8; ++j) { const float pv = __shfl_xor(v[j], 2); o[j] = (first ? (v[j] * cs_c[j] - pv * cs_s[j]) : (pv * cs_s[j] + v[j] * cs_c[j])) * sc; }
            if (isq) *(u32x4*)(QD + ((size_t)(b * 4 + h) * SEQ + t) * 64 + sub * 8) = pack8(o);
            else *(u32x4*)(KD + ((size_t)(b * 2 + (h - 4)) * NTILE + tt) * 4096 + (sub * 64 + tok) * 8) = pack8(o);
        }
#pragma unroll
        for (int h = 0; h < 2; ++h) *(LAS u32x4*)(VS + (h * 64 + tok) * 72 + sub * 8) = *(const u32x4*)(prow + 2048 + 384 + h * 64 + sub * 8);
    }
    __syncthreads();
    vt_write(c, 2, c.wsb(WS_VD), b * 2, tt);
    __syncthreads();
}

namespace att {
constexpr int SLOT_K = 12288, SLOT = 20480, LUT_OFF = 3 * SLOT;
struct Args { const bf16_t* Q; const bf16_t* K; const bf16_t* V; bf16_t* Y; int ycol, kv_shift, nkvh; const float* lut_src; const float* lam_src; float lam_init; };
__device__ __forceinline__ int crow(int r, int hi) { return (r & 3) + 8 * (r >> 2) + 4 * hi; }
__device__ __forceinline__ int iclamp(int v, int lo, int hi) { return v < lo ? lo : (v > hi ? hi : v); }
__device__ __forceinline__ void glds16(const bf16_t* src, LAS unsigned char* dst) { __builtin_amdgcn_global_load_lds((const unsigned*)src, (LAS unsigned*)dst, 16, 0, 0); }

template <int MODE, int DQK>
__device__ __forceinline__ void unit(const Args& a, int bh, int qb, LAS unsigned char* lds, const int tid) {
    constexpr int NQF = DQK / 16, NMAP = (MODE == 1) ? 2 : 1, FPM = NQF / NMAP, NKP = DQK / 8, NP = NKP + 8, NPW = (NP + 7) / 8, KT_ELEMS = DQK * 64;
    const int lane = tid & 63, r32 = lane & 31, hi = lane >> 5, w = __builtin_amdgcn_readfirstlane(tid >> 6);
    const int b = bh >> 2, h = bh & 3, kvh = b * a.nkvh + (h >> a.kv_shift);
    const int qrow = qb * 256 + 32 * w + r32;
    int t_lo = 0, t_hi = NTILE, my_lo = 0, my_hi = NTILE, myr = 0;
    if (MODE == 2) { const int r0 = qb * 4; t_lo = iclamp(r0 - 4, 0, 120); t_hi = iclamp(r0 + 3 - 4, 0, 120) + 8; myr = r0 + (w >> 1); my_lo = iclamp(myr - 4, 0, 120); my_hi = my_lo + 8; }
    const int NT = t_hi - t_lo;
    LAS float* lut = (LAS float*)(lds + LUT_OFF);
    if (MODE == 1) {
        for (int i = tid; i < 257; i += NTHREADS) { const int rel = i - 128, n = rel < 0 ? -rel : rel;
            int large = 8 + (int)(logf((float)(n < 1 ? 1 : n) / 8.0f) / 2.772588722239781f * 8.0f); large = large > 15 ? 15 : large;
            const int bucket = (rel > 0 ? 16 : 0) + (n < 8 ? n : large);
            lut[i] = a.lut_src[bucket * 4 + h] * LOG2E; }
    }
    if (MODE == 2) { for (int i = tid; i < 465; i += NTHREADS) lut[i] = a.lut_src[h * 465 + i] * LOG2E; }
    bf16x8 qf[NQF];
    { const bf16_t* qp = a.Q + ((size_t)bh * SEQ + qrow) * DQK + 8 * hi;
#pragma unroll
      for (int d0 = 0; d0 < NQF; ++d0) qf[d0] = *(const bf16x8*)(qp + 16 * d0); }
    float mrun[NMAP], lrun[NMAP]; f32x16 o[NMAP][2];
#pragma unroll
    for (int mp = 0; mp < NMAP; ++mp) { mrun[mp] = -1e30f; lrun[mp] = 0.f; o[mp][0] = f32x16{}; o[mp][1] = f32x16{}; }
    const bf16_t* Kt = a.K + (size_t)kvh * NTILE * KT_ELEMS; const bf16_t* Vt = a.V + (size_t)kvh * NTILE * 4096;
#define ATT_ISSUE(t, slot) do { _Pragma("unroll") for (int j_ = 0; j_ < NPW; ++j_) { int p_ = w + 8 * j_; if (p_ >= NP) p_ -= 8; \
        if (p_ < NKP) glds16(Kt + (size_t)(t) * KT_ELEMS + p_ * 512 + lane * 8, lds + (slot) * SLOT + p_ * 1024); \
        else glds16(Vt + (size_t)(t) * 4096 + (p_ - NKP) * 512 + lane * 8, lds + (slot) * SLOT + SLOT_K + (p_ - NKP) * 1024); } } while (0)
    ATT_ISSUE(t_lo, 0);
    if (NT > 1) ATT_ISSUE(t_lo + 1, 1);
    int slot = 0;
    for (int i = 0; i < NT; ++i) {
        if (i + 1 < NT) { if constexpr (NPW == 2) asm volatile("s_waitcnt vmcnt(2)" ::: "memory"); else asm volatile("s_waitcnt vmcnt(3)" ::: "memory"); }
        else asm volatile("s_waitcnt vmcnt(0)" ::: "memory");
        asm volatile("s_waitcnt lgkmcnt(0)" ::: "memory"); __builtin_amdgcn_s_barrier(); asm volatile("" ::: "memory");
        if (i + 2 < NT) { const int s2 = slot >= 1 ? slot - 1 : 2; ATT_ISSUE(t_lo + i + 2, s2); }
        const int t = t_lo + i;
        if (MODE != 2 || (t >= my_lo && t < my_hi)) {
            const LAS unsigned char* ks = lds + slot * SLOT + hi * 1024 + r32 * 16;
            const LAS unsigned char* vs = lds + slot * SLOT + SLOT_K + hi * 1024 + r32 * 16;
#pragma unroll
            for (int mp = 0; mp < NMAP; ++mp) {
                f32x16 b0 = f32x16{}, b1 = f32x16{};
                if (MODE == 1) {
                    const int qw0 = qb * 256 + 32 * w, d_lo = 64 * t - (qw0 + 31), d_hi = 64 * t + 63 - qw0;
                    if (d_hi <= -128) { const float v = lut[0];
#pragma unroll
                        for (int r = 0; r < 16; ++r) { b0[r] = v; b1[r] = v; } }
                    else if (d_lo >= 128) { const float v = lut[256];
#pragma unroll
                        for (int r = 0; r < 16; ++r) { b0[r] = v; b1[r] = v; } }
                    else {
#pragma unroll
                        for (int r = 0; r < 16; ++r) { const int rel = 64 * t + crow(r, hi) - qrow; b0[r] = lut[iclamp(rel, -128, 128) + 128]; b1[r] = lut[iclamp(rel + 32, -128, 128) + 128]; } }
                }
                if (MODE == 2) {
                    const int qc = 32 * (w & 1) + r32, qs = iclamp(qc - 8, 0, 48), dr = t - myr + 7;
#pragma unroll
                    for (int r = 0; r < 16; ++r) { const int kc = crow(r, hi), kc2 = kc + 32;
                        const bool v1 = (kc >= qs) && (kc < qs + 16), v2 = (kc2 >= qs) && (kc2 < qs + 16);
                        b0[r] = v1 ? lut[dr * 31 + (kc - qc + 15)] : -1e30f; b1[r] = v2 ? lut[dr * 31 + (kc2 - qc + 15)] : -1e30f; }
                }
                f32x16 p0 = b0, p1 = b1;
#pragma unroll
                for (int d = 0; d < FPM; ++d) { const int d0 = mp * FPM + d;
                    const bf16x8 kf0 = *(const LAS bf16x8*)(ks + d0 * 2048), kf1 = *(const LAS bf16x8*)(ks + d0 * 2048 + 512);
                    p0 = __builtin_amdgcn_mfma_f32_32x32x16_bf16(kf0, qf[d0], p0, 0, 0, 0);
                    p1 = __builtin_amdgcn_mfma_f32_32x32x16_bf16(kf1, qf[d0], p1, 0, 0, 0); }
                float mx = fmaxf(p0[0], p1[0]);
#pragma unroll
                for (int r = 1; r < 16; ++r) mx = fmaxf(mx, fmaxf(p0[r], p1[r]));
                mx = fmaxf(mx, __shfl_xor(mx, 32));
                const float mn = fmaxf(mrun[mp], mx), alpha = __builtin_amdgcn_exp2f(mrun[mp] - mn);
                mrun[mp] = mn; float rsum = 0.f;
#pragma unroll
                for (int r = 0; r < 16; ++r) { p0[r] = __builtin_amdgcn_exp2f(p0[r] - mn); p1[r] = __builtin_amdgcn_exp2f(p1[r] - mn); rsum += p0[r] + p1[r]; }
                lrun[mp] = lrun[mp] * alpha + rsum;
                if (__any(alpha != 1.0f)) { o[mp][0] = o[mp][0] * alpha; o[mp][1] = o[mp][1] * alpha; }
                u32x4 pw[4];
#pragma unroll
                for (int j = 0; j < 4; ++j) { pw[0][j] = pk2(p0[2 * j], p0[2 * j + 1]); pw[1][j] = pk2(p0[8 + 2 * j], p0[9 + 2 * j]); pw[2][j] = pk2(p1[2 * j], p1[2 * j + 1]); pw[3][j] = pk2(p1[8 + 2 * j], p1[9 + 2 * j]); }
#pragma unroll
                for (int db = 0; db < 2; ++db)
#pragma unroll
                    for (int k4 = 0; k4 < 4; ++k4) { const bf16x8 vf = *(const LAS bf16x8*)(vs + k4 * 2048 + db * 512);
                        o[mp][db] = __builtin_amdgcn_mfma_f32_32x32x16_bf16(vf, __builtin_bit_cast(bf16x8, pw[k4]), o[mp][db], 0, 0, 0); }
            }
        }
        slot = slot == 2 ? 0 : slot + 1;
    }
#undef ATT_ISSUE
#pragma unroll
    for (int mp = 0; mp < NMAP; ++mp) lrun[mp] += __shfl_xor(lrun[mp], 32);
    f32x16 val[2];
    if (MODE == 1) {
        float s1 = 0.f, s2 = 0.f;
        for (int i = 0; i < 32; ++i) { s1 += a.lam_src[i] * a.lam_src[32 + i]; s2 += a.lam_src[64 + i] * a.lam_src[96 + i]; }
        const float lam = expf(s1) - expf(s2) + a.lam_init;
        const float i0 = 1.0f / lrun[0], i1 = lam / lrun[NMAP - 1];
        val[0] = o[0][0] * i0 - o[NMAP - 1][0] * i1; val[1] = o[0][1] * i0 - o[NMAP - 1][1] * i1;
        float s = 0.f;
#pragma unroll
        for (int r = 0; r < 16; ++r) s += val[0][r] * val[0][r] + val[1][r] * val[1][r];
        s += __shfl_xor(s, 32);
        const float rn = 1.0f / sqrtf(s * (1.0f / 64.0f) + EPS);
        val[0] = val[0] * rn; val[1] = val[1] * rn;
    } else { const float i0 = 1.0f / lrun[0]; val[0] = o[0][0] * i0; val[1] = o[0][1] * i0; }
    bf16_t* yp = a.Y + ((size_t)(b * SEQ + qrow)) * DM + a.ycol + h * 64 + 4 * hi;
#pragma unroll
    for (int db = 0; db < 2; ++db)
#pragma unroll
        for (int g = 0; g < 4; ++g) { u32x2 wv; wv.x = pk2(val[db][4 * g], val[db][4 * g + 1]); wv.y = pk2(val[db][4 * g + 2], val[db][4 * g + 3]); *(u32x2*)(yp + 32 * db + 8 * g) = wv; }
    asm volatile("s_waitcnt lgkmcnt(0)" ::: "memory"); __builtin_amdgcn_s_barrier(); asm volatile("" ::: "memory");
}
}

__device__ __forceinline__ void attention_phase(const Ctx& c, int l) {
    bf16_t* Y = c.wsb(WS_R);
    for (int u = c.bid; u < 1024; u += c.G) {
        const int type = u >> 8, v = u & 255, bh = v & 7, qb = v >> 3;
        int tid_u = c.tid; asm volatile("" : "+v"(tid_u));
        if (type == 0 && EN(8)) { att::Args a{c.wsb(WS_QC), c.wsb(WS_KC), c.wsb(WS_VC), Y, 512, 0, 4, c.kp->in[I_T5], c.kp->in[I_DLAM] + l * 128, lambda_init(l)}; att::unit<1, 64>(a, bh, qb, c.lds, tid_u); }
        else if (type == 1 && EN(9)) { att::Args a{c.wsb(WS_QB), c.wsb(WS_KB), c.wsb(WS_VB), Y, 256, 0, 4, nullptr, nullptr, 0.f}; att::unit<0, 96>(a, bh, qb, c.lds, tid_u); }
        else if (type == 2 && EN(10)) { att::Args a{c.wsb(WS_QD), c.wsb(WS_KD), c.wsb(WS_VD), Y, 768, 1, 2, nullptr, nullptr, 0.f}; att::unit<0, 64>(a, bh, qb, c.lds, tid_u); }
        else if (type == 3 && EN(11)) { att::Args a{c.wsb(WS_QA), c.wsb(WS_KA), c.wsb(WS_VA), Y, 0, 0, 4, c.kp->in[I_NARPB] + l * 4 * 465, nullptr, 0.f}; att::unit<2, 64>(a, bh, qb, c.lds, tid_u); }
    }
}

__device__ __forceinline__ void ynorm_phase(const Ctx& c) {
    const int gw = c.bid * NWAVES + c.wave, NGW = c.G * NWAVES; bf16_t* Y = c.wsb(WS_R);
    for (int row = gw; row < MROWS; row += NGW) {
        u32x4* yr = (u32x4*)(Y + (size_t)row * DM + c.lane * 16);
        const u32x4 u0 = yr[0], u1 = yr[1]; float v[16]; unpack8(u0, v); unpack8(u1, v + 8);
        float s = 0.f;
#pragma unroll
        for (int j = 0; j < 16; ++j) s += v[j] * v[j];
        s += __shfl_xor(s, 1); s += __shfl_xor(s, 2); s += __shfl_xor(s, 4); s += __shfl_xor(s, 8);
        const float rs = 1.0f / sqrtf(s * (1.0f / 256.0f) + EPS);
        if ((c.lane >> 4) != 2) {
#pragma unroll
            for (int j = 0; j < 16; ++j) v[j] *= rs;
            yr[0] = pack8(v); yr[1] = pack8(v + 8);
        }
    }
}
__device__ __forceinline__ void final_phase(const Ctx& c) {
    const int gw = c.bid * NWAVES + c.wave, NGW = c.G * NWAVES; float* X = c.kp->out; const float* ss3 = c.ssp(2); const float* gf = c.kp->in[I_FINN] + DM;
    for (int row = gw; row < MROWS; row += NGW) {
        const float rs = 1.0f / sqrtf(pg8::sum16(ss3 + (size_t)row * 16) * (1.0f / DM) + EPS);
        f32x4* xr = (f32x4*)(X + (size_t)row * DM) + c.lane;
#pragma unroll
        for (int j = 0; j < 4; ++j) { const f32x4 g = *((const f32x4*)gf + c.lane + 64 * j); xr[64 * j] = xr[64 * j] * g * rs; }
    }
}

constexpr int N_PHASES = 21;
__device__ __forceinline__ void run_kind(const Ctx& c, int kind, int l) {
    using namespace pg8;
    const int G = c.G, bid = c.bid;
    switch (kind) {
        case 0: case 7: if (EN(0)) {
            const bool second = kind == 7;
            Gemm g{c.wsb(WS_XB), c.wsb(second ? WS_WGU2 : WS_WGU1), MROWS, 2 * DFF, DM}; StaticOrder S; S.init(MROWS, 2 * DFF, G, bid);
            RowScale rsc; if (second) { rsc.ss1 = nullptr; rsc.ssp = c.ssp(1); rsc.ssgp = nullptr; } else if (l == 0) { rsc.ss1 = c.ss0(); rsc.ssp = nullptr; rsc.ssgp = nullptr; } else { rsc.ss1 = nullptr; rsc.ssp = c.ssp(2); rsc.ssgp = c.ssp(3); }
            EpiSwiGLU E{c.wsb(WS_R), rsc};
            gemm_phase<EpiSwiGLU, StaticOrder, true, true>(c.lds, g, S, E, c.tid);
        } break;
        case 1: case 8: if (EN(1)) {
            const bool second = kind == 8;
            Gemm g{c.wsb(WS_R), c.wsb(second ? WS_WD2 : WS_WD1), MROWS, DM, DFF}; StaticOrder S; S.init(MROWS, DM, G, bid);
            EpiResid E;
            E.alpha = 0.5f; E.out = c.kp->out; E.outb = c.wsb(WS_XB);
            if (second) { E.base = c.kp->out; E.bss = nullptr; E.bg = nullptr; E.ss_out = c.ssp(2); E.gf = c.kp->in[I_FINN] + l * DM; E.ssg_out = c.ssp(3); }
            else { E.ss_out = c.ssp(0); E.gf = nullptr; E.ssg_out = nullptr;
                   if (l == 0) { E.base = c.kp->in[I_X]; E.bss = nullptr; E.bg = nullptr; } else { E.base = c.kp->out; E.bss = c.ssp(2); E.bg = c.kp->in[I_FINN] + (l - 1) * DM; } }
            gemm_phase<EpiResid, StaticOrder, true, true>(c.lds, g, S, E, c.tid);
        } break;
        case 2: if (EN(2)) {
            Gemm g{c.wsb(WS_XB), c.wsb(WS_WIN), MROWS, NIN, DM}; StaticOrder S; S.init(MROWS, NIN, G, bid);
            RowScale rsc{nullptr, c.ssp(0), nullptr};
            EpiScaleBf16 E{c.wsb(WS_R), NIN, rsc};
            gemm_phase<EpiScaleBf16, StaticOrder, true, true>(c.lds, g, S, E, c.tid);
        } break;
        case 3: if (EN(3)) for (int T = bid; T < MROWS / 64; T += G) prep_unit(c, l, T); break;
        case 4: if (EN(4)) attention_phase(c, l); break;
        case 5: if (EN(5)) ynorm_phase(c); break;
        case 6: if (EN(6)) {
            Gemm g{c.wsb(WS_R), c.wsb(WS_WOUT), MROWS, DM, DM}; StaticOrder S; S.init(MROWS, DM, G, bid);
            EpiResid E; E.base = c.kp->out; E.bss = nullptr; E.bg = nullptr; E.alpha = 1.0f; E.out = c.kp->out; E.outb = c.wsb(WS_XB); E.ss_out = c.ssp(1); E.gf = nullptr; E.ssg_out = nullptr;
            gemm_phase<EpiResid, StaticOrder, true, true>(c.lds, g, S, E, c.tid);
        } break;
        default: break;
    }
}

__global__ void __launch_bounds__(NTHREADS, 2) fwd_megakernel(Params p) {
    extern __shared__ __attribute__((aligned(16))) unsigned char lds_raw[];
    cg::grid_group grid = cg::this_grid();
    const int ph_lo = p.ph_lo, ph_hi = p.ph_hi;
    const int wave_id = __builtin_amdgcn_readfirstlane((int)threadIdx.x >> 6);
    for (int ph = ph_lo; ph < ph_hi; ++ph) {
        if (ph > ph_lo) grid.sync();
        KParams kp = (KParams)__builtin_amdgcn_kernarg_segment_ptr();
        asm volatile("" : "+s"(kp));
        int lane_; asm volatile("v_mbcnt_lo_u32_b32 %0, -1, 0\n\tv_mbcnt_hi_u32_b32 %0, -1, %0" : "=v"(lane_));
        int tid_ = wave_id * 64 + lane_, bid_ = blockIdx.x, G_ = gridDim.x; unsigned lds_ = (unsigned)(uintptr_t)(LAS unsigned char*)lds_raw;
        asm volatile("" : "+v"(tid_)); asm volatile("" : "+s"(bid_)); asm volatile("" : "+s"(G_)); asm volatile("" : "+s"(lds_));
        Ctx c; c.kp = kp; c.lds = (LAS unsigned char*)(uintptr_t)lds_; c.tid = tid_; c.lane = c.tid & 63; c.wave = __builtin_amdgcn_readfirstlane(c.tid >> 6); c.G = G_; c.bid = bid_;
        if (ph == 0) { if (EN(16)) prologue(c); }
        else if (ph == 10) { if (EN(18)) wconv_layer(c, 1); }
        else if (ph == 20) { if (EN(17)) final_phase(c); }
        else { const int l = ph > 10 ? 1 : 0; run_kind(c, ph - 1 - 10 * l, l); }
    }
}

extern "C" void kernel_launch(void* const* d_in, const int* in_sizes, int n_in, void* d_out, int out_size, void* d_ws, size_t ws_size, hipStream_t stream) {
    static int grid = 0;
    if (grid == 0) {
        if (n_in != 32 || out_size != MROWS * DM || ws_size < WS_END) { fprintf(stderr, "kernel_launch: unexpected shapes (n_in %d, out %d, ws %zu)\n", n_in, out_size, ws_size); grid = -1; return; }
        int dev = 0, cus = 0, per_cu = 0;
        hipGetDevice(&dev); hipDeviceGetAttribute(&cus, hipDeviceAttributeMultiprocessorCount, dev);
        hipFuncSetAttribute((const void*)fwd_megakernel, hipFuncAttributeMaxDynamicSharedMemorySize, LDS_BYTES);
        hipOccupancyMaxActiveBlocksPerMultiprocessor(&per_cu, (const void*)fwd_megakernel, NTHREADS, LDS_BYTES);
        if (per_cu < 1) { fprintf(stderr, "kernel_launch: occupancy query says %d blocks per CU\n", per_cu); per_cu = 1; }
        (void)hipGetLastError();
        grid = cus * 1;
    }
    if (grid < 0) return;
    Params p{};
    for (int i = 0; i < 32; ++i) p.in[i] = (const float*)d_in[i];
    p.out = (float*)d_out; p.ws = (unsigned char*)d_ws;
#if MK_SPLIT
    for (int ph = 0; ph < N_PHASES; ++ph) {
        p.ph_lo = ph; p.ph_hi = ph + 1; void* args[] = {&p};
        hipError_t e = hipLaunchCooperativeKernel((const void*)fwd_megakernel, dim3(grid), dim3(NTHREADS), args, LDS_BYTES, stream);
        if (e != hipSuccess) { fprintf(stderr, "cooperative launch failed: %s (grid %d)\n", hipGetErrorString(e), grid); break; }
    }
#else
    p.ph_lo = 0; p.ph_hi = N_PHASES; void* args[] = {&p};
    hipError_t e = hipLaunchCooperativeKernel((const void*)fwd_megakernel, dim3(grid), dim3(NTHREADS), args, LDS_BYTES, stream);
    if (e != hipSuccess) fprintf(stderr, "cooperative launch failed: %s (grid %d)\n", hipGetErrorString(e), grid);
#endif
}
```

```cpp
#include <hip/hip_runtime.h>
#include <hip/hip_cooperative_groups.h>
#include <cstdio>
#include <cstdint>
namespace cg = cooperative_groups;

#ifndef MK_ENABLE
#define MK_ENABLE 0xFFFFFF
#endif
#define EN(k) ((MK_ENABLE >> (k)) & 1)
#ifndef MK_DUP
#define MK_DUP -1
#endif
#ifndef MK_SPLIT
#define MK_SPLIT 0
#endif

#define LAS __attribute__((address_space(3)))
typedef unsigned short bf16_t;
typedef short bf16x8 __attribute__((ext_vector_type(8)));
typedef float f32x4 __attribute__((ext_vector_type(4)));
typedef float f32x16 __attribute__((ext_vector_type(16)));
typedef unsigned u32x4 __attribute__((ext_vector_type(4)));
typedef unsigned u32x2 __attribute__((ext_vector_type(2)));
typedef float f32x2_t __attribute__((ext_vector_type(2)));
typedef __bf16 bf16x2_t __attribute__((ext_vector_type(2)));

constexpr int BATCH = 2, SEQ = 8192, DM = 1024, MROWS = BATCH * SEQ, DFF = 2816, NIN = 2560, NTILE = SEQ / 64, DEPTH = 2;
constexpr float EPS = 1e-6f;
constexpr float LOG2E = 1.4426950408889634f;
constexpr int NWAVES = 8, NTHREADS = 512;

constexpr size_t MiB = 1u << 20;
constexpr size_t WS_SS0 = 65536;
constexpr size_t WS_SSP = 252 * MiB;
constexpr size_t WS_TAB = 1 * MiB;
constexpr size_t WS_WGU1 = 3 * MiB, WS_WD1 = 14 * MiB, WS_WIN = 19 * MiB + 512 * 1024, WS_WOUT = 24 * MiB + 512 * 1024, WS_WGU2 = 26 * MiB + 512 * 1024, WS_WD2 = 37 * MiB + 512 * 1024;
constexpr size_t WS_WUQ = 43 * MiB, WS_WUKV = 43 * MiB + 256 * 1024;
constexpr size_t WS_XB = 44 * MiB;
constexpr size_t WS_R = 76 * MiB;
constexpr size_t WS_QA = 156 * MiB, WS_KA = 164 * MiB, WS_VA = 172 * MiB, WS_QB = 180 * MiB, WS_KB = 192 * MiB, WS_VB = 204 * MiB;
constexpr size_t WS_QC = 212 * MiB, WS_KC = 220 * MiB, WS_VC = 228 * MiB, WS_QD = 236 * MiB, WS_KD = 244 * MiB, WS_VD = 248 * MiB, WS_END = 256 * MiB;
constexpr int LDS_BYTES = 147456;
constexpr int LDS_MISC = LDS_BYTES - 64;
constexpr size_t WS_BAR = 0, BAR_ZERO_BYTES = 16384;

__device__ __forceinline__ unsigned pk2(float lo, float hi) { f32x2_t v = {lo, hi}; bf16x2_t b = __builtin_convertvector(v, bf16x2_t); return __builtin_bit_cast(unsigned, b); }
__device__ __forceinline__ float bf2f(unsigned short u) { return __uint_as_float(((unsigned)u) << 16); }
__device__ __forceinline__ void unpack8(const u32x4 u, float* v) {
    v[0] = __uint_as_float(u.x << 16); v[1] = __uint_as_float(u.x & 0xffff0000u); v[2] = __uint_as_float(u.y << 16); v[3] = __uint_as_float(u.y & 0xffff0000u);
    v[4] = __uint_as_float(u.z << 16); v[5] = __uint_as_float(u.z & 0xffff0000u); v[6] = __uint_as_float(u.w << 16); v[7] = __uint_as_float(u.w & 0xffff0000u);
}
__device__ __forceinline__ u32x4 pack8(const float* v) { u32x4 u; u.x = pk2(v[0], v[1]); u.y = pk2(v[2], v[3]); u.z = pk2(v[4], v[5]); u.w = pk2(v[6], v[7]); return u; }
__device__ __forceinline__ float wave_sum(float v) {
#pragma unroll
    for (int o = 1; o < 64; o <<= 1) v += __shfl_xor(v, o);
    return v;
}

namespace pg8 {
constexpr int BM = 256, BK = 64, HALF = 128, HTB = HALF * BK * 2, STAGE_BYTES = 8 * HTB, NXCD = 8, WGM = 8;
__host__ __device__ __forceinline__ int lds_byte(int r, int c) { const int st = (r >> 4) * 2 + (c >> 5), rr = r & 15, cc = c & 31, ob = rr * 64 + cc * 2; return st * 1024 + (ob ^ (((ob >> 9) & 1) << 5)); }
__host__ __device__ __forceinline__ void stage_rc(int b, int& R, int& C) { const int st = b / 1024, sb = b % 1024, swz = sb ^ (((sb >> 9) & 1) << 5); R = (st >> 1) * 16 + swz / 64; C = (st & 1) * 32 + (swz % 64) / 2; }
__host__ __device__ __forceinline__ int perm32(int rho) { const int n = rho >> 4, i = rho & 15; return 8 * (i >> 2) + 4 * n + (i & 3); }
struct Unit { int pm, pn; };
struct Gemm { const bf16_t* A; const bf16_t* Bt; int M, N, K; };
struct StaticOrder {
    int nM, nN, nwg, G, c;
    __host__ __device__ void init(int M, int N, int G_, int c_) { nM = M / BM; nN = N / BM; nwg = nM * nN; G = G_; c = c_; }
    __host__ __device__ bool next(int i, Unit& u) const {
        const long L = (long)i * G + c; if (L >= nwg) return false;
        int wgid = (int)L; { const int q = nwg / NXCD, r = nwg % NXCD, xcd = wgid % NXCD, off = wgid / NXCD; wgid = (xcd < r ? xcd * (q + 1) : r * (q + 1) + (xcd - r) * q) + off; }
        const int nig = WGM * nN, gid = wgid / nig, fm = gid * WGM, gsz = (nM - fm) < WGM ? (nM - fm) : WGM;
        u.pm = fm + ((wgid % nig) % gsz); u.pn = (wgid % nig) / gsz; return true;
    }
    __device__ __forceinline__ void a_ready(const Unit&) const {}
    __device__ __forceinline__ void done(const Unit&) const {}
};

__device__ __forceinline__ float sum16(const float* p) {
    const f32x4 a = *(const f32x4*)p, b = *(const f32x4*)(p + 4), c = *(const f32x4*)(p + 8), d = *(const f32x4*)(p + 12);
    return (((a[0] + a[1]) + (a[2] + a[3])) + ((b[0] + b[1]) + (b[2] + b[3]))) + (((c[0] + c[1]) + (c[2] + c[3])) + ((d[0] + d[1]) + (d[2] + d[3])));
}
struct RowScale {
    const float* ss1; const float* ssp; const float* ssgp;
    __device__ __forceinline__ float get(int row) const {
        const float s = ss1 ? ss1[row] : sum16(ssp + (size_t)row * 16);
        float rs = 1.0f / sqrtf(s * (1.0f / DM) + EPS);
        if (ssgp) { const float rsn = 1.0f / sqrtf(rs * rs * sum16(ssgp + (size_t)row * 16) * (1.0f / DM) + EPS); rs *= rsn; }
        return rs;
    }
};

struct EpiSwiGLU {
    static constexpr bool PERM = true, AFTER_DRAIN = false;
    bf16_t* O; RowScale rsc;
    __device__ __forceinline__ void operator()(const f32x4 (&acc)[2][2][4][2], const Unit& u, int wr, int wc, int fr, int fq) const {
        const int row0 = u.pm * BM + wr * 64 + fr, col0 = u.pn * HALF + wc * 32 + 8 * fq;
#pragma unroll
        for (int ai = 0; ai < 2; ++ai)
#pragma unroll
            for (int m = 0; m < 4; ++m) {
                const int row = row0 + ai * HALF + m * 16; const float rs = rsc.get(row);
                float a[8];
#pragma unroll
                for (int n = 0; n < 2; ++n)
#pragma unroll
                    for (int i = 0; i < 4; ++i) {
                        const float g = acc[ai][0][m][n][i] * rs, up = acc[ai][1][m][n][i] * rs;
                        const float sg = g * __builtin_amdgcn_rcpf(1.0f + __builtin_amdgcn_exp2f(-g * LOG2E));
                        a[n * 4 + i] = sg * up;
                    }
                *(u32x4*)(O + (size_t)row * DFF + col0) = pack8(a);
            }
    }
};
struct EpiScaleBf16 {
    static constexpr bool PERM = true, AFTER_DRAIN = false;
    bf16_t* O; int ldo; RowScale rsc;
    __device__ __forceinline__ void operator()(const f32x4 (&acc)[2][2][4][2], const Unit& u, int wr, int wc, int fr, int fq) const {
        const int row0 = u.pm * BM + wr * 64 + fr, col0 = u.pn * BM + wc * 32 + 8 * fq;
#pragma unroll
        for (int ai = 0; ai < 2; ++ai)
#pragma unroll
            for (int m = 0; m < 4; ++m) {
                const int row = row0 + ai * HALF + m * 16; const float rs = rsc.get(row);
#pragma unroll
                for (int bj = 0; bj < 2; ++bj) {
                    float a[8];
#pragma unroll
                    for (int n = 0; n < 2; ++n)
#pragma unroll
                        for (int i = 0; i < 4; ++i) a[n * 4 + i] = acc[ai][bj][m][n][i] * rs;
                    *(u32x4*)(O + (size_t)row * ldo + col0 + bj * HALF) = pack8(a);
                }
            }
    }
};
struct EpiResid {
    static constexpr bool PERM = false, AFTER_DRAIN = false;
    const float* base; const float* bss; const float* bg; float alpha; float* out; bf16_t* outb; float* ss_out; const float* gf; float* ssg_out;
    __device__ __forceinline__ void operator()(const f32x4 (&acc)[2][2][4][2], const Unit& u, int wr, int wc, int fr, int fq) const {
        const int row0 = u.pm * BM + wr * 64 + fr, col0 = u.pn * BM + wc * 32 + 4 * fq;
#pragma unroll
        for (int ai = 0; ai < 2; ++ai)
#pragma unroll
            for (int m = 0; m < 4; ++m) {
                const int row = row0 + ai * HALF + m * 16; const size_t off = (size_t)row * DM + col0;
                float brs = 1.0f; if (bss) brs = 1.0f / sqrtf(sum16(bss + (size_t)row * 16) * (1.0f / DM) + EPS);
                float s = 0.f, sg = 0.f;
#pragma unroll
                for (int bj = 0; bj < 2; ++bj)
#pragma unroll
                    for (int n = 0; n < 2; ++n) {
                        const int co = bj * HALF + n * 16;
                        f32x4 b = *(const f32x4*)(base + off + co);
                        if (bss) { const f32x4 g = *(const f32x4*)(bg + col0 + co); b = b * g * brs; }
                        const f32x4 v = b + acc[ai][bj][m][n] * alpha;
                        *(f32x4*)(out + off + co) = v;
                        u32x2 w; w.x = pk2(v[0], v[1]); w.y = pk2(v[2], v[3]); *(u32x2*)(outb + off + co) = w;
                        s += (v[0] * v[0] + v[1] * v[1]) + (v[2] * v[2] + v[3] * v[3]);
                        if (gf) { const f32x4 g2 = *(const f32x4*)(gf + col0 + co); const f32x4 t = v * g2; sg += (t[0] * t[0] + t[1] * t[1]) + (t[2] * t[2] + t[3] * t[3]); }
                    }
                s += __shfl_xor(s, 16); s += __shfl_xor(s, 32);
                if (fq == 0) ss_out[(size_t)row * 16 + u.pn * 4 + wc] = s;
                if (gf) { sg += __shfl_xor(sg, 16); sg += __shfl_xor(sg, 32); if (fq == 0) ssg_out[(size_t)row * 16 + u.pn * 4 + wc] = sg; }
            }
    }
};

template <class Epi, class Sched, bool ALIGN_EPI = false, bool SP2 = false>
__device__ __forceinline__ void gemm_phase(LAS unsigned char* lds, const Gemm g, const Sched& S, const Epi& E, const int tid) {
    const int wid = __builtin_amdgcn_readfirstlane(tid >> 6), lane = tid & 63, wr = wid >> 2, wc = wid & 3, fr = lane & 15, fq = lane >> 4;
    const int K = g.K, nt = K / BK;
    unsigned voffA[2], voffB[2];
#pragma unroll
    for (int i = 0; i < 2; ++i) { int R, C; stage_rc(tid * 16 + i * 8192, R, C); const int Rb = Epi::PERM ? ((R & ~31) + perm32(R & 31)) : R;
        voffA[i] = (unsigned)(R * K + C) * 2u; voffB[i] = (unsigned)(Rb * K + C) * 2u; }
    const size_t kstep = (size_t)(BK * 2);
    const size_t hstep = (size_t)HALF * K * 2;
    const size_t tstep = 2 * hstep;
    const unsigned ldsw = (unsigned)wid * 1024u;
    const int aoff = lds_byte(wr * 64 + fr, fq * 8), boff = lds_byte(wc * 32 + fr, fq * 8);
#define PG8_SA(b, h) (((b) * 2 + (h)) * HTB)
#define PG8_SB(b, h) ((4 + (b) * 2 + (h)) * HTB)
#define PG8_STAGE(bufoff, gbase, voff) do { _Pragma("unroll") for (int _i = 0; _i < 2; ++_i) \
        __builtin_amdgcn_global_load_lds((const unsigned*)((const char*)(gbase) + (voff)[_i]), (LAS unsigned*)(lds + (bufoff) + ldsw + _i * 8192), 16, 0, 0); } while (0)
#define PG8_LDA(dst, b, h) do { _Pragma("unroll") for (int m = 0; m < 4; ++m) _Pragma("unroll") for (int k = 0; k < 2; ++k) dst[m][k] = *(const LAS bf16x8*)(lds + PG8_SA(b, h) + aoff + m * 2048 + k * 1024); } while (0)
#define PG8_LDB(dst, b, h) do { _Pragma("unroll") for (int n = 0; n < 2; ++n) _Pragma("unroll") for (int k = 0; k < 2; ++k) dst[n][k] = *(const LAS bf16x8*)(lds + PG8_SB(b, h) + boff + n * 2048 + k * 1024); } while (0)
#define PG8_MMA(ai, bj, At, Bt) do { __builtin_amdgcn_s_setprio(1); _Pragma("unroll") for (int m = 0; m < 4; ++m) _Pragma("unroll") for (int n = 0; n < 2; ++n) _Pragma("unroll") for (int k = 0; k < 2; ++k) \
        acc[ai][bj][m][n] = __builtin_amdgcn_mfma_f32_16x16x32_bf16(Bt[n][k], At[m][k], acc[ai][bj][m][n], 0, 0, 0); __builtin_amdgcn_s_setprio(0); } while (0)
#define PG8_WAIT_V(n) asm volatile("s_waitcnt vmcnt(" #n ")" ::: "memory")
#define PG8_WAIT_L(n) asm volatile("s_waitcnt lgkmcnt(" #n ")" ::: "memory")
#define PG8_BAR __builtin_amdgcn_s_barrier()
#define PG8_SCHED __builtin_amdgcn_sched_barrier(0)
    Unit cur, nxt; int ui = 0;
    if (!S.next(0, cur)) return;
    f32x4 acc[2][2][4][2];
#pragma unroll
    for (int a = 0; a < 2; ++a)
#pragma unroll
        for (int b = 0; b < 2; ++b)
#pragma unroll
            for (int m = 0; m < 4; ++m)
#pragma unroll
                for (int n = 0; n < 2; ++n) acc[a][b][m][n] = (f32x4){0.f, 0.f, 0.f, 0.f};
    bf16x8 At[4][2], B0[2][2], B1[2][2];
    const char* cA = (const char*)g.A + (size_t)cur.pm * tstep; const char* cB = (const char*)g.Bt + (size_t)cur.pn * tstep;
    S.a_ready(cur);
    if constexpr (SP2) {
        PG8_STAGE(PG8_SB(0, 0), cB, voffB); PG8_STAGE(PG8_SB(0, 1), cB + hstep, voffB); PG8_STAGE(PG8_SA(0, 0), cA, voffA); PG8_STAGE(PG8_SA(0, 1), cA + hstep, voffA);
        if (wr == 1) PG8_BAR;
        PG8_WAIT_V(2); PG8_BAR;
        PG8_STAGE(PG8_SB(1, 0), cB + kstep, voffB); PG8_STAGE(PG8_SA(1, 0), cA + kstep, voffA); PG8_STAGE(PG8_SB(1, 1), cB + hstep + kstep, voffB);
        PG8_WAIT_V(6); PG8_BAR;
    } else {
        PG8_STAGE(PG8_SB(0, 0), cB, voffB); PG8_STAGE(PG8_SA(0, 0), cA, voffA); PG8_STAGE(PG8_SB(0, 1), cB + hstep, voffB); PG8_STAGE(PG8_SA(0, 1), cA + hstep, voffA);
        if (wr == 1) PG8_BAR;
        PG8_WAIT_V(4); PG8_BAR;
        PG8_STAGE(PG8_SB(1, 0), cB + kstep, voffB); PG8_STAGE(PG8_SA(1, 0), cA + kstep, voffA); PG8_STAGE(PG8_SB(1, 1), cB + hstep + kstep, voffB);
        PG8_WAIT_V(6); PG8_BAR;
    }
    for (;;) {
        const bool has_next = S.next(ui + 1, nxt);
        const char* nA = has_next ? (const char*)g.A + (size_t)nxt.pm * tstep : cA; const char* nB = has_next ? (const char*)g.Bt + (size_t)nxt.pn * tstep : cB;
        for (int t = 0; t < nt; t += 2) {
            const bool last = (t == nt - 2);
            const char* a1 = cA + (size_t)(t + 1) * kstep;
            const char* a2 = last ? nA : cA + (size_t)(t + 2) * kstep; const char* b2 = last ? nB : cB + (size_t)(t + 2) * kstep;
            const char* a3 = a2 + kstep; const char* b3 = b2 + kstep;
            if (last && has_next) S.a_ready(nxt);
            if constexpr (SP2) {
            PG8_LDB(B0, 0, 0); PG8_LDB(B1, 0, 1); PG8_SCHED; PG8_LDA(At, 0, 0); PG8_STAGE(PG8_SA(1, 1), a1 + hstep, voffA);
            PG8_WAIT_V(8); PG8_WAIT_L(0); PG8_BAR; PG8_MMA(0, 0, At, B0); PG8_MMA(0, 1, At, B1); PG8_BAR; PG8_SCHED;
            PG8_LDA(At, 0, 1); PG8_STAGE(PG8_SB(0, 0), b2, voffB); PG8_STAGE(PG8_SB(0, 1), b2 + hstep, voffB); PG8_STAGE(PG8_SA(0, 0), a2, voffA);
            PG8_WAIT_V(8); PG8_WAIT_L(0); PG8_BAR; PG8_MMA(1, 0, At, B0); PG8_MMA(1, 1, At, B1); PG8_BAR; PG8_SCHED;
            PG8_LDB(B0, 1, 0); PG8_LDB(B1, 1, 1); PG8_SCHED; PG8_LDA(At, 1, 0); PG8_STAGE(PG8_SA(0, 1), a2 + hstep, voffA);
            PG8_WAIT_V(8); PG8_WAIT_L(0); PG8_BAR; PG8_MMA(0, 0, At, B0); PG8_MMA(0, 1, At, B1); PG8_BAR; PG8_SCHED;
            PG8_LDA(At, 1, 1); PG8_STAGE(PG8_SB(1, 0), b3, voffB); PG8_STAGE(PG8_SB(1, 1), b3 + hstep, voffB); PG8_STAGE(PG8_SA(1, 0), a3, voffA);
            PG8_WAIT_V(8); PG8_WAIT_L(0); PG8_BAR; PG8_MMA(1, 0, At, B0); PG8_MMA(1, 1, At, B1); PG8_BAR; PG8_SCHED;
            } else {
            PG8_LDB(B0, 0, 0); PG8_SCHED; PG8_LDA(At, 0, 0); PG8_STAGE(PG8_SA(1, 1), a1 + hstep, voffA);
            PG8_WAIT_L(8); PG8_BAR; PG8_WAIT_L(0); PG8_MMA(0, 0, At, B0); PG8_BAR; PG8_SCHED;
            PG8_LDB(B1, 0, 1); PG8_STAGE(PG8_SB(0, 0), b2, voffB);
            PG8_BAR; PG8_WAIT_L(0); PG8_MMA(0, 1, At, B1); PG8_BAR;
            PG8_LDA(At, 0, 1); PG8_STAGE(PG8_SA(0, 0), a2, voffA);
            PG8_BAR; PG8_WAIT_L(0); PG8_MMA(1, 0, At, B0); PG8_BAR; PG8_SCHED;
            PG8_STAGE(PG8_SB(0, 1), b2 + hstep, voffB);
            PG8_WAIT_V(6); PG8_BAR; PG8_MMA(1, 1, At, B1); PG8_BAR;
            PG8_LDB(B0, 1, 0); PG8_SCHED; PG8_LDA(At, 1, 0); PG8_STAGE(PG8_SA(0, 1), a2 + hstep, voffA);
            PG8_WAIT_L(8); PG8_BAR; PG8_WAIT_L(0); PG8_MMA(0, 0, At, B0); PG8_BAR; PG8_SCHED;
            PG8_LDB(B1, 1, 1); PG8_STAGE(PG8_SB(1, 0), b3, voffB);
            PG8_BAR; PG8_WAIT_L(0); PG8_MMA(0, 1, At, B1); PG8_BAR;
            PG8_LDA(At, 1, 1); PG8_STAGE(PG8_SA(1, 0), a3, voffA);
            PG8_BAR; PG8_WAIT_L(0); PG8_MMA(1, 0, At, B0); PG8_BAR; PG8_SCHED;
            PG8_STAGE(PG8_SB(1, 1), b3 + hstep, voffB);
            PG8_WAIT_V(6); PG8_BAR; PG8_MMA(1, 1, At, B1); PG8_BAR;
            }
        }
        if constexpr (ALIGN_EPI) { if (wr == 0) PG8_BAR; }
        if constexpr (!Epi::AFTER_DRAIN) { E(acc, cur, wr, wc, fr, fq); S.done(cur); }
        if (!has_next) break;
#pragma unroll
        for (int a = 0; a < 2; ++a)
#pragma unroll
            for (int b = 0; b < 2; ++b)
#pragma unroll
                for (int m = 0; m < 4; ++m)
#pragma unroll
                    for (int n = 0; n < 2; ++n) acc[a][b][m][n] = (f32x4){0.f, 0.f, 0.f, 0.f};
        cur = nxt; cA = nA; cB = nB; ++ui;
        if constexpr (ALIGN_EPI) { if (wr == 1) PG8_BAR; }
    }
    PG8_WAIT_V(0);
    if constexpr (!ALIGN_EPI) { if (wr == 0) PG8_BAR; }
    PG8_BAR;
#undef PG8_SA
#undef PG8_SB
#undef PG8_STAGE
#undef PG8_LDA
#undef PG8_LDB
#undef PG8_MMA
#undef PG8_WAIT_V
#undef PG8_WAIT_L
#undef PG8_BAR
#undef PG8_SCHED
}
}

#define RLX_AGENT __ATOMIC_RELAXED, __HIP_MEMORY_SCOPE_AGENT
#define XB_TMO      128
#define XB_XCNT(j)  (256  + 64 * (j))
#define XB_XSUB(j)  (1280 + 64 * (j))
#define XB_XGEN(j)  (2304 + 64 * (j))
#define XB_TOP      3328
#define XB_TOPGEN   3392
#define XCD_BAR_WORDS 3456
#define XB_SPIN_CAP (1u << 20)

__device__ __forceinline__ unsigned xb_ld(unsigned* p)              { return __hip_atomic_load(p, __ATOMIC_RELAXED, __HIP_MEMORY_SCOPE_AGENT); }
__device__ __forceinline__ unsigned xb_add(unsigned* p, unsigned v) { return __hip_atomic_fetch_add(p, v, __ATOMIC_RELAXED, __HIP_MEMORY_SCOPE_AGENT); }
__device__ __forceinline__ unsigned xb_xcc_id() { return (unsigned)__builtin_amdgcn_s_getreg((3 << 11) | 20) & 0xFu; }
#define XB_SPIN(cond, bar) do { unsigned _sp = 0; while (cond) { __builtin_amdgcn_s_sleep(1); \
    if ((++_sp & 255u) == 0u) { if (xb_ld(&(bar)[XB_TMO])) break; if (_sp > XB_SPIN_CAP) { atomicAdd(&(bar)[XB_TMO], 1u); break; } } } } while (0)

struct XcdBarrier {
    unsigned* bar; unsigned x;
    volatile LAS unsigned* st;
};

__device__ __forceinline__ XcdBarrier xcd_barrier_post(unsigned* bar, volatile LAS unsigned* st) {
    XcdBarrier b; b.bar = bar; b.x = xb_xcc_id(); b.st = st;
    if (threadIdx.x == 0) (void)xb_add(&bar[XB_XCNT(b.x)], 1u);
    return b;
}
__device__ __forceinline__ void xcd_barrier_complete(unsigned* bar, unsigned x, unsigned& nloc, unsigned& nx) {
    const unsigned G = gridDim.x * gridDim.y * gridDim.z;
    unsigned sum, cnt, mine, sp = 0u;
    for (;;) {
        sum = 0u; cnt = 0u; mine = 0u;
#pragma unroll
        for (unsigned j = 0; j < 16; ++j) { const unsigned c = xb_ld(&bar[XB_XCNT(j)]); sum += c; cnt += (c > 0u) ? 1u : 0u; mine = (j == x) ? c : mine; }
        if (sum == G) break;
        __builtin_amdgcn_s_sleep(1);
        if ((++sp & 255u) == 0u) { if (xb_ld(&bar[XB_TMO])) break; if (sp > XB_SPIN_CAP) { atomicAdd(&bar[XB_TMO], 1u); break; } }
    }
    nloc = mine > 0u ? mine : 1u; nx = cnt > 0u ? cnt : 1u;
}

__device__ __forceinline__ void xcd_barrier(const XcdBarrier& b) {
    asm volatile("s_waitcnt vmcnt(0)" ::: "memory");
    __syncthreads();
    if (threadIdx.x == 0) {
        unsigned* bar = b.bar;
        __builtin_amdgcn_s_waitcnt(0);
        unsigned nloc = b.st[0], nx = b.st[1];
        if (nloc == 0u) { xcd_barrier_complete(bar, b.x, nloc, nx); b.st[0] = nloc; b.st[1] = nx; }
        const unsigned old = xb_add(&bar[XB_XSUB(b.x)], 1u);
        const unsigned gen = old / nloc;
        if (old + 1u == (gen + 1u) * nloc) {
            __builtin_amdgcn_fence(__ATOMIC_RELEASE, "agent");
            asm volatile("s_waitcnt vmcnt(0)" ::: "memory");
            const unsigned og = xb_add(&bar[XB_TOP], 1u);
            const unsigned tg = og / nx;
            if (og + 1u == (tg + 1u) * nx) xb_add(&bar[XB_TOPGEN], 1u);
            else XB_SPIN(xb_ld(&bar[XB_TOPGEN]) == tg, bar);
            __builtin_amdgcn_fence(__ATOMIC_ACQUIRE, "agent");
            xb_add(&bar[XB_XGEN(b.x)], 1u);
            asm volatile("s_waitcnt vmcnt(0)" ::: "memory");
        } else {
            XB_SPIN(xb_ld(&bar[XB_XGEN(b.x)]) == gen, bar);
            __builtin_amdgcn_fence(__ATOMIC_ACQUIRE, "agent");
            asm volatile("s_waitcnt vmcnt(0)" ::: "memory");
        }
    }
    __syncthreads();
}


struct Params { const float* in[32]; float* out; unsigned char* ws; int ph_lo, ph_hi; };
enum { I_X = 0, I_F1N, I_F1G, I_F1U, I_F1D, I_MIXN, I_WIN, I_NAQN, I_NAKN, I_NARPB, I_NABETA, I_MLAQLN, I_MLAWUQ, I_MLAKVLN, I_MLAWUKV, I_MLAQN, I_MLAKN, I_MLABETA,
       I_DQN, I_DKN, I_DLAM, I_DSUBLN, I_GQN, I_GKN, I_GBETA, I_WOUT, I_F2N, I_F2G, I_F2U, I_F2D, I_FINN, I_T5 };
__host__ __device__ __forceinline__ float lambda_init(int l) { return l == 0 ? 0.2f : 0.35550906f; }

typedef const __attribute__((address_space(4))) Params* KParams;
typedef const float* const __attribute__((address_space(4)))* InPtr;
struct Ctx {
    KParams kp; LAS unsigned char* lds; int tid, lane, wave, G, bid;
    __device__ __forceinline__ float* ssp(int k) const { return (float*)(kp->ws + WS_SSP + (size_t)k * MiB); }
    __device__ __forceinline__ float* ss0() const { return (float*)(kp->ws + WS_SS0); }
    __device__ __forceinline__ bf16_t* wsb(size_t off) const { return (bf16_t*)(kp->ws + off); }
};

__device__ __forceinline__ float gain_for(const Ctx& c, int job, int l, int k) {
    InPtr in = c.kp->in;
    switch (job) {
        case 0: { float g = in[I_F1N][l * DM + k]; if (l > 0) g *= in[I_FINN][(l - 1) * DM + k]; return g; }
        case 2: return in[I_MIXN][l * DM + k];
        case 3: { const int gidx = k >> 8, kk = k & 255;
                  if (gidx == 0) return in[I_NABETA][l * 256 + kk];
                  if (gidx == 1) return in[I_MLABETA][l * 256 + kk];
                  if (gidx == 2) return in[I_DSUBLN][l * 64 + (kk & 63)] * (1.0f - lambda_init(l));
                  return in[I_GBETA][l * 256 + kk]; }
        case 4: return in[I_F2N][l * DM + k];
        case 6: return in[I_MLAQLN][l * 256 + k];
        case 7: return in[I_MLAKVLN][l * 128 + k];
        default: return 1.0f;
    }
}
__device__ __forceinline__ void tr_item64(const Ctx& c, const float* W0, const float* W1, int Nsrc, int sc0, int sc1, bf16_t* WT, int K, int n0, int k0, int job, int l, LAS float* scr) {
    const int lane = c.lane, hh = (lane & 15) >> 3, cc = 4 * (lane & 7);
    const float* W = hh ? W1 : W0; const int sc = hh ? sc1 : sc0;
    f32x4 v[16];
#pragma unroll
    for (int i = 0; i < 16; ++i) { const int kk = 4 * i + (lane >> 4);
        v[i] = (f32x4){0.f, 0.f, 0.f, 0.f}; if (sc >= 0) v[i] = *(const f32x4*)(W + (size_t)(k0 + kk) * Nsrc + sc + cc); }
#pragma unroll
    for (int i = 0; i < 16; ++i) { const int kk = 4 * i + (lane >> 4); LAS float* d = scr + kk * 65 + 4 * (lane & 15);
        d[0] = v[i][0]; d[1] = v[i][1]; d[2] = v[i][2]; d[3] = v[i][3]; }
    asm volatile("s_waitcnt lgkmcnt(0)" ::: "memory");
    const int ch = lane & 7;
    float g[8];
#pragma unroll
    for (int i = 0; i < 8; ++i) g[i] = gain_for(c, job, l, k0 + 8 * ch + i);
#pragma unroll
    for (int j = 0; j < 8; ++j) { const int n = (lane >> 3) + 8 * j; const LAS float* s = scr + (8 * ch) * 65 + n;
        u32x4 o; o.x = pk2(s[0 * 65] * g[0], s[1 * 65] * g[1]); o.y = pk2(s[2 * 65] * g[2], s[3 * 65] * g[3]); o.z = pk2(s[4 * 65] * g[4], s[5 * 65] * g[5]); o.w = pk2(s[6 * 65] * g[6], s[7 * 65] * g[7]);
        *(u32x4*)(WT + (size_t)(n0 + n) * K + k0 + 8 * ch) = o; }
    asm volatile("s_waitcnt lgkmcnt(0)" ::: "memory");
}
__device__ __forceinline__ void wconv_layer(const Ctx& c, int l) {
    LAS float* scr = (LAS float*)(c.lds + c.wave * 16640);
    const int gw = c.bid * NWAVES + c.wave, NGW = c.G * NWAVES;
    constexpr int C0 = 16 * 88, C1 = 44 * 16, C2 = 16 * 40, C3 = 16 * 16, C6 = 4 * 6, C7 = 2 * 8;
    constexpr int NITEMS = 2 * C0 + 2 * C1 + C2 + C3 + C6 + C7;
    InPtr in = c.kp->in;
    for (int it = gw; it < NITEMS; it += NGW) {
        int r = it;
        if (r < C0 || (r >= C0 + C1 + C2 + C3 && r < 2 * C0 + C1 + C2 + C3)) {
            const bool second = r >= C0; if (second) r -= C0 + C1 + C2 + C3;
            const int nblk = 88, kb = r / nblk, nb = r % nblk, pn = nb >> 2, blk = nb & 3;
            const float* Wg = second ? in[I_F2G] : in[I_F1G]; const float* Wu = second ? in[I_F2U] : in[I_F1U];
            const float* W = (blk < 2 ? Wg : Wu) + (size_t)l * DM * DFF; const int sc = 128 * pn + 64 * (blk & 1);
            tr_item64(c, W, W, DFF, sc, sc + 32, c.wsb(second ? WS_WGU2 : WS_WGU1), DM, 64 * nb, 64 * kb, second ? 4 : 0, l, scr);
            continue;
        }
        r -= C0;
        if (r < C1) { const int kb = r / 16, nb = r % 16; const float* W = in[I_F1D] + (size_t)l * DFF * DM; tr_item64(c, W, W, DM, 64 * nb, 64 * nb + 32, c.wsb(WS_WD1), DFF, 64 * nb, 64 * kb, 1, l, scr); continue; }
        r -= C1;
        if (r < C2) { const int kb = r / 40, nb = r % 40, n0 = 64 * nb;
            const float* W = in[I_WIN] + (size_t)l * DM * 2464; int sc[2];
#pragma unroll
            for (int hh = 0; hh < 2; ++hh) { const int n = n0 + 32 * hh; sc[hh] = n < 1184 ? n : (n < 1280 ? -1 : n - 96); }
            tr_item64(c, W, W, 2464, sc[0], sc[1], c.wsb(WS_WIN), DM, n0, 64 * kb, 2, l, scr); continue; }
        r -= C2;
        if (r < C3) { const int kb = r / 16, nb = r % 16; const float* W = in[I_WOUT] + (size_t)l * DM * DM; tr_item64(c, W, W, DM, 64 * nb, 64 * nb + 32, c.wsb(WS_WOUT), DM, 64 * nb, 64 * kb, 3, l, scr); continue; }
        r -= C3; r -= C0;
        if (r < C1) { const int kb = r / 16, nb = r % 16; const float* W = in[I_F2D] + (size_t)l * DFF * DM; tr_item64(c, W, W, DM, 64 * nb, 64 * nb + 32, c.wsb(WS_WD2), DFF, 64 * nb, 64 * kb, 5, l, scr); continue; }
        r -= C1;
        if (r < C6) { const int kb = r / 6, nb = r % 6; const float* W = in[I_MLAWUQ] + (size_t)l * 256 * 384; tr_item64(c, W, W, 384, 64 * nb, 64 * nb + 32, c.wsb(WS_WUQ), 256, 64 * nb, 64 * kb, 6, l, scr); continue; }
        r -= C6;
        { const int kb = r / 8, nb = r % 8; const float* W = in[I_MLAWUKV] + (size_t)l * 128 * 512; tr_item64(c, W, W, 512, 64 * nb, 64 * nb + 32, c.wsb(WS_WUKV), 128, 64 * nb, 64 * kb, 7, l, scr); }
    }
}
__device__ __forceinline__ void prologue(const Ctx& c) {
    const int gt = c.bid * NTHREADS + c.tid, NGT = c.G * NTHREADS;
    for (int i = gt; i < SEQ * 16; i += NGT) {
        const int pos = i >> 4, fi = i & 15;
        const float inv = expf(-9.210340371976184f * (float)(2 * fi) / 32.0f);
        const float ang = (float)pos * inv;
        const double a = (double)ang * 0.15915494309189535;
        const double fr = a - rint(a);
        const float f = (float)fr;
        float2 cs; cs.x = __builtin_amdgcn_cosf(f); cs.y = __builtin_amdgcn_sinf(f);
        ((float2*)(c.kp->ws + WS_TAB))[i] = cs;
    }
    const int gw = c.bid * NWAVES + c.wave, NGW = c.G * NWAVES;
    const float* x = c.kp->in[I_X]; bf16_t* xb = c.wsb(WS_XB); float* ss0 = c.ss0();
    for (int row = gw; row < MROWS; row += NGW) {
        const f32x4* xr = (const f32x4*)(x + (size_t)row * DM) + c.lane; float s = 0.f;
#pragma unroll
        for (int j = 0; j < 4; ++j) { const f32x4 v = xr[64 * j]; s += (v[0] * v[0] + v[1] * v[1]) + (v[2] * v[2] + v[3] * v[3]);
            u32x2 w; w.x = pk2(v[0], v[1]); w.y = pk2(v[2], v[3]); *((u32x2*)(xb + (size_t)row * DM) + c.lane + 64 * j) = w; }
        s = wave_sum(s); if (c.lane == 0) ss0[row] = s;
    }
    wconv_layer(c, 0);
}

constexpr int PL_VS = 0, PL_CQ = 36864, PL_CKV = 70656, PL_KR = 88064, PL_RSQ = 96256, PL_RSKV = 96512;
__device__ __forceinline__ void vt_write(const Ctx& c, int nh, bf16_t* Vbase, int kvh0, int tt) {
    const LAS bf16_t* VS = (const LAS bf16_t*)(c.lds + PL_VS);
    const int kc = c.tid >> 6, d = c.tid & 63;
    for (int h = 0; h < nh; ++h) {
        unsigned short e[8];
#pragma unroll
        for (int j = 0; j < 8; ++j) { const int key = 16 * (kc >> 1) + 8 * (j >> 2) + 4 * (kc & 1) + (j & 3); e[j] = VS[(h * 64 + key) * 72 + d]; }
        u32x4 o; o.x = e[0] | ((unsigned)e[1] << 16); o.y = e[2] | ((unsigned)e[3] << 16); o.z = e[4] | ((unsigned)e[5] << 16); o.w = e[6] | ((unsigned)e[7] << 16);
        *(u32x4*)(Vbase + ((size_t)(kvh0 + h) * NTILE + tt) * 4096 + (kc * 64 + d) * 8) = o;
    }
}
__device__ __forceinline__ void prep_unit(const Ctx& c, int l, int T) {
    InPtr in = c.kp->in;
    const int tid = c.tid, tok = tid >> 3, sub = tid & 7, b = T >> 7, tt = T & 127, t = tt * 64 + tok;
    const bf16_t* prow = c.wsb(WS_R) + (size_t)(T * 64 + tok) * NIN;
    LAS bf16_t* VS = (LAS bf16_t*)(c.lds + PL_VS);
    LAS bf16_t* CQ = (LAS bf16_t*)(c.lds + PL_CQ);
    LAS bf16_t* CKV = (LAS bf16_t*)(c.lds + PL_CKV);
    LAS float* KR = (LAS float*)(c.lds + PL_KR);
    LAS float* RSQ = (LAS float*)(c.lds + PL_RSQ);
    LAS float* RSKV = (LAS float*)(c.lds + PL_RSKV);
    const float2* tab = (const float2*)(c.kp->ws + WS_TAB);
    {
        float ssq = 0.f;
#pragma unroll
        for (int i = 0; i < 4; ++i) { const u32x4 u = *(const u32x4*)(prow + 768 + 64 * i + 8 * sub); float v[8]; unpack8(u, v);
#pragma unroll
            for (int j = 0; j < 8; ++j) ssq += v[j] * v[j];
            *(LAS u32x4*)(CQ + tok * 264 + 64 * i + 8 * sub) = u; }
        ssq += __shfl_xor(ssq, 1); ssq += __shfl_xor(ssq, 2); ssq += __shfl_xor(ssq, 4);
        if (sub == 0) RSQ[tok] = 1.0f / sqrtf(ssq * (1.0f / 256.0f) + EPS);
        float ssk = 0.f;
#pragma unroll
        for (int i = 0; i < 2; ++i) { const u32x4 u = *(const u32x4*)(prow + 1024 + 64 * i + 8 * sub); float v[8]; unpack8(u, v);
#pragma unroll
            for (int j = 0; j < 8; ++j) ssk += v[j] * v[j];
            *(LAS u32x4*)(CKV + tok * 136 + 64 * i + 8 * sub) = u; }
        ssk += __shfl_xor(ssk, 1); ssk += __shfl_xor(ssk, 2); ssk += __shfl_xor(ssk, 4);
        if (sub == 0) RSKV[tok] = 1.0f / sqrtf(ssk * (1.0f / 128.0f) + EPS);
        if (sub < 4) { const u32x4 u = *(const u32x4*)(prow + 1152 + 8 * sub); float v[8]; unpack8(u, v);
#pragma unroll
            for (int j = 0; j < 8; ++j) KR[tok * 32 + 8 * sub + j] = v[j]; }
    }
    {
        const float* qg = in[I_NAQN] + l * 64 + sub * 8; const float* kg = in[I_NAKN] + l * 64 + sub * 8;
        bf16_t* QA = c.wsb(WS_QA); bf16_t* KA = c.wsb(WS_KA);
#pragma unroll
        for (int h = 0; h < 4; ++h) {
            float v[8], o[8]; unpack8(*(const u32x4*)(prow + h * 64 + sub * 8), v);
            float s = 0.f;
#pragma unroll
            for (int j = 0; j < 8; ++j) s += v[j] * v[j];
            s += __shfl_xor(s, 1); s += __shfl_xor(s, 2); s += __shfl_xor(s, 4);
            float rs = (1.0f / sqrtf(s * (1.0f / 64.0f) + EPS)) * (0.125f * LOG2E);
#pragma unroll
            for (int j = 0; j < 8; ++j) o[j] = v[j] * rs * qg[j];
            *(u32x4*)(QA + ((size_t)(b * 4 + h) * SEQ + t) * 64 + sub * 8) = pack8(o);
            unpack8(*(const u32x4*)(prow + 256 + h * 64 + sub * 8), v);
            s = 0.f;
#pragma unroll
            for (int j = 0; j < 8; ++j) s += v[j] * v[j];
            s += __shfl_xor(s, 1); s += __shfl_xor(s, 2); s += __shfl_xor(s, 4);
            rs = 1.0f / sqrtf(s * (1.0f / 64.0f) + EPS);
#pragma unroll
            for (int j = 0; j < 8; ++j) o[j] = v[j] * rs * kg[j];
            *(u32x4*)(KA + ((size_t)(b * 4 + h) * NTILE + tt) * 4096 + (sub * 64 + tok) * 8) = pack8(o);
            *(LAS u32x4*)(VS + (h * 64 + tok) * 72 + sub * 8) = *(const u32x4*)(prow + 512 + h * 64 + sub * 8);
        }
    }
    __syncthreads();
    vt_write(c, 4, c.wsb(WS_VA), b * 4, tt);
    __syncthreads();
    {
        const int lane = c.lane, l15 = lane & 15, fq = lane >> 4;
        const bf16_t* Wuq = c.wsb(WS_WUQ); const bf16_t* Wukv = c.wsb(WS_WUKV);
        for (int it = 0; it < 4; ++it) {
            const int task = c.wave + 8 * it;
            if (task < 16) {
                const int mt = task & 3, h = task >> 2, tokl = 16 * mt + l15, tq = tt * 64 + tokl, bh = b * 4 + h;
                f32x4 acc[6];
#pragma unroll
                for (int nt = 0; nt < 6; ++nt) acc[nt] = (f32x4){0.f, 0.f, 0.f, 0.f};
#pragma unroll
                for (int ks = 0; ks < 8; ++ks) {
                    const bf16x8 bfrag = *(const LAS bf16x8*)(CQ + tokl * 264 + 32 * ks + 8 * fq);
#pragma unroll
                    for (int nt = 0; nt < 6; ++nt) {
                        const bf16x8 afrag = *(const bf16x8*)(Wuq + (size_t)(h * 96 + 16 * nt + l15) * 256 + 32 * ks + 8 * fq);
                        acc[nt] = __builtin_amdgcn_mfma_f32_16x16x32_bf16(afrag, bfrag, acc[nt], 0, 0, 0);
                    }
                }
                const float rsq = RSQ[tokl]; float s = 0.f;
#pragma unroll
                for (int nt = 0; nt < 6; ++nt) { acc[nt] = acc[nt] * rsq; s += (acc[nt][0] * acc[nt][0] + acc[nt][1] * acc[nt][1]) + (acc[nt][2] * acc[nt][2] + acc[nt][3] * acc[nt][3]); }
                s += __shfl_xor(s, 16); s += __shfl_xor(s, 32);
                const float rh = 1.0f / sqrtf(s * (1.0f / 96.0f) + EPS);
                const float* gq = in[I_MLAQN] + l * 96 + 4 * fq;
#pragma unroll
                for (int nt = 0; nt < 6; ++nt) { const f32x4 g = *(const f32x4*)(gq + 16 * nt); acc[nt] = acc[nt] * g * rh; }
#pragma unroll
                for (int r = 0; r < 4; ++r) { const float2 cs = tab[tq * 16 + 4 * fq + r]; const float x1 = acc[4][r], x2 = acc[5][r]; acc[4][r] = x1 * cs.x - x2 * cs.y; acc[5][r] = x1 * cs.y + x2 * cs.x; }
                const float sc = 0.10206207261596577f * LOG2E;
                bf16_t* qo = c.wsb(WS_QB) + ((size_t)bh * SEQ + tq) * 96 + 4 * fq;
#pragma unroll
                for (int nt = 0; nt < 6; ++nt) { u32x2 w; w.x = pk2(acc[nt][0] * sc, acc[nt][1] * sc); w.y = pk2(acc[nt][2] * sc, acc[nt][3] * sc); *(u32x2*)(qo + 16 * nt) = w; }
            } else {
                const int tk = task - 16, mt = tk & 3, h = tk >> 2, tokl = 16 * mt + l15, tq = tt * 64 + tokl, bh = b * 4 + h;
                f32x4 acc[8];
#pragma unroll
                for (int nt = 0; nt < 8; ++nt) acc[nt] = (f32x4){0.f, 0.f, 0.f, 0.f};
#pragma unroll
                for (int ks = 0; ks < 4; ++ks) {
                    const bf16x8 bfrag = *(const LAS bf16x8*)(CKV + tokl * 136 + 32 * ks + 8 * fq);
#pragma unroll
                    for (int nt = 0; nt < 8; ++nt) {
                        const bf16x8 afrag = *(const bf16x8*)(Wukv + (size_t)(h * 128 + 16 * nt + l15) * 128 + 32 * ks + 8 * fq);
                        acc[nt] = __builtin_amdgcn_mfma_f32_16x16x32_bf16(afrag, bfrag, acc[nt], 0, 0, 0);
                    }
                }
                const float rskv = RSKV[tokl];
#pragma unroll
                for (int nt = 0; nt < 8; ++nt) acc[nt] = acc[nt] * rskv;
                f32x4 kr1 = *(const LAS f32x4*)(KR + tokl * 32 + 4 * fq), kr2 = *(const LAS f32x4*)(KR + tokl * 32 + 16 + 4 * fq);
                float s = (kr1[0] * kr1[0] + kr1[1] * kr1[1]) + (kr1[2] * kr1[2] + kr1[3] * kr1[3]) + (kr2[0] * kr2[0] + kr2[1] * kr2[1]) + (kr2[2] * kr2[2] + kr2[3] * kr2[3]);
#pragma unroll
                for (int nt = 0; nt < 4; ++nt) s += (acc[nt][0] * acc[nt][0] + acc[nt][1] * acc[nt][1]) + (acc[nt][2] * acc[nt][2] + acc[nt][3] * acc[nt][3]);
                s += __shfl_xor(s, 16); s += __shfl_xor(s, 32);
                const float rh = 1.0f / sqrtf(s * (1.0f / 96.0f) + EPS);
                const float* gk = in[I_MLAKN] + l * 96 + 4 * fq;
#pragma unroll
                for (int nt = 0; nt < 4; ++nt) { const f32x4 g = *(const f32x4*)(gk + 16 * nt); acc[nt] = acc[nt] * g * rh; }
                kr1 = kr1 * *(const f32x4*)(gk + 64) * rh; kr2 = kr2 * *(const f32x4*)(gk + 80) * rh;
#pragma unroll
                for (int r = 0; r < 4; ++r) { const float2 cs = tab[tq * 16 + 4 * fq + r]; const float x1 = kr1[r], x2 = kr2[r]; kr1[r] = x1 * cs.x - x2 * cs.y; kr2[r] = x1 * cs.y + x2 * cs.x; }
                bf16_t* kt = c.wsb(WS_KB) + ((size_t)bh * NTILE + tt) * 6144 + tokl * 8 + (fq & 1) * 4;
#pragma unroll
                for (int nt = 0; nt < 4; ++nt) { u32x2 w; w.x = pk2(acc[nt][0], acc[nt][1]); w.y = pk2(acc[nt][2], acc[nt][3]); *(u32x2*)(kt + (2 * nt + (fq >> 1)) * 512) = w; }
                { u32x2 w; w.x = pk2(kr1[0], kr1[1]); w.y = pk2(kr1[2], kr1[3]); *(u32x2*)(kt + (8 + (fq >> 1)) * 512) = w;
                  w.x = pk2(kr2[0], kr2[1]); w.y = pk2(kr2[2], kr2[3]); *(u32x2*)(kt + (10 + (fq >> 1)) * 512) = w; }
#pragma unroll
                for (int nt = 4; nt < 8; ++nt) { u32x2 w; w.x = pk2(acc[nt][0], acc[nt][1]); w.y = pk2(acc[nt][2], acc[nt][3]); *(LAS u32x2*)(VS + (h * 64 + tokl) * 72 + 16 * (nt - 4) + 4 * fq) = w; }
            }
        }
    }
    __syncthreads();
    vt_write(c, 4, c.wsb(WS_VB), b * 4, tt);
    __syncthreads();
    {
        const float* qg = in[I_DQN] + l * 32 + (sub & 3) * 8; const float* kg = in[I_DKN] + l * 32 + (sub & 3) * 8;
        bf16_t* QC = c.wsb(WS_QC); bf16_t* KC = c.wsb(WS_KC);
#pragma unroll
        for (int h = 0; h < 4; ++h) {
            float v[8], o[8]; unpack8(*(const u32x4*)(prow + 1280 + h * 64 + sub * 8), v);
            float s = 0.f;
#pragma unroll
            for (int j = 0; j < 8; ++j) s += v[j] * v[j];
            s += __shfl_xor(s, 1); s += __shfl_xor(s, 2);
            float rs = (1.0f / sqrtf(s * (1.0f / 32.0f) + EPS)) * (0.17677669529663687f * LOG2E);
#pragma unroll
            for (int j = 0; j < 8; ++j) o[j] = v[j] * rs * qg[j];
            *(u32x4*)(QC + ((size_t)(b * 4 + h) * SEQ + t) * 64 + sub * 8) = pack8(o);
            unpack8(*(const u32x4*)(prow + 1280 + 256 + h * 64 + sub * 8), v);
            s = 0.f;
#pragma unroll
            for (int j = 0; j < 8; ++j) s += v[j] * v[j];
            s += __shfl_xor(s, 1); s += __shfl_xor(s, 2);
            rs = 1.0f / sqrtf(s * (1.0f / 32.0f) + EPS);
#pragma unroll
            for (int j = 0; j < 8; ++j) o[j] = v[j] * rs * kg[j];
            *(u32x4*)(KC + ((size_t)(b * 4 + h) * NTILE + tt) * 4096 + (sub * 64 + tok) * 8) = pack8(o);
            *(LAS u32x4*)(VS + (h * 64 + tok) * 72 + sub * 8) = *(const u32x4*)(prow + 1280 + 512 + h * 64 + sub * 8);
        }
    }
    __syncthreads();
    vt_write(c, 4, c.wsb(WS_VC), b * 4, tt);
    __syncthreads();
    {
        const float* qg = in[I_GQN] + l * 64 + sub * 8; const float* kg = in[I_GKN] + l * 64 + sub * 8;
        bf16_t* QD = c.wsb(WS_QD); bf16_t* KD = c.wsb(WS_KD);
        const int pos = (sub < 4) ? (t >> 6) : (t & 63); const bool first = (sub & 2) == 0;
        float cs_c[8], cs_s[8];
#pragma unroll
        for (int j = 0; j < 8; ++j) { const float2 cs = tab[pos * 16 + 8 * (sub & 1) + j]; cs_c[j] = cs.x; cs_s[j] = cs.y; }
#pragma unroll
        for (int h = 0; h < 6; ++h) {
            const bool isq = h < 4;
            float v[8], o[8]; unpack8(*(const u32x4*)(prow + 2048 + h * 64 + sub * 8), v);
            float s = 0.f;
#pragma unroll
            for (int j = 0; j < 8; ++j) s += v[j] * v[j];
            s += __shfl_xor(s, 1); s += __shfl_xor(s, 2); s += __shfl_xor(s, 4);
            const float rs = 1.0f / sqrtf(s * (1.0f / 64.0f) + EPS);
            const float* g = isq ? qg : kg;
#pragma unroll
            for (int j = 0; j < 8; ++j) v[j] = v[j] * rs * g[j];
            const float sc = isq ? 0.125f * LOG2E : 1.0f;
#pragma unroll
            for (int j = 0; j < 8; ++j) { const float pv = __shfl_xor(v[j], 2); o[j] = (first ? (v[j] * cs_c[j] - pv * cs_s[j]) : (pv * cs_s[j] + v[j] * cs_c[j])) * sc; }
            if (isq) *(u32x4*)(QD + ((size_t)(b * 4 + h) * SEQ + t) * 64 + sub * 8) = pack8(o);
            else *(u32x4*)(KD + ((size_t)(b * 2 + (h - 4)) * NTILE + tt) * 4096 + (sub * 64 + tok) * 8) = pack8(o);
        }
#pragma unroll
        for (int h = 0; h < 2; ++h) *(LAS u32x4*)(VS + (h * 64 + tok) * 72 + sub * 8) = *(const u32x4*)(prow + 2048 + 384 + h * 64 + sub * 8);
    }
    __syncthreads();
    vt_write(c, 2, c.wsb(WS_VD), b * 2, tt);
    __syncthreads();
}

namespace att {
constexpr int SLOT_K = 12288, SLOT = 20480, LUT_OFF = 69632, PARK_OFF = 73728;
struct Args { const bf16_t* Q; const bf16_t* K; const bf16_t* V; bf16_t* Y; int ycol, kv_shift, nkvh; const float* lut_src; const float* lam_src; float lam_init; };
__device__ __forceinline__ int crow(int r, int hi) { return (r & 3) + 8 * (r >> 2) + 4 * hi; }
__device__ __forceinline__ int iclamp(int v, int lo, int hi) { return v < lo ? lo : (v > hi ? hi : v); }
__device__ __forceinline__ void glds16(const bf16_t* src, LAS unsigned char* dst) { __builtin_amdgcn_global_load_lds((const unsigned*)src, (LAS unsigned*)dst, 16, 0, 0); }

__device__ __forceinline__ float max2f(float a, float b) { return __builtin_amdgcn_fmed3f(a, b, __builtin_inff()); }
template <int MODE, int DQK>
__device__ __forceinline__ void unit(const Args& a, int bh, int qb, LAS unsigned char* lds, const int tid) {
    constexpr int NQF = DQK / 16, NMAP = (MODE == 1) ? 2 : 1, FPM = NQF / NMAP, NKP = DQK / 8, NP = NKP + 8, NPW = (NP + 7) / 8, KT_ELEMS = DQK * 64;
    constexpr float THR = 5.0f;
    const int lane = tid & 63, r32 = lane & 31, hi = lane >> 5, w = __builtin_amdgcn_readfirstlane(tid >> 6);
    const int b = bh >> 2, h = bh & 3, kvh = b * a.nkvh + (h >> a.kv_shift);
    const int qrow = qb * 256 + 32 * w + r32;
    int t_lo = 0, t_hi = NTILE, my_lo = 0, my_hi = NTILE, myr = 0;
    if (MODE == 2) { const int r0 = qb * 4; t_lo = iclamp(r0 - 4, 0, 120); t_hi = iclamp(r0 + 3 - 4, 0, 120) + 8; myr = r0 + (w >> 1); my_lo = iclamp(myr - 4, 0, 120); my_hi = my_lo + 8; }
    const int NT = t_hi - t_lo;
    LAS float* lut = (LAS float*)(lds + LUT_OFF);
    if (MODE == 1) {
        for (int i = tid; i < 257; i += NTHREADS) { const int rel = i - 128, n = rel < 0 ? -rel : rel;
            int large = 8 + (int)(logf((float)(n < 1 ? 1 : n) / 8.0f) / 2.772588722239781f * 8.0f); large = large > 15 ? 15 : large;
            const int bucket = (rel > 0 ? 16 : 0) + (n < 8 ? n : large);
            lut[i] = a.lut_src[bucket * 4 + h] * LOG2E; }
    }
    if (MODE == 2) { for (int i = tid; i < 465; i += NTHREADS) lut[i] = a.lut_src[h * 465 + i] * LOG2E; }
    bf16x8 qf[NQF];
    { const bf16_t* qp = a.Q + ((size_t)bh * SEQ + qrow) * DQK + 8 * hi;
#pragma unroll
      for (int d0 = 0; d0 < NQF; ++d0) qf[d0] = *(const bf16x8*)(qp + 16 * d0); }
    float mrun[NMAP], lrun[NMAP]; f32x16 o[NMAP][2]; f32x16 negm = f32x16{};
#pragma unroll
    for (int mp = 0; mp < NMAP; ++mp) { mrun[mp] = 0.f; lrun[mp] = 0.f; o[mp][0] = f32x16{}; o[mp][1] = f32x16{}; }
    bool started = false;
    const bf16_t* Kt = a.K + (size_t)kvh * NTILE * KT_ELEMS; const bf16_t* Vt = a.V + (size_t)kvh * NTILE * 4096;
#define ATT_ISSUE(t, slot) do { _Pragma("unroll") for (int j_ = 0; j_ < NPW; ++j_) { int p_ = w + 8 * j_; if (p_ >= NP) p_ -= 8; \
        if (p_ < NKP) glds16(Kt + (size_t)(t) * KT_ELEMS + p_ * 512 + lane * 8, lds + (slot) * SLOT + p_ * 1024); \
        else glds16(Vt + (size_t)(t) * 4096 + (p_ - NKP) * 512 + lane * 8, lds + (slot) * SLOT + SLOT_K + (p_ - NKP) * 1024); } } while (0)
    ATT_ISSUE(t_lo, 0);
    if (NT > 1) ATT_ISSUE(t_lo + 1, 1);
    int slot = 0;
    for (int i = 0; i < NT; ++i) {
        if (i + 1 < NT) { if constexpr (NPW == 2) asm volatile("s_waitcnt vmcnt(2)" ::: "memory"); else asm volatile("s_waitcnt vmcnt(3)" ::: "memory"); }
        else asm volatile("s_waitcnt vmcnt(0)" ::: "memory");
        asm volatile("s_waitcnt lgkmcnt(0)" ::: "memory"); __builtin_amdgcn_s_barrier(); asm volatile("" ::: "memory");
        if (i + 2 < NT) { const int s2 = slot >= 1 ? slot - 1 : 2; ATT_ISSUE(t_lo + i + 2, s2); }
        const int t = t_lo + i;
        if (MODE != 2 || (t >= my_lo && t < my_hi)) {
            const LAS unsigned char* ks = lds + slot * SLOT + hi * 1024 + r32 * 16;
            const LAS unsigned char* vs = lds + slot * SLOT + SLOT_K + hi * 1024 + r32 * 16;
#pragma unroll
            for (int mp = 0; mp < NMAP; ++mp) {
                bf16x8 kf[2 * FPM];
#pragma unroll
                for (int d = 0; d < FPM; ++d) { const int d0 = mp * FPM + d; kf[2 * d] = *(const LAS bf16x8*)(ks + d0 * 2048); kf[2 * d + 1] = *(const LAS bf16x8*)(ks + d0 * 2048 + 512); }
                f32x16 c0, c1; const float mneg = -mrun[mp];
                if (MODE == 0) { c0 = negm; c1 = negm; }
                if (MODE == 1) {
                    const int qw0 = qb * 256 + 32 * w, d_lo = 64 * t - (qw0 + 31), d_hi = 64 * t + 63 - qw0;
                    if (d_hi <= -128 || d_lo >= 128) { const float v = lut[d_lo >= 128 ? 256 : 0] + mneg;
#pragma unroll
                        for (int r = 0; r < 16; ++r) c0[r] = v;
                        c1 = c0; }
                    else {
#pragma unroll
                        for (int r = 0; r < 16; ++r) { const int rel = 64 * t + crow(r, hi) - qrow; c0[r] = lut[iclamp(rel, -128, 128) + 128] + mneg; c1[r] = lut[iclamp(rel + 32, -128, 128) + 128] + mneg; } }
                }
                if (MODE == 2) {
                    const int qc = 32 * (w & 1) + r32, qs = iclamp(qc - 8, 0, 48), dr = t - myr + 7;
#pragma unroll
                    for (int r = 0; r < 16; ++r) { const int kc = crow(r, hi), kc2 = kc + 32;
                        const bool v1 = (kc >= qs) && (kc < qs + 16), v2 = (kc2 >= qs) && (kc2 < qs + 16);
                        c0[r] = v1 ? lut[dr * 31 + (kc - qc + 15)] + mneg : -1e30f; c1[r] = v2 ? lut[dr * 31 + (kc2 - qc + 15)] + mneg : -1e30f; }
                }
                __builtin_amdgcn_sched_barrier(0);
                f32x16 p0 = __builtin_amdgcn_mfma_f32_32x32x16_bf16(kf[0], qf[mp * FPM], c0, 0, 0, 0);
                f32x16 p1 = __builtin_amdgcn_mfma_f32_32x32x16_bf16(kf[1], qf[mp * FPM], c1, 0, 0, 0);
#pragma unroll
                for (int d = 1; d < FPM; ++d) { p0 = __builtin_amdgcn_mfma_f32_32x32x16_bf16(kf[2 * d], qf[mp * FPM + d], p0, 0, 0, 0); p1 = __builtin_amdgcn_mfma_f32_32x32x16_bf16(kf[2 * d + 1], qf[mp * FPM + d], p1, 0, 0, 0); }
                bf16x8 vf[8];
#pragma unroll
                for (int q8 = 0; q8 < 8; ++q8) vf[q8] = *(const LAS bf16x8*)(vs + (q8 & 3) * 2048 + (q8 >> 2) * 512);
                __builtin_amdgcn_sched_barrier(0);
                float ma = max2f(p0[0], p1[0]), mb = max2f(p0[1], p1[1]);
#pragma unroll
                for (int r = 2; r < 16; r += 2) { ma = max2f(ma, max2f(p0[r], p1[r])); mb = max2f(mb, max2f(p0[r + 1], p1[r + 1])); }
                float rm = max2f(ma, mb);
                { auto rr = __builtin_amdgcn_permlane32_swap(__float_as_uint(rm), __float_as_uint(rm), false, false); rm = max2f(__uint_as_float(rr[0]), __uint_as_float(rr[1])); }
                if (!started || __any(rm > THR)) {
                    const float dl = started ? fmaxf(rm, 0.f) : rm;
                    mrun[mp] += dl;
#pragma unroll
                    for (int r = 0; r < 16; ++r) { p0[r] -= dl; p1[r] -= dl; }
                    const float alpha = __builtin_amdgcn_exp2f(-dl);
                    lrun[mp] *= alpha; o[mp][0] = o[mp][0] * alpha; o[mp][1] = o[mp][1] * alpha;
                    if (MODE == 0) {
#pragma unroll
                        for (int r = 0; r < 16; ++r) negm[r] = -mrun[mp];
                    }
                }
                float rs0 = 0.f, rs1 = 0.f;
#pragma unroll
                for (int r = 0; r < 16; ++r) { p0[r] = __builtin_amdgcn_exp2f(p0[r]); p1[r] = __builtin_amdgcn_exp2f(p1[r]); rs0 += p0[r]; rs1 += p1[r]; }
                lrun[mp] += rs0 + rs1;
                u32x4 pw[4];
#pragma unroll
                for (int j = 0; j < 4; ++j) { pw[0][j] = pk2(p0[2 * j], p0[2 * j + 1]); pw[1][j] = pk2(p0[8 + 2 * j], p0[9 + 2 * j]); pw[2][j] = pk2(p1[2 * j], p1[2 * j + 1]); pw[3][j] = pk2(p1[8 + 2 * j], p1[9 + 2 * j]); }
#pragma unroll
                for (int k4 = 0; k4 < 4; ++k4) {
                    o[mp][0] = __builtin_amdgcn_mfma_f32_32x32x16_bf16(vf[k4], __builtin_bit_cast(bf16x8, pw[k4]), o[mp][0], 0, 0, 0);
                    o[mp][1] = __builtin_amdgcn_mfma_f32_32x32x16_bf16(vf[4 + k4], __builtin_bit_cast(bf16x8, pw[k4]), o[mp][1], 0, 0, 0); }
            }
            started = true;
        }
        slot = slot == 2 ? 0 : slot + 1;
    }
#undef ATT_ISSUE
#pragma unroll
    for (int mp = 0; mp < NMAP; ++mp) lrun[mp] += __shfl_xor(lrun[mp], 32);
    f32x16 val[2];
    if (MODE == 1) {
        float s1 = 0.f, s2 = 0.f;
        for (int i = 0; i < 32; ++i) { s1 += a.lam_src[i] * a.lam_src[32 + i]; s2 += a.lam_src[64 + i] * a.lam_src[96 + i]; }
        const float lam = expf(s1) - expf(s2) + a.lam_init;
        const float i0 = 1.0f / lrun[0], i1 = lam / lrun[NMAP - 1];
        val[0] = o[0][0] * i0 - o[NMAP - 1][0] * i1; val[1] = o[0][1] * i0 - o[NMAP - 1][1] * i1;
        float s = 0.f;
#pragma unroll
        for (int r = 0; r < 16; ++r) s += val[0][r] * val[0][r] + val[1][r] * val[1][r];
        s += __shfl_xor(s, 32);
        const float rn = 1.0f / sqrtf(s * (1.0f / 64.0f) + EPS);
        val[0] = val[0] * rn; val[1] = val[1] * rn;
    } else { const float i0 = 1.0f / lrun[0]; val[0] = o[0][0] * i0; val[1] = o[0][1] * i0; }
    bf16_t* yp = a.Y + ((size_t)(b * SEQ + qrow)) * DM + a.ycol + h * 64 + 4 * hi;
#pragma unroll
    for (int db = 0; db < 2; ++db)
#pragma unroll
        for (int g = 0; g < 4; ++g) { u32x2 wv; wv.x = pk2(val[db][4 * g], val[db][4 * g + 1]); wv.y = pk2(val[db][4 * g + 2], val[db][4 * g + 3]); *(u32x2*)(yp + 32 * db + 8 * g) = wv; }
    asm volatile("s_waitcnt lgkmcnt(0)" ::: "memory"); __builtin_amdgcn_s_barrier(); asm volatile("" ::: "memory");
}

#define ATT_WAITV(n) asm volatile("s_waitcnt vmcnt(" #n ") lgkmcnt(0)\n\ts_barrier" ::: "memory")
__device__ __forceinline__ void wait_bar_n(int n) {
    if (n == 0) ATT_WAITV(0); else if (n == 1) ATT_WAITV(1); else if (n == 2) ATT_WAITV(2); else if (n == 3) ATT_WAITV(3); else ATT_WAITV(4);
}
template <int DQK> struct PipeCfg {
    static constexpr int KSLOT = DQK * 128, VSLOT = 8192, KRING = 0, VRING = 3 * KSLOT, NKP = DQK / 8, NKW = (NKP + 7) / 8, KT_ELEMS = DQK * 64;
};
struct PipeState { float mrun, lrun, cb; f32x16 negm; };
__device__ __forceinline__ void bias_tile(f32x16& C0, f32x16& C1, const LAS float* lut, int t, int qrow, int hi, float mrun) {
#pragma unroll
    for (int r = 0; r < 16; ++r) { const int rel = 64 * t + crow(r, hi) - qrow; C0[r] = lut[iclamp(rel, -128, 128) + 128] - mrun; C1[r] = lut[iclamp(rel + 32, -128, 128) + 128] - mrun; }
}
template <int DQK, int F0, int NF, bool BIAS>
__device__ __forceinline__ void pipe_step(int t, f32x16& C0, f32x16& C1, f32x16& P0, f32x16& P1, f32x16 (&o)[2], bf16x8 (&kf)[2 * NF], const bf16x8 (&qf)[NF],
                                          PipeState& st, LAS unsigned char* lds, const bf16_t* Kt, const bf16_t* Vt, int lane, int w, int frag_off,
                                          const LAS float* lut, int qw0, int qrow, int hi, float cL, float cR) {
    typedef PipeCfg<DQK> Cf;
    constexpr int NKF = 2 * NF, NT = NTILE, GPG = (8 + NKF - 1) / NKF;
    constexpr float THR = 5.0f;
    const int sv_prev = (t - 1) & 3, sk_next = (t + 1) % 3;
    const LAS unsigned char* vs = lds + Cf::VRING + sv_prev * Cf::VSLOT + frag_off;
    const LAS unsigned char* kn = lds + Cf::KRING + sk_next * Cf::KSLOT + frag_off + F0 * 2048;
    bf16x8 vf[8]; u32x4 pw[4]; float sacc = 0.f;
    bool near = false;
    if (BIAS) {
        const int d_lo = 64 * t - (qw0 + 31), d_hi = 64 * t + 63 - qw0;
        near = !(d_hi <= -128 || d_lo >= 128);
        if (near) bias_tile(C0, C1, lut, t, qrow, hi, st.mrun);
        else { const float ct = d_lo >= 128 ? cR : cL;
            if (ct != st.cb) { st.cb = ct;
#pragma unroll
                for (int r = 0; r < 16; ++r) st.negm[r] = ct - st.mrun; } }
    }
    __builtin_amdgcn_sched_barrier(0);
#pragma unroll
    for (int g = 0; g < NKF; ++g) {
        if (g >= NKF - 4) { const int q8 = g - (NKF - 4); vf[q8] = *(const LAS bf16x8*)(vs + q8 * 2048); }
        __builtin_amdgcn_sched_barrier(0);
        const int d = g >> 1;
        if (d == 0) {
            if (BIAS && near) { if ((g & 1) == 0) C0 = __builtin_amdgcn_mfma_f32_32x32x16_bf16(kf[g], qf[d], C0, 0, 0, 0); else C1 = __builtin_amdgcn_mfma_f32_32x32x16_bf16(kf[g], qf[d], C1, 0, 0, 0); }
            else { if ((g & 1) == 0) C0 = __builtin_amdgcn_mfma_f32_32x32x16_bf16(kf[g], qf[d], st.negm, 0, 0, 0); else C1 = __builtin_amdgcn_mfma_f32_32x32x16_bf16(kf[g], qf[d], st.negm, 0, 0, 0); }
        } else { if ((g & 1) == 0) C0 = __builtin_amdgcn_mfma_f32_32x32x16_bf16(kf[g], qf[d], C0, 0, 0, 0); else C1 = __builtin_amdgcn_mfma_f32_32x32x16_bf16(kf[g], qf[d], C1, 0, 0, 0); }
#pragma unroll
        for (int gg = 0; gg < GPG; ++gg) { const int grp = g * GPG + gg;
            if (grp < 8) {
                if (grp < 4) { sacc += (P0[4 * grp] + P0[4 * grp + 1]) + (P0[4 * grp + 2] + P0[4 * grp + 3]); pw[grp >> 1][2 * (grp & 1)] = pk2(P0[4 * grp], P0[4 * grp + 1]); pw[grp >> 1][2 * (grp & 1) + 1] = pk2(P0[4 * grp + 2], P0[4 * grp + 3]); }
                else { const int e = 4 * (grp - 4); sacc += (P1[e] + P1[e + 1]) + (P1[e + 2] + P1[e + 3]); pw[grp >> 1][2 * (grp & 1)] = pk2(P1[e], P1[e + 1]); pw[grp >> 1][2 * (grp & 1) + 1] = pk2(P1[e + 2], P1[e + 3]); }
                asm volatile("" : "+v"(sacc)); asm volatile("" : "+v"(pw[grp >> 1]));
            } }
        __builtin_amdgcn_sched_barrier(0);
    }
    st.lrun += sacc;
    if (t + 3 < NT) {
#pragma unroll
        for (int j = 0; j < Cf::NKW; ++j) { int p = w + 8 * j; if (p >= Cf::NKP) p -= 8;
            glds16(Kt + (size_t)(t + 3) * Cf::KT_ELEMS + p * 512 + lane * 8, lds + Cf::KRING + (t % 3) * Cf::KSLOT + p * 1024); }
    }
    if (t + 2 < NT) glds16(Vt + (size_t)(t + 2) * 4096 + w * 512 + lane * 8, lds + Cf::VRING + ((t + 2) & 3) * Cf::VSLOT + w * 1024);
    float alpha = 1.0f; bool resc = false;
    {
        int ia = max(max(__float_as_int(C0[0]), __float_as_int(C0[1])), __float_as_int(C1[0])), ib = max(max(__float_as_int(C0[2]), __float_as_int(C0[3])), __float_as_int(C1[1]));
        ia = max(max(ia, __float_as_int(C1[2])), __float_as_int(C1[3]));
#pragma unroll
        for (int r = 4; r < 16; r += 4) { ia = max(max(ia, __float_as_int(C0[r])), __float_as_int(C0[r + 1])); ib = max(max(ib, __float_as_int(C0[r + 2])), __float_as_int(C0[r + 3]));
            ia = max(max(ia, __float_as_int(C1[r])), __float_as_int(C1[r + 1])); ib = max(max(ib, __float_as_int(C1[r + 2])), __float_as_int(C1[r + 3])); }
        int im = max(ia, ib);
        { auto rr = __builtin_amdgcn_permlane32_swap((unsigned)im, (unsigned)im, false, false); im = max((int)rr[0], (int)rr[1]); }
        if (__builtin_expect(__any(im > __float_as_int(THR)), 0)) {
            const float rm = __int_as_float(im), dl = rm > 0.f ? rm : 0.f;
            st.mrun += dl;
#pragma unroll
            for (int r = 0; r < 16; ++r) { C0[r] -= dl; C1[r] -= dl; }
#pragma unroll
            for (int r = 0; r < 16; ++r) st.negm[r] = st.cb - st.mrun;
            alpha = __builtin_amdgcn_exp2f(-dl); st.lrun *= alpha; resc = true;
        }
    }
    __builtin_amdgcn_sched_barrier(0);
#pragma unroll
    for (int g = 0; g < 8; ++g) {
        if (t + 1 < NT) {
            constexpr int G0 = (NKF >= 12) ? 1 : 2;
            if (g >= G0 && 2 * (g - G0) < NKF) { const int f = g - G0; kf[2 * f] = *(const LAS bf16x8*)(kn + f * 2048); kf[2 * f + 1] = *(const LAS bf16x8*)(kn + f * 2048 + 512); }
        }
        if (g < 2) { vf[4 + 2 * g] = *(const LAS bf16x8*)(vs + (2 * g) * 2048 + 512); vf[5 + 2 * g] = *(const LAS bf16x8*)(vs + (2 * g + 1) * 2048 + 512); }
        __builtin_amdgcn_sched_barrier(0);
        const int k4 = g & 3, db = g >> 2;
        o[db] = __builtin_amdgcn_mfma_f32_32x32x16_bf16(vf[g], __builtin_bit_cast(bf16x8, pw[k4]), o[db], 0, 0, 0);
        if (g < 4) {
#pragma unroll
            for (int e = 0; e < 4; ++e) C0[4 * g + e] = __builtin_amdgcn_exp2f(C0[4 * g + e]);
        } else {
#pragma unroll
            for (int e = 0; e < 4; ++e) C1[4 * (g - 4) + e] = __builtin_amdgcn_exp2f(C1[4 * (g - 4) + e]);
        }
        if (g < 4) asm volatile("" : "+v"(C0)); else asm volatile("" : "+v"(C1));
        __builtin_amdgcn_sched_barrier(0);
    }
    wait_bar_n((t + 1 < NT ? 1 : 0) + (t + 3 < NT ? Cf::NKW : 0) + (t + 2 < NT ? 1 : 0));
    if (resc) { o[0] = o[0] * alpha; o[1] = o[1] * alpha; }
}
template <int DQK, int F0, int NF, bool BIAS>
__device__ __forceinline__ void pipe_run(const Args& a, int bh, int qb, LAS unsigned char* lds, const int tid, f32x16 (&o)[2], float& lsum) {
    typedef PipeCfg<DQK> Cf;
    constexpr int NKF = 2 * NF, NT = NTILE;
    const int lane = tid & 63, r32 = lane & 31, hi = lane >> 5, w = __builtin_amdgcn_readfirstlane(tid >> 6);
    const int b = bh >> 2, h = bh & 3, kvh = b * a.nkvh + (h >> a.kv_shift);
    const int qw0 = qb * 256 + 32 * w, qrow = qw0 + r32, frag_off = hi * 1024 + r32 * 16;
    const bf16_t* Kt = a.K + (size_t)kvh * NTILE * Cf::KT_ELEMS; const bf16_t* Vt = a.V + (size_t)kvh * NTILE * 4096;
    const LAS float* lut = (const LAS float*)(lds + LUT_OFF);
#define PIPE_DMA_K(t, slot) do { _Pragma("unroll") for (int j_ = 0; j_ < Cf::NKW; ++j_) { int p_ = w + 8 * j_; if (p_ >= Cf::NKP) p_ -= 8; \
        glds16(Kt + (size_t)(t) * Cf::KT_ELEMS + p_ * 512 + lane * 8, lds + Cf::KRING + (slot) * Cf::KSLOT + p_ * 1024); } } while (0)
#define PIPE_DMA_V(t, slot) glds16(Vt + (size_t)(t) * 4096 + w * 512 + lane * 8, lds + Cf::VRING + (slot) * Cf::VSLOT + w * 1024)
    PIPE_DMA_K(0, 0); PIPE_DMA_V(0, 0); PIPE_DMA_K(1, 1); PIPE_DMA_V(1, 1); PIPE_DMA_K(2, 2);
    bf16x8 qf[NF];
    { const bf16_t* qp = a.Q + ((size_t)bh * SEQ + qrow) * DQK + 8 * hi + 16 * F0;
#pragma unroll
      for (int d0 = 0; d0 < NF; ++d0) qf[d0] = *(const bf16x8*)(qp + 16 * d0); }
    PipeState st; st.mrun = 0.f; st.lrun = 0.f; st.cb = 0.f; st.negm = f32x16{};
    o[0] = f32x16{}; o[1] = f32x16{};
    f32x16 pA0, pA1, pB0, pB1; bf16x8 kf[NKF];
    if (Cf::NKW == 1) ATT_WAITV(4); else asm volatile("s_waitcnt vmcnt(6) lgkmcnt(0)\n\ts_barrier" ::: "memory");
    float cL = 0.f, cR = 0.f;
    if (BIAS) { cL = __int_as_float(__builtin_amdgcn_readfirstlane(__float_as_int(lut[0]))); cR = __int_as_float(__builtin_amdgcn_readfirstlane(__float_as_int(lut[256]))); }
    {
        const LAS unsigned char* k0 = lds + Cf::KRING + frag_off + F0 * 2048;
#pragma unroll
        for (int g = 0; g < NKF; ++g) kf[g] = *(const LAS bf16x8*)(k0 + (g >> 1) * 2048 + (g & 1) * 512);
        pA0 = f32x16{}; pA1 = f32x16{};
        if (BIAS) bias_tile(pA0, pA1, lut, 0, qrow, hi, 0.f);
#pragma unroll
        for (int d = 0; d < NF; ++d) { pA0 = __builtin_amdgcn_mfma_f32_32x32x16_bf16(kf[2 * d], qf[d], pA0, 0, 0, 0); pA1 = __builtin_amdgcn_mfma_f32_32x32x16_bf16(kf[2 * d + 1], qf[d], pA1, 0, 0, 0); }
        float rm = fmaxf(pA0[0], pA1[0]);
#pragma unroll
        for (int r = 1; r < 16; ++r) rm = fmaxf(rm, fmaxf(pA0[r], pA1[r]));
        { auto rr = __builtin_amdgcn_permlane32_swap(__float_as_uint(rm), __float_as_uint(rm), false, false); rm = fmaxf(__uint_as_float(rr[0]), __uint_as_float(rr[1])); }
        st.mrun = rm;
#pragma unroll
        for (int r = 0; r < 16; ++r) { pA0[r] = __builtin_amdgcn_exp2f(pA0[r] - rm); pA1[r] = __builtin_amdgcn_exp2f(pA1[r] - rm); st.negm[r] = -rm; }
    }
    ATT_WAITV(0);
    PIPE_DMA_K(3, 0); PIPE_DMA_V(2, 2);
    {   const LAS unsigned char* k1 = lds + Cf::KRING + Cf::KSLOT + frag_off + F0 * 2048;
#pragma unroll
        for (int g = 0; g < NKF; ++g) kf[g] = *(const LAS bf16x8*)(k1 + (g >> 1) * 2048 + (g & 1) * 512); }
    if (Cf::NKW == 1) ATT_WAITV(2); else ATT_WAITV(3);
    int t = 1;
    for (; t + 1 < NT; t += 2) {
        pipe_step<DQK, F0, NF, BIAS>(t, pB0, pB1, pA0, pA1, o, kf, qf, st, lds, Kt, Vt, lane, w, frag_off, lut, qw0, qrow, hi, cL, cR);
        pipe_step<DQK, F0, NF, BIAS>(t + 1, pA0, pA1, pB0, pB1, o, kf, qf, st, lds, Kt, Vt, lane, w, frag_off, lut, qw0, qrow, hi, cL, cR);
    }
    pipe_step<DQK, F0, NF, BIAS>(NT - 1, pB0, pB1, pA0, pA1, o, kf, qf, st, lds, Kt, Vt, lane, w, frag_off, lut, qw0, qrow, hi, cL, cR);
    {
        float sacc = 0.f;
#pragma unroll
        for (int r = 0; r < 16; ++r) sacc += pB0[r] + pB1[r];
        st.lrun += sacc;
        u32x4 pw[4];
#pragma unroll
        for (int j = 0; j < 4; ++j) { pw[0][j] = pk2(pB0[2 * j], pB0[2 * j + 1]); pw[1][j] = pk2(pB0[8 + 2 * j], pB0[9 + 2 * j]); pw[2][j] = pk2(pB1[2 * j], pB1[2 * j + 1]); pw[3][j] = pk2(pB1[8 + 2 * j], pB1[9 + 2 * j]); }
        const LAS unsigned char* vs = lds + Cf::VRING + ((NT - 1) & 3) * Cf::VSLOT + frag_off;
#pragma unroll
        for (int k4 = 0; k4 < 4; ++k4)
#pragma unroll
            for (int db = 0; db < 2; ++db) { const bf16x8 vfr = *(const LAS bf16x8*)(vs + k4 * 2048 + db * 512);
                o[db] = __builtin_amdgcn_mfma_f32_32x32x16_bf16(vfr, __builtin_bit_cast(bf16x8, pw[k4]), o[db], 0, 0, 0); }
    }
#undef PIPE_DMA_K
#undef PIPE_DMA_V
    lsum = st.lrun + __shfl_xor(st.lrun, 32);
    asm volatile("s_waitcnt lgkmcnt(0)\n\ts_barrier" ::: "memory");
}
__device__ __forceinline__ void store_rows(const Args& a, int bh, int qb, int tid, const f32x16 (&val)[2]) {
    const int lane = tid & 63, r32 = lane & 31, hi = lane >> 5, w = __builtin_amdgcn_readfirstlane(tid >> 6), b = bh >> 2, h = bh & 3, qrow = qb * 256 + 32 * w + r32;
    bf16_t* yp = a.Y + ((size_t)(b * SEQ + qrow)) * DM + a.ycol + h * 64 + 4 * hi;
#pragma unroll
    for (int db = 0; db < 2; ++db)
#pragma unroll
        for (int g = 0; g < 4; ++g) { u32x2 wv; wv.x = pk2(val[db][4 * g], val[db][4 * g + 1]); wv.y = pk2(val[db][4 * g + 2], val[db][4 * g + 3]); *(u32x2*)(yp + 32 * db + 8 * g) = wv; }
}
template <int DQK>
__device__ __forceinline__ void unit_plain(const Args& a, int bh, int qb, LAS unsigned char* lds, const int tid) {
    f32x16 o[2]; float l;
    pipe_run<DQK, 0, DQK / 16, false>(a, bh, qb, lds, tid, o, l);
    const float i0 = 1.0f / l; o[0] = o[0] * i0; o[1] = o[1] * i0;
    store_rows(a, bh, qb, tid, o);
}
__device__ __forceinline__ void unit_diff(const Args& a, int bh, int qb, LAS unsigned char* lds, const int tid) {
    const int h = bh & 3;
    LAS float* lut = (LAS float*)(lds + LUT_OFF);
    for (int i = tid; i < 257; i += NTHREADS) { const int rel = i - 128, n = rel < 0 ? -rel : rel;
        int large = 8 + (int)(logf((float)(n < 1 ? 1 : n) / 8.0f) / 2.772588722239781f * 8.0f); large = large > 15 ? 15 : large;
        const int bucket = (rel > 0 ? 16 : 0) + (n < 8 ? n : large);
        lut[i] = a.lut_src[bucket * 4 + h] * LOG2E; }
    f32x16 va[2], ob[2]; float la, lb;
    LAS float* park = (LAS float*)(lds + PARK_OFF) + (tid >> 6) * 2048 + (tid & 63);
    pipe_run<64, 0, 2, true>(a, bh, qb, lds, tid, va, la);
    { const float i0 = 1.0f / la;
#pragma unroll
      for (int r = 0; r < 16; ++r) { park[r * 64] = va[0][r] * i0; park[(16 + r) * 64] = va[1][r] * i0; } }
    pipe_run<64, 2, 2, true>(a, bh, qb, lds, tid, ob, lb);
#pragma unroll
    for (int r = 0; r < 16; ++r) { va[0][r] = park[r * 64]; va[1][r] = park[(16 + r) * 64]; }
    float s1 = 0.f, s2 = 0.f;
    for (int i = 0; i < 32; ++i) { s1 += a.lam_src[i] * a.lam_src[32 + i]; s2 += a.lam_src[64 + i] * a.lam_src[96 + i]; }
    const float lam = expf(s1) - expf(s2) + a.lam_init, i1 = lam / lb;
    va[0] = va[0] - ob[0] * i1; va[1] = va[1] - ob[1] * i1;
    float s = 0.f;
#pragma unroll
    for (int r = 0; r < 16; ++r) s += va[0][r] * va[0][r] + va[1][r] * va[1][r];
    s += __shfl_xor(s, 32);
    const float rn = 1.0f / sqrtf(s * (1.0f / 64.0f) + EPS);
    va[0] = va[0] * rn; va[1] = va[1] * rn;
    store_rows(a, bh, qb, tid, va);
}
}

__device__ __forceinline__ void attention_phase(const Ctx& c, int l) {
    bf16_t* Y = c.wsb(WS_R);
    for (int u = c.bid; u < 1024; u += c.G) {
        const int type = u >> 8, v = u & 255, bh = v & 7, qb = v >> 3;
        int tid_u = c.tid; asm volatile("" : "+v"(tid_u));
        if (type == 0 && EN(8)) { att::Args a{c.wsb(WS_QC), c.wsb(WS_KC), c.wsb(WS_VC), Y, 512, 0, 4, c.kp->in[I_T5], c.kp->in[I_DLAM] + l * 128, lambda_init(l)}; att::unit_diff(a, bh, qb, c.lds, tid_u); }
        else if (type == 1 && EN(9)) { att::Args a{c.wsb(WS_QB), c.wsb(WS_KB), c.wsb(WS_VB), Y, 256, 0, 4, nullptr, nullptr, 0.f}; att::unit_plain<96>(a, bh, qb, c.lds, tid_u); }
        else if (type == 2 && EN(10)) { att::Args a{c.wsb(WS_QD), c.wsb(WS_KD), c.wsb(WS_VD), Y, 768, 1, 2, nullptr, nullptr, 0.f}; att::unit_plain<64>(a, bh, qb, c.lds, tid_u); }
        else if (type == 3 && EN(11)) { att::Args a{c.wsb(WS_QA), c.wsb(WS_KA), c.wsb(WS_VA), Y, 0, 0, 4, c.kp->in[I_NARPB] + l * 4 * 465, nullptr, 0.f}; att::unit<2, 64>(a, bh, qb, c.lds, tid_u); }
    }
}

__device__ __forceinline__ void ynorm_phase(const Ctx& c) {
    const int gw = c.bid * NWAVES + c.wave, NGW = c.G * NWAVES; bf16_t* Y = c.wsb(WS_R);
    for (int row = gw; row < MROWS; row += NGW) {
        u32x4* yr = (u32x4*)(Y + (size_t)row * DM + c.lane * 16);
        const u32x4 u0 = yr[0], u1 = yr[1]; float v[16]; unpack8(u0, v); unpack8(u1, v + 8);
        float s = 0.f;
#pragma unroll
        for (int j = 0; j < 16; ++j) s += v[j] * v[j];
        s += __shfl_xor(s, 1); s += __shfl_xor(s, 2); s += __shfl_xor(s, 4); s += __shfl_xor(s, 8);
        const float rs = 1.0f / sqrtf(s * (1.0f / 256.0f) + EPS);
        if ((c.lane >> 4) != 2) {
#pragma unroll
            for (int j = 0; j < 16; ++j) v[j] *= rs;
            yr[0] = pack8(v); yr[1] = pack8(v + 8);
        }
    }
}
__device__ __forceinline__ void final_phase(const Ctx& c) {
    const int gw = c.bid * NWAVES + c.wave, NGW = c.G * NWAVES; float* X = c.kp->out; const float* ss3 = c.ssp(2); const float* gf = c.kp->in[I_FINN] + DM;
    for (int row = gw; row < MROWS; row += NGW) {
        const float rs = 1.0f / sqrtf(pg8::sum16(ss3 + (size_t)row * 16) * (1.0f / DM) + EPS);
        f32x4* xr = (f32x4*)(X + (size_t)row * DM) + c.lane;
#pragma unroll
        for (int j = 0; j < 4; ++j) { const f32x4 g = *((const f32x4*)gf + c.lane + 64 * j); xr[64 * j] = xr[64 * j] * g * rs; }
    }
}

constexpr int N_PHASES = 21;
__device__ __forceinline__ void run_kind(const Ctx& c, int kind, int l) {
    using namespace pg8;
    const int G = c.G, bid = c.bid;
    switch (kind) {
        case 0: case 7: if (EN(0)) {
            const bool second = kind == 7;
            Gemm g{c.wsb(WS_XB), c.wsb(second ? WS_WGU2 : WS_WGU1), MROWS, 2 * DFF, DM}; StaticOrder S; S.init(MROWS, 2 * DFF, G, bid);
            RowScale rsc; if (second) { rsc.ss1 = nullptr; rsc.ssp = c.ssp(1); rsc.ssgp = nullptr; } else if (l == 0) { rsc.ss1 = c.ss0(); rsc.ssp = nullptr; rsc.ssgp = nullptr; } else { rsc.ss1 = nullptr; rsc.ssp = c.ssp(2); rsc.ssgp = c.ssp(3); }
            EpiSwiGLU E{c.wsb(WS_R), rsc};
            gemm_phase<EpiSwiGLU, StaticOrder, true, true>(c.lds, g, S, E, c.tid);
        } break;
        case 1: case 8: if (EN(1)) {
            const bool second = kind == 8;
            Gemm g{c.wsb(WS_R), c.wsb(second ? WS_WD2 : WS_WD1), MROWS, DM, DFF}; StaticOrder S; S.init(MROWS, DM, G, bid);
            EpiResid E;
            E.alpha = 0.5f; E.out = c.kp->out; E.outb = c.wsb(WS_XB);
            if (second) { E.base = c.kp->out; E.bss = nullptr; E.bg = nullptr; E.ss_out = c.ssp(2); E.gf = c.kp->in[I_FINN] + l * DM; E.ssg_out = c.ssp(3); }
            else { E.ss_out = c.ssp(0); E.gf = nullptr; E.ssg_out = nullptr;
                   if (l == 0) { E.base = c.kp->in[I_X]; E.bss = nullptr; E.bg = nullptr; } else { E.base = c.kp->out; E.bss = c.ssp(2); E.bg = c.kp->in[I_FINN] + (l - 1) * DM; } }
            gemm_phase<EpiResid, StaticOrder, true, true>(c.lds, g, S, E, c.tid);
        } break;
        case 2: if (EN(2)) {
            Gemm g{c.wsb(WS_XB), c.wsb(WS_WIN), MROWS, NIN, DM}; StaticOrder S; S.init(MROWS, NIN, G, bid);
            RowScale rsc{nullptr, c.ssp(0), nullptr};
            EpiScaleBf16 E{c.wsb(WS_R), NIN, rsc};
            gemm_phase<EpiScaleBf16, StaticOrder, true, true>(c.lds, g, S, E, c.tid);
        } break;
        case 3: if (EN(3)) for (int T = bid; T < MROWS / 64; T += G) prep_unit(c, l, T); break;
        case 4: if (EN(4)) attention_phase(c, l); break;
        case 5: if (EN(5)) ynorm_phase(c); break;
        case 6: if (EN(6)) {
            Gemm g{c.wsb(WS_R), c.wsb(WS_WOUT), MROWS, DM, DM}; StaticOrder S; S.init(MROWS, DM, G, bid);
            EpiResid E; E.base = c.kp->out; E.bss = nullptr; E.bg = nullptr; E.alpha = 1.0f; E.out = c.kp->out; E.outb = c.wsb(WS_XB); E.ss_out = c.ssp(1); E.gf = nullptr; E.ssg_out = nullptr;
            gemm_phase<EpiResid, StaticOrder, true, true>(c.lds, g, S, E, c.tid);
        } break;
        default: break;
    }
}

__global__ void __launch_bounds__(NTHREADS, 2) fwd_megakernel(Params p) {
    extern __shared__ __attribute__((aligned(16))) unsigned char lds_raw[];
    cg::grid_group grid = cg::this_grid();
    const int ph_lo = p.ph_lo, ph_hi = p.ph_hi;
    const int wave_id = __builtin_amdgcn_readfirstlane((int)threadIdx.x >> 6);
    {
        volatile LAS unsigned* st0 = (volatile LAS unsigned*)((LAS unsigned char*)lds_raw + LDS_MISC);
        if (threadIdx.x < 4) st0[threadIdx.x] = 0u;
        __syncthreads();
        (void)xcd_barrier_post((unsigned*)p.ws, st0);
    }
    for (int ph = ph_lo; ph < ph_hi; ++ph) {
        if (ph == ph_lo + 1) grid.sync();
        else if (ph > ph_lo + 1) { XcdBarrier xb; xb.bar = (unsigned*)((KParams)__builtin_amdgcn_kernarg_segment_ptr())->ws; xb.x = xb_xcc_id(); xb.st = (volatile LAS unsigned*)((LAS unsigned char*)lds_raw + LDS_MISC); xcd_barrier(xb); }
        KParams kp = (KParams)__builtin_amdgcn_kernarg_segment_ptr();
        asm volatile("" : "+s"(kp));
        int lane_; asm volatile("v_mbcnt_lo_u32_b32 %0, -1, 0\n\tv_mbcnt_hi_u32_b32 %0, -1, %0" : "=v"(lane_));
        int tid_ = wave_id * 64 + lane_, bid_ = blockIdx.x, G_ = gridDim.x; unsigned lds_ = (unsigned)(uintptr_t)(LAS unsigned char*)lds_raw;
        asm volatile("" : "+v"(tid_)); asm volatile("" : "+s"(bid_)); asm volatile("" : "+s"(G_)); asm volatile("" : "+s"(lds_));
        Ctx c; c.kp = kp; c.lds = (LAS unsigned char*)(uintptr_t)lds_; c.tid = tid_; c.lane = c.tid & 63; c.wave = __builtin_amdgcn_readfirstlane(c.tid >> 6); c.G = G_; c.bid = bid_;
        if (ph == 0) { if (EN(16)) prologue(c); }
        else if (ph == 10) { if (EN(18)) wconv_layer(c, 1); }
        else if (ph == 20) { if (EN(17)) final_phase(c); }
        else { const int l = ph > 10 ? 1 : 0; run_kind(c, ph - 1 - 10 * l, l); if (MK_DUP >= 0 && ph - 1 - 10 * l == MK_DUP) { __syncthreads(); run_kind(c, ph - 1 - 10 * l, l); } }
    }
}

extern "C" void kernel_launch(void* const* d_in, const int* in_sizes, int n_in, void* d_out, int out_size, void* d_ws, size_t ws_size, hipStream_t stream) {
    static int grid = 0;
    if (grid == 0) {
        if (n_in != 32 || out_size != MROWS * DM || ws_size < WS_END) { fprintf(stderr, "kernel_launch: unexpected shapes (n_in %d, out %d, ws %zu)\n", n_in, out_size, ws_size); grid = -1; return; }
        int dev = 0, cus = 0, per_cu = 0;
        hipGetDevice(&dev); hipDeviceGetAttribute(&cus, hipDeviceAttributeMultiprocessorCount, dev);
        hipFuncSetAttribute((const void*)fwd_megakernel, hipFuncAttributeMaxDynamicSharedMemorySize, LDS_BYTES);
        hipOccupancyMaxActiveBlocksPerMultiprocessor(&per_cu, (const void*)fwd_megakernel, NTHREADS, LDS_BYTES);
        if (per_cu < 1) { fprintf(stderr, "kernel_launch: occupancy query says %d blocks per CU\n", per_cu); per_cu = 1; }
        (void)hipGetLastError();
        grid = cus * 1;
    }
    if (grid < 0) return;
    if (hipMemsetAsync((char*)d_ws + WS_BAR, 0, BAR_ZERO_BYTES, stream) != hipSuccess) { fprintf(stderr, "kernel_launch: memset of barrier words failed\n"); return; }
    Params p{};
    for (int i = 0; i < 32; ++i) p.in[i] = (const float*)d_in[i];
    p.out = (float*)d_out; p.ws = (unsigned char*)d_ws;
#if MK_SPLIT
    for (int ph = 0; ph < N_PHASES; ++ph) {
        p.ph_lo = ph; p.ph_hi = ph + 1; void* args[] = {&p};
        hipError_t e = hipLaunchCooperativeKernel((const void*)fwd_megakernel, dim3(grid), dim3(NTHREADS), args, LDS_BYTES, stream);
        if (e != hipSuccess) { fprintf(stderr, "cooperative launch failed: %s (grid %d)\n", hipGetErrorString(e), grid); break; }
    }
#else
    p.ph_lo = 0; p.ph_hi = N_PHASES; void* args[] = {&p};
    hipError_t e = hipLaunchCooperativeKernel((const void*)fwd_megakernel, dim3(grid), dim3(NTHREADS), args, LDS_BYTES, stream);
    if (e != hipSuccess) fprintf(stderr, "cooperative launch failed: %s (grid %d)\n", hipGetErrorString(e), grid);
#endif
}
```

```cpp
#include <hip/hip_runtime.h>
#include <hip/hip_cooperative_groups.h>
#include <cstdio>
#include <cstdint>
namespace cg = cooperative_groups;

#ifndef MK_ENABLE
#define MK_ENABLE 0xFFFFFF
#endif
#define EN(k) ((MK_ENABLE >> (k)) & 1)
#ifndef MK_DUP
#define MK_DUP -1
#endif
#ifndef MK_SPLIT
#define MK_SPLIT 0
#endif

#define LAS __attribute__((address_space(3)))
typedef unsigned short bf16_t;
typedef short bf16x8 __attribute__((ext_vector_type(8)));
typedef float f32x4 __attribute__((ext_vector_type(4)));
typedef float f32x16 __attribute__((ext_vector_type(16)));
typedef unsigned u32x4 __attribute__((ext_vector_type(4)));
typedef unsigned u32x2 __attribute__((ext_vector_type(2)));
typedef float f32x2_t __attribute__((ext_vector_type(2)));
typedef __bf16 bf16x2_t __attribute__((ext_vector_type(2)));

constexpr int BATCH = 2, SEQ = 8192, DM = 1024, MROWS = BATCH * SEQ, DFF = 2816, NIN = 2560, NTILE = SEQ / 64, DEPTH = 2;
constexpr float EPS = 1e-6f;
constexpr float LOG2E = 1.4426950408889634f;
constexpr int NWAVES = 8, NTHREADS = 512;

constexpr size_t MiB = 1u << 20;
constexpr size_t WS_SS0 = 65536;
constexpr size_t WS_SSP = 252 * MiB;
constexpr size_t WS_TAB = 1 * MiB;
constexpr size_t WS_WGU1 = 3 * MiB, WS_WD1 = 14 * MiB, WS_WIN = 19 * MiB + 512 * 1024, WS_WOUT = 24 * MiB + 512 * 1024, WS_WGU2 = 26 * MiB + 512 * 1024, WS_WD2 = 37 * MiB + 512 * 1024;
constexpr size_t WS_WUQ = 43 * MiB, WS_WUKV = 43 * MiB + 256 * 1024;
constexpr size_t WS_XB = 44 * MiB;
constexpr size_t WS_R = 76 * MiB;
constexpr size_t WS_QA = 156 * MiB, WS_KA = 164 * MiB, WS_VA = 172 * MiB, WS_QB = 180 * MiB, WS_KB = 192 * MiB, WS_VB = 204 * MiB;
constexpr size_t WS_QC = 212 * MiB, WS_KC = 220 * MiB, WS_VC = 228 * MiB, WS_QD = 236 * MiB, WS_KD = 244 * MiB, WS_VD = 248 * MiB, WS_END = 256 * MiB;
constexpr int LDS_BYTES = 147456;
constexpr int LDS_MISC = LDS_BYTES - 64;
constexpr size_t WS_BAR = 0, BAR_ZERO_BYTES = 16384;

__device__ __forceinline__ unsigned pk2(float lo, float hi) { f32x2_t v = {lo, hi}; bf16x2_t b = __builtin_convertvector(v, bf16x2_t); return __builtin_bit_cast(unsigned, b); }
__device__ __forceinline__ float bf2f(unsigned short u) { return __uint_as_float(((unsigned)u) << 16); }
__device__ __forceinline__ void unpack8(const u32x4 u, float* v) {
    v[0] = __uint_as_float(u.x << 16); v[1] = __uint_as_float(u.x & 0xffff0000u); v[2] = __uint_as_float(u.y << 16); v[3] = __uint_as_float(u.y & 0xffff0000u);
    v[4] = __uint_as_float(u.z << 16); v[5] = __uint_as_float(u.z & 0xffff0000u); v[6] = __uint_as_float(u.w << 16); v[7] = __uint_as_float(u.w & 0xffff0000u);
}
__device__ __forceinline__ u32x4 pack8(const float* v) { u32x4 u; u.x = pk2(v[0], v[1]); u.y = pk2(v[2], v[3]); u.z = pk2(v[4], v[5]); u.w = pk2(v[6], v[7]); return u; }
__device__ __forceinline__ float wave_sum(float v) {
#pragma unroll
    for (int o = 1; o < 64; o <<= 1) v += __shfl_xor(v, o);
    return v;
}

namespace pg8 {
constexpr int BM = 256, BK = 64, HALF = 128, HTB = HALF * BK * 2, STAGE_BYTES = 8 * HTB, NXCD = 8, WGM = 8;
__host__ __device__ __forceinline__ int lds_byte(int r, int c) { const int st = (r >> 4) * 2 + (c >> 5), rr = r & 15, cc = c & 31, ob = rr * 64 + cc * 2; return st * 1024 + (ob ^ (((ob >> 9) & 1) << 5)); }
__host__ __device__ __forceinline__ void stage_rc(int b, int& R, int& C) { const int st = b / 1024, sb = b % 1024, swz = sb ^ (((sb >> 9) & 1) << 5); R = (st >> 1) * 16 + swz / 64; C = (st & 1) * 32 + (swz % 64) / 2; }
__host__ __device__ __forceinline__ int perm32(int rho) { const int n = rho >> 4, i = rho & 15; return 8 * (i >> 2) + 4 * n + (i & 3); }
struct Unit { int pm, pn; };
struct Gemm { const bf16_t* A; const bf16_t* Bt; int M, N, K; };
struct StaticOrder {
    int nM, nN, nwg, G, c;
    __host__ __device__ void init(int M, int N, int G_, int c_) { nM = M / BM; nN = N / BM; nwg = nM * nN; G = G_; c = c_; }
    __host__ __device__ bool next(int i, Unit& u) const {
        const long L = (long)i * G + c; if (L >= nwg) return false;
        int wgid = (int)L; { const int q = nwg / NXCD, r = nwg % NXCD, xcd = wgid % NXCD, off = wgid / NXCD; wgid = (xcd < r ? xcd * (q + 1) : r * (q + 1) + (xcd - r) * q) + off; }
        const int nig = WGM * nN, gid = wgid / nig, fm = gid * WGM, gsz = (nM - fm) < WGM ? (nM - fm) : WGM;
        u.pm = fm + ((wgid % nig) % gsz); u.pn = (wgid % nig) / gsz; return true;
    }
    __device__ __forceinline__ void a_ready(const Unit&) const {}
    __device__ __forceinline__ void done(const Unit&) const {}
};

__device__ __forceinline__ float sum16(const float* p) {
    const f32x4 a = *(const f32x4*)p, b = *(const f32x4*)(p + 4), c = *(const f32x4*)(p + 8), d = *(const f32x4*)(p + 12);
    return (((a[0] + a[1]) + (a[2] + a[3])) + ((b[0] + b[1]) + (b[2] + b[3]))) + (((c[0] + c[1]) + (c[2] + c[3])) + ((d[0] + d[1]) + (d[2] + d[3])));
}
struct RowScale {
    const float* ss1; const float* ssp; const float* ssgp;
    __device__ __forceinline__ float get(int row) const {
        const float s = ss1 ? ss1[row] : sum16(ssp + (size_t)row * 16);
        float rs = 1.0f / sqrtf(s * (1.0f / DM) + EPS);
        if (ssgp) { const float rsn = 1.0f / sqrtf(rs * rs * sum16(ssgp + (size_t)row * 16) * (1.0f / DM) + EPS); rs *= rsn; }
        return rs;
    }
};

struct EpiSwiGLU {
    static constexpr bool PERM = true, AFTER_DRAIN = false;
    bf16_t* O; RowScale rsc;
    __device__ __forceinline__ void operator()(const f32x4 (&acc)[2][2][4][2], const Unit& u, int wr, int wc, int fr, int fq) const {
        const int row0 = u.pm * BM + wr * 64 + fr, col0 = u.pn * HALF + wc * 32 + 8 * fq;
#pragma unroll
        for (int ai = 0; ai < 2; ++ai)
#pragma unroll
            for (int m = 0; m < 4; ++m) {
                const int row = row0 + ai * HALF + m * 16; const float rs = rsc.get(row);
                float a[8];
#pragma unroll
                for (int n = 0; n < 2; ++n)
#pragma unroll
                    for (int i = 0; i < 4; ++i) {
                        const float g = acc[ai][0][m][n][i] * rs, up = acc[ai][1][m][n][i] * rs;
                        const float sg = g * __builtin_amdgcn_rcpf(1.0f + __builtin_amdgcn_exp2f(-g * LOG2E));
                        a[n * 4 + i] = sg * up;
                    }
                *(u32x4*)(O + (size_t)row * DFF + col0) = pack8(a);
            }
    }
};
struct EpiScaleBf16 {
    static constexpr bool PERM = true, AFTER_DRAIN = false;
    bf16_t* O; int ldo; RowScale rsc;
    __device__ __forceinline__ void operator()(const f32x4 (&acc)[2][2][4][2], const Unit& u, int wr, int wc, int fr, int fq) const {
        const int row0 = u.pm * BM + wr * 64 + fr, col0 = u.pn * BM + wc * 32 + 8 * fq;
#pragma unroll
        for (int ai = 0; ai < 2; ++ai)
#pragma unroll
            for (int m = 0; m < 4; ++m) {
                const int row = row0 + ai * HALF + m * 16; const float rs = rsc.get(row);
#pragma unroll
                for (int bj = 0; bj < 2; ++bj) {
                    float a[8];
#pragma unroll
                    for (int n = 0; n < 2; ++n)
#pragma unroll
                        for (int i = 0; i < 4; ++i) a[n * 4 + i] = acc[ai][bj][m][n][i] * rs;
                    *(u32x4*)(O + (size_t)row * ldo + col0 + bj * HALF) = pack8(a);
                }
            }
    }
};
struct EpiResid {
    static constexpr bool PERM = false, AFTER_DRAIN = false;
    const float* base; const float* bss; const float* bg; float alpha; float* out; bf16_t* outb; float* ss_out; const float* gf; float* ssg_out;
    __device__ __forceinline__ void operator()(const f32x4 (&acc)[2][2][4][2], const Unit& u, int wr, int wc, int fr, int fq) const {
        const int row0 = u.pm * BM + wr * 64 + fr, col0 = u.pn * BM + wc * 32 + 4 * fq;
#pragma unroll
        for (int ai = 0; ai < 2; ++ai)
#pragma unroll
            for (int m = 0; m < 4; ++m) {
                const int row = row0 + ai * HALF + m * 16; const size_t off = (size_t)row * DM + col0;
                float brs = 1.0f; if (bss) brs = 1.0f / sqrtf(sum16(bss + (size_t)row * 16) * (1.0f / DM) + EPS);
                float s = 0.f, sg = 0.f;
#pragma unroll
                for (int bj = 0; bj < 2; ++bj)
#pragma unroll
                    for (int n = 0; n < 2; ++n) {
                        const int co = bj * HALF + n * 16;
                        f32x4 b = *(const f32x4*)(base + off + co);
                        if (bss) { const f32x4 g = *(const f32x4*)(bg + col0 + co); b = b * g * brs; }
                        const f32x4 v = b + acc[ai][bj][m][n] * alpha;
                        *(f32x4*)(out + off + co) = v;
                        u32x2 w; w.x = pk2(v[0], v[1]); w.y = pk2(v[2], v[3]); *(u32x2*)(outb + off + co) = w;
                        s += (v[0] * v[0] + v[1] * v[1]) + (v[2] * v[2] + v[3] * v[3]);
                        if (gf) { const f32x4 g2 = *(const f32x4*)(gf + col0 + co); const f32x4 t = v * g2; sg += (t[0] * t[0] + t[1] * t[1]) + (t[2] * t[2] + t[3] * t[3]); }
                    }
                s += __shfl_xor(s, 16); s += __shfl_xor(s, 32);
                if (fq == 0) ss_out[(size_t)row * 16 + u.pn * 4 + wc] = s;
                if (gf) { sg += __shfl_xor(sg, 16); sg += __shfl_xor(sg, 32); if (fq == 0) ssg_out[(size_t)row * 16 + u.pn * 4 + wc] = sg; }
            }
    }
};

template <class Epi, class Sched, bool ALIGN_EPI = false, bool SP2 = false>
__device__ __forceinline__ void gemm_phase(LAS unsigned char* lds, const Gemm g, const Sched& S, const Epi& E, const int tid) {
    const int wid = __builtin_amdgcn_readfirstlane(tid >> 6), lane = tid & 63, wr = wid >> 2, wc = wid & 3, fr = lane & 15, fq = lane >> 4;
    const int K = g.K, nt = K / BK;
    unsigned voffA[2], voffB[2];
#pragma unroll
    for (int i = 0; i < 2; ++i) { int R, C; stage_rc(tid * 16 + i * 8192, R, C); const int Rb = Epi::PERM ? ((R & ~31) + perm32(R & 31)) : R;
        voffA[i] = (unsigned)(R * K + C) * 2u; voffB[i] = (unsigned)(Rb * K + C) * 2u; }
    const size_t kstep = (size_t)(BK * 2);
    const size_t hstep = (size_t)HALF * K * 2;
    const size_t tstep = 2 * hstep;
    const unsigned ldsw = (unsigned)wid * 1024u;
    const int aoff = lds_byte(wr * 64 + fr, fq * 8), boff = lds_byte(wc * 32 + fr, fq * 8);
#define PG8_SA(b, h) (((b) * 2 + (h)) * HTB)
#define PG8_SB(b, h) ((4 + (b) * 2 + (h)) * HTB)
#define PG8_STAGE(bufoff, gbase, voff) do { _Pragma("unroll") for (int _i = 0; _i < 2; ++_i) \
        __builtin_amdgcn_global_load_lds((const unsigned*)((const char*)(gbase) + (voff)[_i]), (LAS unsigned*)(lds + (bufoff) + ldsw + _i * 8192), 16, 0, 0); } while (0)
#define PG8_LDA(dst, b, h) do { _Pragma("unroll") for (int m = 0; m < 4; ++m) _Pragma("unroll") for (int k = 0; k < 2; ++k) dst[m][k] = *(const LAS bf16x8*)(lds + PG8_SA(b, h) + aoff + m * 2048 + k * 1024); } while (0)
#define PG8_LDB(dst, b, h) do { _Pragma("unroll") for (int n = 0; n < 2; ++n) _Pragma("unroll") for (int k = 0; k < 2; ++k) dst[n][k] = *(const LAS bf16x8*)(lds + PG8_SB(b, h) + boff + n * 2048 + k * 1024); } while (0)
#define PG8_MMA(ai, bj, At, Bt) do { __builtin_amdgcn_s_setprio(1); _Pragma("unroll") for (int m = 0; m < 4; ++m) _Pragma("unroll") for (int n = 0; n < 2; ++n) _Pragma("unroll") for (int k = 0; k < 2; ++k) \
        acc[ai][bj][m][n] = __builtin_amdgcn_mfma_f32_16x16x32_bf16(Bt[n][k], At[m][k], acc[ai][bj][m][n], 0, 0, 0); __builtin_amdgcn_s_setprio(0); } while (0)
#define PG8_WAIT_V(n) asm volatile("s_waitcnt vmcnt(" #n ")" ::: "memory")
#define PG8_WAIT_L(n) asm volatile("s_waitcnt lgkmcnt(" #n ")" ::: "memory")
#define PG8_BAR __builtin_amdgcn_s_barrier()
#define PG8_SCHED __builtin_amdgcn_sched_barrier(0)
    Unit cur, nxt; int ui = 0;
    if (!S.next(0, cur)) return;
    f32x4 acc[2][2][4][2];
#pragma unroll
    for (int a = 0; a < 2; ++a)
#pragma unroll
        for (int b = 0; b < 2; ++b)
#pragma unroll
            for (int m = 0; m < 4; ++m)
#pragma unroll
                for (int n = 0; n < 2; ++n) acc[a][b][m][n] = (f32x4){0.f, 0.f, 0.f, 0.f};
    bf16x8 At[4][2], B0[2][2], B1[2][2];
    const char* cA = (const char*)g.A + (size_t)cur.pm * tstep; const char* cB = (const char*)g.Bt + (size_t)cur.pn * tstep;
    S.a_ready(cur);
    if constexpr (SP2) {
        PG8_STAGE(PG8_SB(0, 0), cB, voffB); PG8_STAGE(PG8_SB(0, 1), cB + hstep, voffB); PG8_STAGE(PG8_SA(0, 0), cA, voffA); PG8_STAGE(PG8_SA(0, 1), cA + hstep, voffA);
        if (wr == 1) PG8_BAR;
        PG8_WAIT_V(2); PG8_BAR;
        PG8_STAGE(PG8_SB(1, 0), cB + kstep, voffB); PG8_STAGE(PG8_SA(1, 0), cA + kstep, voffA); PG8_STAGE(PG8_SB(1, 1), cB + hstep + kstep, voffB);
        PG8_WAIT_V(6); PG8_BAR;
    } else {
        PG8_STAGE(PG8_SB(0, 0), cB, voffB); PG8_STAGE(PG8_SA(0, 0), cA, voffA); PG8_STAGE(PG8_SB(0, 1), cB + hstep, voffB); PG8_STAGE(PG8_SA(0, 1), cA + hstep, voffA);
        if (wr == 1) PG8_BAR;
        PG8_WAIT_V(4); PG8_BAR;
        PG8_STAGE(PG8_SB(1, 0), cB + kstep, voffB); PG8_STAGE(PG8_SA(1, 0), cA + kstep, voffA); PG8_STAGE(PG8_SB(1, 1), cB + hstep + kstep, voffB);
        PG8_WAIT_V(6); PG8_BAR;
    }
    for (;;) {
        const bool has_next = S.next(ui + 1, nxt);
        const char* nA = has_next ? (const char*)g.A + (size_t)nxt.pm * tstep : cA; const char* nB = has_next ? (const char*)g.Bt + (size_t)nxt.pn * tstep : cB;
        for (int t = 0; t < nt; t += 2) {
            const bool last = (t == nt - 2);
            const char* a1 = cA + (size_t)(t + 1) * kstep;
            const char* a2 = last ? nA : cA + (size_t)(t + 2) * kstep; const char* b2 = last ? nB : cB + (size_t)(t + 2) * kstep;
            const char* a3 = a2 + kstep; const char* b3 = b2 + kstep;
            if (last && has_next) S.a_ready(nxt);
            if constexpr (SP2) {
            PG8_LDB(B0, 0, 0); PG8_LDB(B1, 0, 1); PG8_SCHED; PG8_LDA(At, 0, 0); PG8_STAGE(PG8_SA(1, 1), a1 + hstep, voffA);
            PG8_WAIT_V(8); PG8_WAIT_L(0); PG8_BAR; PG8_MMA(0, 0, At, B0); PG8_MMA(0, 1, At, B1); PG8_BAR; PG8_SCHED;
            PG8_LDA(At, 0, 1); PG8_STAGE(PG8_SB(0, 0), b2, voffB); PG8_STAGE(PG8_SB(0, 1), b2 + hstep, voffB); PG8_STAGE(PG8_SA(0, 0), a2, voffA);
            PG8_WAIT_V(8); PG8_WAIT_L(0); PG8_BAR; PG8_MMA(1, 0, At, B0); PG8_MMA(1, 1, At, B1); PG8_BAR; PG8_SCHED;
            PG8_LDB(B0, 1, 0); PG8_LDB(B1, 1, 1); PG8_SCHED; PG8_LDA(At, 1, 0); PG8_STAGE(PG8_SA(0, 1), a2 + hstep, voffA);
            PG8_WAIT_V(8); PG8_WAIT_L(0); PG8_BAR; PG8_MMA(0, 0, At, B0); PG8_MMA(0, 1, At, B1); PG8_BAR; PG8_SCHED;
            PG8_LDA(At, 1, 1); PG8_STAGE(PG8_SB(1, 0), b3, voffB); PG8_STAGE(PG8_SB(1, 1), b3 + hstep, voffB); PG8_STAGE(PG8_SA(1, 0), a3, voffA);
            PG8_WAIT_V(8); PG8_WAIT_L(0); PG8_BAR; PG8_MMA(1, 0, At, B0); PG8_MMA(1, 1, At, B1); PG8_BAR; PG8_SCHED;
            } else {
            PG8_LDB(B0, 0, 0); PG8_SCHED; PG8_LDA(At, 0, 0); PG8_STAGE(PG8_SA(1, 1), a1 + hstep, voffA);
            PG8_WAIT_L(8); PG8_BAR; PG8_WAIT_L(0); PG8_MMA(0, 0, At, B0); PG8_BAR; PG8_SCHED;
            PG8_LDB(B1, 0, 1); PG8_STAGE(PG8_SB(0, 0), b2, voffB);
            PG8_BAR; PG8_WAIT_L(0); PG8_MMA(0, 1, At, B1); PG8_BAR;
            PG8_LDA(At, 0, 1); PG8_STAGE(PG8_SA(0, 0), a2, voffA);
            PG8_BAR; PG8_WAIT_L(0); PG8_MMA(1, 0, At, B0); PG8_BAR; PG8_SCHED;
            PG8_STAGE(PG8_SB(0, 1), b2 + hstep, voffB);
            PG8_WAIT_V(6); PG8_BAR; PG8_MMA(1, 1, At, B1); PG8_BAR;
            PG8_LDB(B0, 1, 0); PG8_SCHED; PG8_LDA(At, 1, 0); PG8_STAGE(PG8_SA(0, 1), a2 + hstep, voffA);
            PG8_WAIT_L(8); PG8_BAR; PG8_WAIT_L(0); PG8_MMA(0, 0, At, B0); PG8_BAR; PG8_SCHED;
            PG8_LDB(B1, 1, 1); PG8_STAGE(PG8_SB(1, 0), b3, voffB);
            PG8_BAR; PG8_WAIT_L(0); PG8_MMA(0, 1, At, B1); PG8_BAR;
            PG8_LDA(At, 1, 1); PG8_STAGE(PG8_SA(1, 0), a3, voffA);
            PG8_BAR; PG8_WAIT_L(0); PG8_MMA(1, 0, At, B0); PG8_BAR; PG8_SCHED;
            PG8_STAGE(PG8_SB(1, 1), b3 + hstep, voffB);
            PG8_WAIT_V(6); PG8_BAR; PG8_MMA(1, 1, At, B1); PG8_BAR;
            }
        }
        if constexpr (ALIGN_EPI) { if (wr == 0) PG8_BAR; }
        if constexpr (!Epi::AFTER_DRAIN) { E(acc, cur, wr, wc, fr, fq); S.done(cur); }
        if (!has_next) break;
#pragma unroll
        for (int a = 0; a < 2; ++a)
#pragma unroll
            for (int b = 0; b < 2; ++b)
#pragma unroll
                for (int m = 0; m < 4; ++m)
#pragma unroll
                    for (int n = 0; n < 2; ++n) acc[a][b][m][n] = (f32x4){0.f, 0.f, 0.f, 0.f};
        cur = nxt; cA = nA; cB = nB; ++ui;
        if constexpr (ALIGN_EPI) { if (wr == 1) PG8_BAR; }
    }
    PG8_WAIT_V(0);
    if constexpr (!ALIGN_EPI) { if (wr == 0) PG8_BAR; }
    PG8_BAR;
#undef PG8_SA
#undef PG8_SB
#undef PG8_STAGE
#undef PG8_LDA
#undef PG8_LDB
#undef PG8_MMA
#undef PG8_WAIT_V
#undef PG8_WAIT_L
#undef PG8_BAR
#undef PG8_SCHED
}
}

#define RLX_AGENT __ATOMIC_RELAXED, __HIP_MEMORY_SCOPE_AGENT
#define XB_TMO      128
#define XB_XCNT(j)  (256  + 64 * (j))
#define XB_XSUB(j)  (1280 + 64 * (j))
#define XB_XGEN(j)  (2304 + 64 * (j))
#define XB_TOP      3328
#define XB_TOPGEN   3392
#define XCD_BAR_WORDS 3456
#define XB_SPIN_CAP (1u << 20)

__device__ __forceinline__ unsigned xb_ld(unsigned* p)              { return __hip_atomic_load(p, __ATOMIC_RELAXED, __HIP_MEMORY_SCOPE_AGENT); }
__device__ __forceinline__ unsigned xb_add(unsigned* p, unsigned v) { return __hip_atomic_fetch_add(p, v, __ATOMIC_RELAXED, __HIP_MEMORY_SCOPE_AGENT); }
__device__ __forceinline__ unsigned xb_xcc_id() { return (unsigned)__builtin_amdgcn_s_getreg((3 << 11) | 20) & 0xFu; }
#define XB_SPIN(cond, bar) do { unsigned _sp = 0; while (cond) { __builtin_amdgcn_s_sleep(1); \
    if ((++_sp & 255u) == 0u) { if (xb_ld(&(bar)[XB_TMO])) break; if (_sp > XB_SPIN_CAP) { atomicAdd(&(bar)[XB_TMO], 1u); break; } } } } while (0)

struct XcdBarrier {
    unsigned* bar; unsigned x;
    volatile LAS unsigned* st;
};

__device__ __forceinline__ XcdBarrier xcd_barrier_post(unsigned* bar, volatile LAS unsigned* st) {
    XcdBarrier b; b.bar = bar; b.x = xb_xcc_id(); b.st = st;
    if (threadIdx.x == 0) (void)xb_add(&bar[XB_XCNT(b.x)], 1u);
    return b;
}
__device__ __forceinline__ void xcd_barrier_complete(unsigned* bar, unsigned x, unsigned& nloc, unsigned& nx) {
    const unsigned G = gridDim.x * gridDim.y * gridDim.z;
    unsigned sum, cnt, mine, sp = 0u;
    for (;;) {
        sum = 0u; cnt = 0u; mine = 0u;
#pragma unroll
        for (unsigned j = 0; j < 16; ++j) { const unsigned c = xb_ld(&bar[XB_XCNT(j)]); sum += c; cnt += (c > 0u) ? 1u : 0u; mine = (j == x) ? c : mine; }
        if (sum == G) break;
        __builtin_amdgcn_s_sleep(1);
        if ((++sp & 255u) == 0u) { if (xb_ld(&bar[XB_TMO])) break; if (sp > XB_SPIN_CAP) { atomicAdd(&bar[XB_TMO], 1u); break; } }
    }
    nloc = mine > 0u ? mine : 1u; nx = cnt > 0u ? cnt : 1u;
}

__device__ __forceinline__ void xcd_barrier(const XcdBarrier& b) {
    asm volatile("s_waitcnt vmcnt(0)" ::: "memory");
    __syncthreads();
    if (threadIdx.x == 0) {
        unsigned* bar = b.bar;
        __builtin_amdgcn_s_waitcnt(0);
        unsigned nloc = b.st[0], nx = b.st[1];
        if (nloc == 0u) { xcd_barrier_complete(bar, b.x, nloc, nx); b.st[0] = nloc; b.st[1] = nx; }
        const unsigned old = xb_add(&bar[XB_XSUB(b.x)], 1u);
        const unsigned gen = old / nloc;
        if (old + 1u == (gen + 1u) * nloc) {
            __builtin_amdgcn_fence(__ATOMIC_RELEASE, "agent");
            asm volatile("s_waitcnt vmcnt(0)" ::: "memory");
            const unsigned og = xb_add(&bar[XB_TOP], 1u);
            const unsigned tg = og / nx;
            if (og + 1u == (tg + 1u) * nx) xb_add(&bar[XB_TOPGEN], 1u);
            else XB_SPIN(xb_ld(&bar[XB_TOPGEN]) == tg, bar);
            __builtin_amdgcn_fence(__ATOMIC_ACQUIRE, "agent");
            xb_add(&bar[XB_XGEN(b.x)], 1u);
            asm volatile("s_waitcnt vmcnt(0)" ::: "memory");
        } else {
            XB_SPIN(xb_ld(&bar[XB_XGEN(b.x)]) == gen, bar);
            __builtin_amdgcn_fence(__ATOMIC_ACQUIRE, "agent");
            asm volatile("s_waitcnt vmcnt(0)" ::: "memory");
        }
    }
    __syncthreads();
}


struct Params { const float* in[32]; float* out; unsigned char* ws; int ph_lo, ph_hi; };
enum { I_X = 0, I_F1N, I_F1G, I_F1U, I_F1D, I_MIXN, I_WIN, I_NAQN, I_NAKN, I_NARPB, I_NABETA, I_MLAQLN, I_MLAWUQ, I_MLAKVLN, I_MLAWUKV, I_MLAQN, I_MLAKN, I_MLABETA,
       I_DQN, I_DKN, I_DLAM, I_DSUBLN, I_GQN, I_GKN, I_GBETA, I_WOUT, I_F2N, I_F2G, I_F2U, I_F2D, I_FINN, I_T5 };
__host__ __device__ __forceinline__ float lambda_init(int l) { return l == 0 ? 0.2f : 0.35550906f; }

typedef const __attribute__((address_space(4))) Params* KParams;
typedef const float* const __attribute__((address_space(4)))* InPtr;
struct Ctx {
    KParams kp; LAS unsigned char* lds; int tid, lane, wave, G, bid;
    __device__ __forceinline__ float* ssp(int k) const { return (float*)(kp->ws + WS_SSP + (size_t)k * MiB); }
    __device__ __forceinline__ float* ss0() const { return (float*)(kp->ws + WS_SS0); }
    __device__ __forceinline__ bf16_t* wsb(size_t off) const { return (bf16_t*)(kp->ws + off); }
};

__device__ __forceinline__ float gain_for(const Ctx& c, int job, int l, int k) {
    InPtr in = c.kp->in;
    switch (job) {
        case 0: { float g = in[I_F1N][l * DM + k]; if (l > 0) g *= in[I_FINN][(l - 1) * DM + k]; return g; }
        case 2: return in[I_MIXN][l * DM + k];
        case 3: { const int gidx = k >> 8, kk = k & 255;
                  if (gidx == 0) return in[I_NABETA][l * 256 + kk];
                  if (gidx == 1) return in[I_MLABETA][l * 256 + kk];
                  if (gidx == 2) return in[I_DSUBLN][l * 64 + (kk & 63)] * (1.0f - lambda_init(l));
                  return in[I_GBETA][l * 256 + kk]; }
        case 4: return in[I_F2N][l * DM + k];
        case 6: return in[I_MLAQLN][l * 256 + k];
        case 7: return in[I_MLAKVLN][l * 128 + k];
        default: return 1.0f;
    }
}
__device__ __forceinline__ void tr_item64(const Ctx& c, const float* W0, const float* W1, int Nsrc, int sc0, int sc1, bf16_t* WT, int K, int n0, int k0, int job, int l, LAS float* scr) {
    const int lane = c.lane, hh = (lane & 15) >> 3, cc = 4 * (lane & 7);
    const float* W = hh ? W1 : W0; const int sc = hh ? sc1 : sc0;
    f32x4 v[16];
#pragma unroll
    for (int i = 0; i < 16; ++i) { const int kk = 4 * i + (lane >> 4);
        v[i] = (f32x4){0.f, 0.f, 0.f, 0.f}; if (sc >= 0) v[i] = *(const f32x4*)(W + (size_t)(k0 + kk) * Nsrc + sc + cc); }
#pragma unroll
    for (int i = 0; i < 16; ++i) { const int kk = 4 * i + (lane >> 4); LAS float* d = scr + kk * 65 + 4 * (lane & 15);
        d[0] = v[i][0]; d[1] = v[i][1]; d[2] = v[i][2]; d[3] = v[i][3]; }
    asm volatile("s_waitcnt lgkmcnt(0)" ::: "memory");
    const int ch = lane & 7;
    float g[8];
#pragma unroll
    for (int i = 0; i < 8; ++i) g[i] = gain_for(c, job, l, k0 + 8 * ch + i);
#pragma unroll
    for (int j = 0; j < 8; ++j) { const int n = (lane >> 3) + 8 * j; const LAS float* s = scr + (8 * ch) * 65 + n;
        u32x4 o; o.x = pk2(s[0 * 65] * g[0], s[1 * 65] * g[1]); o.y = pk2(s[2 * 65] * g[2], s[3 * 65] * g[3]); o.z = pk2(s[4 * 65] * g[4], s[5 * 65] * g[5]); o.w = pk2(s[6 * 65] * g[6], s[7 * 65] * g[7]);
        *(u32x4*)(WT + (size_t)(n0 + n) * K + k0 + 8 * ch) = o; }
    asm volatile("s_waitcnt lgkmcnt(0)" ::: "memory");
}
__device__ __forceinline__ void wconv_layer(const Ctx& c, int l) {
    LAS float* scr = (LAS float*)(c.lds + c.wave * 16640);
    const int gw = c.bid * NWAVES + c.wave, NGW = c.G * NWAVES;
    constexpr int C0 = 16 * 88, C1 = 44 * 16, C2 = 16 * 40, C3 = 16 * 16, C6 = 4 * 6, C7 = 2 * 8;
    constexpr int NITEMS = 2 * C0 + 2 * C1 + C2 + C3 + C6 + C7;
    InPtr in = c.kp->in;
    for (int it = gw; it < NITEMS; it += NGW) {
        int r = it;
        if (r < C0 || (r >= C0 + C1 + C2 + C3 && r < 2 * C0 + C1 + C2 + C3)) {
            const bool second = r >= C0; if (second) r -= C0 + C1 + C2 + C3;
            const int nblk = 88, kb = r / nblk, nb = r % nblk, pn = nb >> 2, blk = nb & 3;
            const float* Wg = second ? in[I_F2G] : in[I_F1G]; const float* Wu = second ? in[I_F2U] : in[I_F1U];
            const float* W = (blk < 2 ? Wg : Wu) + (size_t)l * DM * DFF; const int sc = 128 * pn + 64 * (blk & 1);
            tr_item64(c, W, W, DFF, sc, sc + 32, c.wsb(second ? WS_WGU2 : WS_WGU1), DM, 64 * nb, 64 * kb, second ? 4 : 0, l, scr);
            continue;
        }
        r -= C0;
        if (r < C1) { const int kb = r / 16, nb = r % 16; const float* W = in[I_F1D] + (size_t)l * DFF * DM; tr_item64(c, W, W, DM, 64 * nb, 64 * nb + 32, c.wsb(WS_WD1), DFF, 64 * nb, 64 * kb, 1, l, scr); continue; }
        r -= C1;
        if (r < C2) { const int kb = r / 40, nb = r % 40, n0 = 64 * nb;
            const float* W = in[I_WIN] + (size_t)l * DM * 2464; int sc[2];
#pragma unroll
            for (int hh = 0; hh < 2; ++hh) { const int n = n0 + 32 * hh; sc[hh] = n < 1184 ? n : (n < 1280 ? -1 : n - 96); }
            tr_item64(c, W, W, 2464, sc[0], sc[1], c.wsb(WS_WIN), DM, n0, 64 * kb, 2, l, scr); continue; }
        r -= C2;
        if (r < C3) { const int kb = r / 16, nb = r % 16; const float* W = in[I_WOUT] + (size_t)l * DM * DM; tr_item64(c, W, W, DM, 64 * nb, 64 * nb + 32, c.wsb(WS_WOUT), DM, 64 * nb, 64 * kb, 3, l, scr); continue; }
        r -= C3; r -= C0;
        if (r < C1) { const int kb = r / 16, nb = r % 16; const float* W = in[I_F2D] + (size_t)l * DFF * DM; tr_item64(c, W, W, DM, 64 * nb, 64 * nb + 32, c.wsb(WS_WD2), DFF, 64 * nb, 64 * kb, 5, l, scr); continue; }
        r -= C1;
        if (r < C6) { const int kb = r / 6, nb = r % 6; const float* W = in[I_MLAWUQ] + (size_t)l * 256 * 384; tr_item64(c, W, W, 384, 64 * nb, 64 * nb + 32, c.wsb(WS_WUQ), 256, 64 * nb, 64 * kb, 6, l, scr); continue; }
        r -= C6;
        { const int kb = r / 8, nb = r % 8; const float* W = in[I_MLAWUKV] + (size_t)l * 128 * 512; tr_item64(c, W, W, 512, 64 * nb, 64 * nb + 32, c.wsb(WS_WUKV), 128, 64 * nb, 64 * kb, 7, l, scr); }
    }
}
__device__ __forceinline__ void prologue(const Ctx& c) {
    const int gt = c.bid * NTHREADS + c.tid, NGT = c.G * NTHREADS;
    for (int i = gt; i < SEQ * 16; i += NGT) {
        const int pos = i >> 4, fi = i & 15;
        const float inv = expf(-9.210340371976184f * (float)(2 * fi) / 32.0f);
        const float ang = (float)pos * inv;
        const double a = (double)ang * 0.15915494309189535;
        const double fr = a - rint(a);
        const float f = (float)fr;
        float2 cs; cs.x = __builtin_amdgcn_cosf(f); cs.y = __builtin_amdgcn_sinf(f);
        ((float2*)(c.kp->ws + WS_TAB))[i] = cs;
    }
    const int gw = c.bid * NWAVES + c.wave, NGW = c.G * NWAVES;
    const float* x = c.kp->in[I_X]; bf16_t* xb = c.wsb(WS_XB); float* ss0 = c.ss0();
    for (int row = gw; row < MROWS; row += NGW) {
        const f32x4* xr = (const f32x4*)(x + (size_t)row * DM) + c.lane; float s = 0.f;
#pragma unroll
        for (int j = 0; j < 4; ++j) { const f32x4 v = xr[64 * j]; s += (v[0] * v[0] + v[1] * v[1]) + (v[2] * v[2] + v[3] * v[3]);
            u32x2 w; w.x = pk2(v[0], v[1]); w.y = pk2(v[2], v[3]); *((u32x2*)(xb + (size_t)row * DM) + c.lane + 64 * j) = w; }
        s = wave_sum(s); if (c.lane == 0) ss0[row] = s;
    }
    wconv_layer(c, 0);
}

constexpr int PL_VS = 0, PL_CQ = 73728, PL_CKV = 107520, PL_KR = 124928, PL_RSQ = 133120, PL_RSKV = 133376;
__device__ __forceinline__ void vt_write(const Ctx& c, int slot0, int nh, bf16_t* Vbase, int kvh0, int tt) {
    const LAS bf16_t* VS = (const LAS bf16_t*)(c.lds + PL_VS);
    const int kc = c.tid >> 6, d = c.tid & 63;
    for (int h = 0; h < nh; ++h) {
        unsigned short e[8];
#pragma unroll
        for (int j = 0; j < 8; ++j) { const int key = 16 * (kc >> 1) + 8 * (j >> 2) + 4 * (kc & 1) + (j & 3); e[j] = VS[((slot0 + h) * 64 + key) * 72 + d]; }
        u32x4 o; o.x = e[0] | ((unsigned)e[1] << 16); o.y = e[2] | ((unsigned)e[3] << 16); o.z = e[4] | ((unsigned)e[5] << 16); o.w = e[6] | ((unsigned)e[7] << 16);
        *(u32x4*)(Vbase + ((size_t)(kvh0 + h) * NTILE + tt) * 4096 + (kc * 64 + d) * 8) = o;
    }
}
template <int LG>
__device__ __forceinline__ void norm8(const u32x4 raw, const float* g, float inv_n, float post, float* o) {
    float v[8]; unpack8(raw, v); float s = 0.f;
#pragma unroll
    for (int j = 0; j < 8; ++j) s += v[j] * v[j];
#pragma unroll
    for (int k = 0; k < LG; ++k) s += __shfl_xor(s, 1 << k);
    const float rs = (1.0f / sqrtf(s * inv_n + EPS)) * post;
#pragma unroll
    for (int j = 0; j < 8; ++j) o[j] = v[j] * rs * g[j];
}
__device__ __forceinline__ void prep_unit(const Ctx& c, int l, int T) {
    InPtr in = c.kp->in;
    const int tid = c.tid, tok = tid >> 3, sub = tid & 7, b = T >> 7, tt = T & 127, t = tt * 64 + tok;
    const bf16_t* prow = c.wsb(WS_R) + (size_t)(T * 64 + tok) * NIN;
    LAS bf16_t* VS = (LAS bf16_t*)(c.lds + PL_VS);
    LAS bf16_t* CQ = (LAS bf16_t*)(c.lds + PL_CQ);
    LAS bf16_t* CKV = (LAS bf16_t*)(c.lds + PL_CKV);
    LAS float* KR = (LAS float*)(c.lds + PL_KR);
    LAS float* RSQ = (LAS float*)(c.lds + PL_RSQ);
    LAS float* RSKV = (LAS float*)(c.lds + PL_RSKV);
    const float2* tab = (const float2*)(c.kp->ws + WS_TAB);
    u32x4 ra[12], rc[12], rd[8], rq[4], rkv[2], rkr = (u32x4){0u, 0u, 0u, 0u};
#pragma unroll
    for (int i = 0; i < 12; ++i) ra[i] = *(const u32x4*)(prow + i * 64 + sub * 8);
#pragma unroll
    for (int i = 0; i < 4; ++i) rq[i] = *(const u32x4*)(prow + 768 + 64 * i + 8 * sub);
#pragma unroll
    for (int i = 0; i < 2; ++i) rkv[i] = *(const u32x4*)(prow + 1024 + 64 * i + 8 * sub);
    if (sub < 4) rkr = *(const u32x4*)(prow + 1152 + 8 * sub);
    {
        float ssq = 0.f;
#pragma unroll
        for (int i = 0; i < 4; ++i) { float v[8]; unpack8(rq[i], v);
#pragma unroll
            for (int j = 0; j < 8; ++j) ssq += v[j] * v[j];
            *(LAS u32x4*)(CQ + tok * 264 + 64 * i + 8 * sub) = rq[i]; }
        ssq += __shfl_xor(ssq, 1); ssq += __shfl_xor(ssq, 2); ssq += __shfl_xor(ssq, 4);
        if (sub == 0) RSQ[tok] = 1.0f / sqrtf(ssq * (1.0f / 256.0f) + EPS);
        float ssk = 0.f;
#pragma unroll
        for (int i = 0; i < 2; ++i) { float v[8]; unpack8(rkv[i], v);
#pragma unroll
            for (int j = 0; j < 8; ++j) ssk += v[j] * v[j];
            *(LAS u32x4*)(CKV + tok * 136 + 64 * i + 8 * sub) = rkv[i]; }
        ssk += __shfl_xor(ssk, 1); ssk += __shfl_xor(ssk, 2); ssk += __shfl_xor(ssk, 4);
        if (sub == 0) RSKV[tok] = 1.0f / sqrtf(ssk * (1.0f / 128.0f) + EPS);
        if (sub < 4) { float v[8]; unpack8(rkr, v);
#pragma unroll
            for (int j = 0; j < 8; ++j) KR[tok * 32 + 8 * sub + j] = v[j]; }
    }
#pragma unroll
    for (int i = 0; i < 8; ++i) rd[i] = *(const u32x4*)(prow + 2048 + i * 64 + sub * 8);
    {
        const float* qg = in[I_NAQN] + l * 64 + sub * 8; const float* kg = in[I_NAKN] + l * 64 + sub * 8;
        bf16_t* QA = c.wsb(WS_QA); bf16_t* KA = c.wsb(WS_KA);
#pragma unroll
        for (int h = 0; h < 4; ++h) {
            float o[8];
            norm8<3>(ra[h], qg, 1.0f / 64.0f, 0.125f * LOG2E, o);
            *(u32x4*)(QA + ((size_t)(b * 4 + h) * SEQ + t) * 64 + sub * 8) = pack8(o);
            norm8<3>(ra[4 + h], kg, 1.0f / 64.0f, 1.0f, o);
            *(u32x4*)(KA + ((size_t)(b * 4 + h) * NTILE + tt) * 4096 + (sub * 64 + tok) * 8) = pack8(o);
            *(LAS u32x4*)(VS + (h * 64 + tok) * 72 + sub * 8) = ra[8 + h];
        }
    }
    {
        const float* qg = in[I_GQN] + l * 64 + sub * 8; const float* kg = in[I_GKN] + l * 64 + sub * 8;
        bf16_t* QD = c.wsb(WS_QD); bf16_t* KD = c.wsb(WS_KD);
        const int pos = (sub < 4) ? (t >> 6) : (t & 63); const bool first = (sub & 2) == 0;
        float cs_c[8], cs_s[8];
#pragma unroll
        for (int j = 0; j < 8; ++j) { const float2 cs = tab[pos * 16 + 8 * (sub & 1) + j]; cs_c[j] = cs.x; cs_s[j] = cs.y; }
#pragma unroll
        for (int h = 0; h < 6; ++h) {
            const bool isq = h < 4;
            float v[8], o[8];
            norm8<3>(rd[h], isq ? qg : kg, 1.0f / 64.0f, 1.0f, v);
            const float sc = isq ? 0.125f * LOG2E : 1.0f;
#pragma unroll
            for (int j = 0; j < 8; ++j) { const float pv = __shfl_xor(v[j], 2); o[j] = (first ? (v[j] * cs_c[j] - pv * cs_s[j]) : (pv * cs_s[j] + v[j] * cs_c[j])) * sc; }
            if (isq) *(u32x4*)(QD + ((size_t)(b * 4 + h) * SEQ + t) * 64 + sub * 8) = pack8(o);
            else *(u32x4*)(KD + ((size_t)(b * 2 + (h - 4)) * NTILE + tt) * 4096 + (sub * 64 + tok) * 8) = pack8(o);
        }
#pragma unroll
        for (int h = 0; h < 2; ++h) *(LAS u32x4*)(VS + ((4 + h) * 64 + tok) * 72 + sub * 8) = rd[6 + h];
    }
#pragma unroll
    for (int i = 0; i < 12; ++i) rc[i] = *(const u32x4*)(prow + 1280 + i * 64 + sub * 8);
    __syncthreads();
    vt_write(c, 0, 4, c.wsb(WS_VA), b * 4, tt);
    vt_write(c, 4, 2, c.wsb(WS_VD), b * 2, tt);
    __syncthreads();
    {
        const float* qg = in[I_DQN] + l * 32 + (sub & 3) * 8; const float* kg = in[I_DKN] + l * 32 + (sub & 3) * 8;
        bf16_t* QC = c.wsb(WS_QC); bf16_t* KC = c.wsb(WS_KC);
#pragma unroll
        for (int h = 0; h < 4; ++h) {
            float o[8];
            norm8<2>(rc[h], qg, 1.0f / 32.0f, 0.17677669529663687f * LOG2E, o);
            *(u32x4*)(QC + ((size_t)(b * 4 + h) * SEQ + t) * 64 + sub * 8) = pack8(o);
            norm8<2>(rc[4 + h], kg, 1.0f / 32.0f, 1.0f, o);
            *(u32x4*)(KC + ((size_t)(b * 4 + h) * NTILE + tt) * 4096 + (sub * 64 + tok) * 8) = pack8(o);
            *(LAS u32x4*)(VS + (h * 64 + tok) * 72 + sub * 8) = rc[8 + h];
        }
    }
    asm volatile("" ::: "memory"); __builtin_amdgcn_sched_barrier(0);
    {
        const int lane = c.lane, l15 = lane & 15, fq = lane >> 4;
        if (c.wave < 4) {
            const int h = c.wave, bh = b * 4 + h; const bf16_t* Wuq = c.wsb(WS_WUQ) + (size_t)(h * 96 + l15) * 256 + 8 * fq;
            f32x4 acc[4][6];
#pragma unroll
            for (int mt = 0; mt < 4; ++mt)
#pragma unroll
                for (int nt = 0; nt < 6; ++nt) acc[mt][nt] = (f32x4){0.f, 0.f, 0.f, 0.f};
#pragma unroll 2
            for (int ks = 0; ks < 8; ++ks) {
                bf16x8 af[6], bfr[4];
#pragma unroll
                for (int nt = 0; nt < 6; ++nt) af[nt] = *(const bf16x8*)(Wuq + (size_t)(16 * nt) * 256 + 32 * ks);
#pragma unroll
                for (int mt = 0; mt < 4; ++mt) bfr[mt] = *(const LAS bf16x8*)(CQ + (16 * mt + l15) * 264 + 32 * ks + 8 * fq);
#pragma unroll
                for (int mt = 0; mt < 4; ++mt)
#pragma unroll
                    for (int nt = 0; nt < 6; ++nt) acc[mt][nt] = __builtin_amdgcn_mfma_f32_16x16x32_bf16(af[nt], bfr[mt], acc[mt][nt], 0, 0, 0);
            }
            asm volatile("" ::: "memory"); __builtin_amdgcn_sched_barrier(0);
            const float* gq = in[I_MLAQN] + l * 96 + 4 * fq; const float sc = 0.10206207261596577f * LOG2E;
#pragma unroll
            for (int mt = 0; mt < 4; ++mt) {
                const int tokl = 16 * mt + l15, tq = tt * 64 + tokl;
                const float rsq = RSQ[tokl]; float s = 0.f;
#pragma unroll
                for (int nt = 0; nt < 6; ++nt) { acc[mt][nt] = acc[mt][nt] * rsq; s += (acc[mt][nt][0] * acc[mt][nt][0] + acc[mt][nt][1] * acc[mt][nt][1]) + (acc[mt][nt][2] * acc[mt][nt][2] + acc[mt][nt][3] * acc[mt][nt][3]); }
                s += __shfl_xor(s, 16); s += __shfl_xor(s, 32);
                const float rh = 1.0f / sqrtf(s * (1.0f / 96.0f) + EPS);
#pragma unroll
                for (int nt = 0; nt < 6; ++nt) { const f32x4 g = *(const f32x4*)(gq + 16 * nt); acc[mt][nt] = acc[mt][nt] * g * rh; }
#pragma unroll
                for (int r = 0; r < 4; ++r) { const float2 cs = tab[tq * 16 + 4 * fq + r]; const float x1 = acc[mt][4][r], x2 = acc[mt][5][r]; acc[mt][4][r] = x1 * cs.x - x2 * cs.y; acc[mt][5][r] = x1 * cs.y + x2 * cs.x; }
                bf16_t* qo = c.wsb(WS_QB) + ((size_t)bh * SEQ + tq) * 96 + 4 * fq;
#pragma unroll
                for (int nt = 0; nt < 6; ++nt) { u32x2 w; w.x = pk2(acc[mt][nt][0] * sc, acc[mt][nt][1] * sc); w.y = pk2(acc[mt][nt][2] * sc, acc[mt][nt][3] * sc); *(u32x2*)(qo + 16 * nt) = w; }
                asm volatile("" ::: "memory"); __builtin_amdgcn_sched_barrier(0);
            }
        } else {
            const int h = c.wave - 4, bh = b * 4 + h; const bf16_t* Wukv = c.wsb(WS_WUKV) + (size_t)(h * 128 + l15) * 128 + 8 * fq;
            const float* gk = in[I_MLAKN] + l * 96 + 4 * fq;
#pragma unroll
            for (int half = 0; half < 2; ++half) {
                f32x4 acc[4][4];
#pragma unroll
                for (int mt = 0; mt < 4; ++mt)
#pragma unroll
                    for (int nt = 0; nt < 4; ++nt) acc[mt][nt] = (f32x4){0.f, 0.f, 0.f, 0.f};
#pragma unroll 2
                for (int ks = 0; ks < 4; ++ks) {
                    bf16x8 af[4], bfr[4];
#pragma unroll
                    for (int nt = 0; nt < 4; ++nt) af[nt] = *(const bf16x8*)(Wukv + (size_t)(64 * half + 16 * nt) * 128 + 32 * ks);
#pragma unroll
                    for (int mt = 0; mt < 4; ++mt) bfr[mt] = *(const LAS bf16x8*)(CKV + (16 * mt + l15) * 136 + 32 * ks + 8 * fq);
#pragma unroll
                    for (int mt = 0; mt < 4; ++mt)
#pragma unroll
                        for (int nt = 0; nt < 4; ++nt) acc[mt][nt] = __builtin_amdgcn_mfma_f32_16x16x32_bf16(af[nt], bfr[mt], acc[mt][nt], 0, 0, 0);
                }
                asm volatile("" ::: "memory"); __builtin_amdgcn_sched_barrier(0);
#pragma unroll
                for (int mt = 0; mt < 4; ++mt) {
                    const int tokl = 16 * mt + l15, tq = tt * 64 + tokl;
                    const float rskv = RSKV[tokl];
#pragma unroll
                    for (int nt = 0; nt < 4; ++nt) acc[mt][nt] = acc[mt][nt] * rskv;
                    if (half == 0) {
                        f32x4 kr1 = *(const LAS f32x4*)(KR + tokl * 32 + 4 * fq), kr2 = *(const LAS f32x4*)(KR + tokl * 32 + 16 + 4 * fq);
                        float s = (kr1[0] * kr1[0] + kr1[1] * kr1[1]) + (kr1[2] * kr1[2] + kr1[3] * kr1[3]) + (kr2[0] * kr2[0] + kr2[1] * kr2[1]) + (kr2[2] * kr2[2] + kr2[3] * kr2[3]);
#pragma unroll
                        for (int nt = 0; nt < 4; ++nt) s += (acc[mt][nt][0] * acc[mt][nt][0] + acc[mt][nt][1] * acc[mt][nt][1]) + (acc[mt][nt][2] * acc[mt][nt][2] + acc[mt][nt][3] * acc[mt][nt][3]);
                        s += __shfl_xor(s, 16); s += __shfl_xor(s, 32);
                        const float rh = 1.0f / sqrtf(s * (1.0f / 96.0f) + EPS);
#pragma unroll
                        for (int nt = 0; nt < 4; ++nt) { const f32x4 g = *(const f32x4*)(gk + 16 * nt); acc[mt][nt] = acc[mt][nt] * g * rh; }
                        kr1 = kr1 * *(const f32x4*)(gk + 64) * rh; kr2 = kr2 * *(const f32x4*)(gk + 80) * rh;
#pragma unroll
                        for (int r = 0; r < 4; ++r) { const float2 cs = tab[tq * 16 + 4 * fq + r]; const float x1 = kr1[r], x2 = kr2[r]; kr1[r] = x1 * cs.x - x2 * cs.y; kr2[r] = x1 * cs.y + x2 * cs.x; }
                        bf16_t* kt = c.wsb(WS_KB) + ((size_t)bh * NTILE + tt) * 6144 + tokl * 8 + (fq & 1) * 4;
#pragma unroll
                        for (int nt = 0; nt < 4; ++nt) { u32x2 w; w.x = pk2(acc[mt][nt][0], acc[mt][nt][1]); w.y = pk2(acc[mt][nt][2], acc[mt][nt][3]); *(u32x2*)(kt + (2 * nt + (fq >> 1)) * 512) = w; }
                        { u32x2 w; w.x = pk2(kr1[0], kr1[1]); w.y = pk2(kr1[2], kr1[3]); *(u32x2*)(kt + (8 + (fq >> 1)) * 512) = w;
                          w.x = pk2(kr2[0], kr2[1]); w.y = pk2(kr2[2], kr2[3]); *(u32x2*)(kt + (10 + (fq >> 1)) * 512) = w; }
                    } else {
#pragma unroll
                        for (int nt = 0; nt < 4; ++nt) { u32x2 w; w.x = pk2(acc[mt][nt][0], acc[mt][nt][1]); w.y = pk2(acc[mt][nt][2], acc[mt][nt][3]); *(LAS u32x2*)(VS + ((4 + h) * 64 + tokl) * 72 + 16 * nt + 4 * fq) = w; }
                    }
                    asm volatile("" ::: "memory"); __builtin_amdgcn_sched_barrier(0);
                }
            }
        }
    }
    __syncthreads();
    vt_write(c, 0, 4, c.wsb(WS_VC), b * 4, tt);
    vt_write(c, 4, 4, c.wsb(WS_VB), b * 4, tt);
    __syncthreads();
}

namespace att {
constexpr int SLOT_K = 12288, SLOT = 20480, LUT_OFF = 69632, PARK_OFF = 73728;
struct Args { const bf16_t* Q; const bf16_t* K; const bf16_t* V; bf16_t* Y; int ycol, kv_shift, nkvh; const float* lut_src; const float* lam_src; float lam_init; const float* gq; const float* gk; int ng; float sqrtd; };
__device__ __forceinline__ int crow(int r, int hi) { return (r & 3) + 8 * (r >> 2) + 4 * hi; }
__device__ __forceinline__ int iclamp(int v, int lo, int hi) { return v < lo ? lo : (v > hi ? hi : v); }
__device__ __forceinline__ void glds16(const bf16_t* src, LAS unsigned char* dst) { __builtin_amdgcn_global_load_lds((const unsigned*)src, (LAS unsigned*)dst, 16, 0, 0); }

__device__ __forceinline__ float max2f(float a, float b) { return __builtin_amdgcn_fmed3f(a, b, __builtin_inff()); }
template <int MODE, int DQK>
__device__ __forceinline__ void unit(const Args& a, int bh, int qb, LAS unsigned char* lds, const int tid) {
    constexpr int NQF = DQK / 16, NMAP = (MODE == 1) ? 2 : 1, FPM = NQF / NMAP, NKP = DQK / 8, NP = NKP + 8, NPW = (NP + 7) / 8, KT_ELEMS = DQK * 64;
    constexpr float THR = 5.0f;
    const int lane = tid & 63, r32 = lane & 31, hi = lane >> 5, w = __builtin_amdgcn_readfirstlane(tid >> 6);
    const int b = bh >> 2, h = bh & 3, kvh = b * a.nkvh + (h >> a.kv_shift);
    const int qrow = qb * 256 + 32 * w + r32;
    int t_lo = 0, t_hi = NTILE, my_lo = 0, my_hi = NTILE, myr = 0;
    if (MODE == 2) { const int r0 = qb * 4; t_lo = iclamp(r0 - 4, 0, 120); t_hi = iclamp(r0 + 3 - 4, 0, 120) + 8; myr = r0 + (w >> 1); my_lo = iclamp(myr - 4, 0, 120); my_hi = my_lo + 8; }
    const int NT = t_hi - t_lo;
    LAS float* lut = (LAS float*)(lds + LUT_OFF);
    if (MODE == 1) {
        for (int i = tid; i < 257; i += NTHREADS) { const int rel = i - 128, n = rel < 0 ? -rel : rel;
            int large = 8 + (int)(logf((float)(n < 1 ? 1 : n) / 8.0f) / 2.772588722239781f * 8.0f); large = large > 15 ? 15 : large;
            const int bucket = (rel > 0 ? 16 : 0) + (n < 8 ? n : large);
            lut[i] = a.lut_src[bucket * 4 + h] * LOG2E; }
    }
    if (MODE == 2) { for (int i = tid; i < 465; i += NTHREADS) lut[i] = a.lut_src[h * 465 + i] * LOG2E; }
    bf16x8 qf[NQF];
    { const bf16_t* qp = a.Q + ((size_t)bh * SEQ + qrow) * DQK + 8 * hi;
#pragma unroll
      for (int d0 = 0; d0 < NQF; ++d0) qf[d0] = *(const bf16x8*)(qp + 16 * d0); }
    float mrun[NMAP], lrun[NMAP]; f32x16 o[NMAP][2]; f32x16 negm = f32x16{};
#pragma unroll
    for (int mp = 0; mp < NMAP; ++mp) { mrun[mp] = 0.f; lrun[mp] = 0.f; o[mp][0] = f32x16{}; o[mp][1] = f32x16{}; }
    bool started = false;
    const bf16_t* Kt = a.K + (size_t)kvh * NTILE * KT_ELEMS; const bf16_t* Vt = a.V + (size_t)kvh * NTILE * 4096;
#define ATT_ISSUE(t, slot) do { _Pragma("unroll") for (int j_ = 0; j_ < NPW; ++j_) { int p_ = w + 8 * j_; if (p_ >= NP) p_ -= 8; \
        if (p_ < NKP) glds16(Kt + (size_t)(t) * KT_ELEMS + p_ * 512 + lane * 8, lds + (slot) * SLOT + p_ * 1024); \
        else glds16(Vt + (size_t)(t) * 4096 + (p_ - NKP) * 512 + lane * 8, lds + (slot) * SLOT + SLOT_K + (p_ - NKP) * 1024); } } while (0)
    ATT_ISSUE(t_lo, 0);
    if (NT > 1) ATT_ISSUE(t_lo + 1, 1);
    int slot = 0;
    for (int i = 0; i < NT; ++i) {
        if (i + 1 < NT) { if constexpr (NPW == 2) asm volatile("s_waitcnt vmcnt(2)" ::: "memory"); else asm volatile("s_waitcnt vmcnt(3)" ::: "memory"); }
        else asm volatile("s_waitcnt vmcnt(0)" ::: "memory");
        asm volatile("s_waitcnt lgkmcnt(0)" ::: "memory"); __builtin_amdgcn_s_barrier(); asm volatile("" ::: "memory");
        if (i + 2 < NT) { const int s2 = slot >= 1 ? slot - 1 : 2; ATT_ISSUE(t_lo + i + 2, s2); }
        const int t = t_lo + i;
        if (MODE != 2 || (t >= my_lo && t < my_hi)) {
            const LAS unsigned char* ks = lds + slot * SLOT + hi * 1024 + r32 * 16;
            const LAS unsigned char* vs = lds + slot * SLOT + SLOT_K + hi * 1024 + r32 * 16;
#pragma unroll
            for (int mp = 0; mp < NMAP; ++mp) {
                bf16x8 kf[2 * FPM];
#pragma unroll
                for (int d = 0; d < FPM; ++d) { const int d0 = mp * FPM + d; kf[2 * d] = *(const LAS bf16x8*)(ks + d0 * 2048); kf[2 * d + 1] = *(const LAS bf16x8*)(ks + d0 * 2048 + 512); }
                f32x16 c0, c1; const float mneg = -mrun[mp];
                if (MODE == 0) { c0 = negm; c1 = negm; }
                if (MODE == 1) {
                    const int qw0 = qb * 256 + 32 * w, d_lo = 64 * t - (qw0 + 31), d_hi = 64 * t + 63 - qw0;
                    if (d_hi <= -128 || d_lo >= 128) { const float v = lut[d_lo >= 128 ? 256 : 0] + mneg;
#pragma unroll
                        for (int r = 0; r < 16; ++r) c0[r] = v;
                        c1 = c0; }
                    else {
#pragma unroll
                        for (int r = 0; r < 16; ++r) { const int rel = 64 * t + crow(r, hi) - qrow; c0[r] = lut[iclamp(rel, -128, 128) + 128] + mneg; c1[r] = lut[iclamp(rel + 32, -128, 128) + 128] + mneg; } }
                }
                if (MODE == 2) {
                    const int qc = 32 * (w & 1) + r32, qs = iclamp(qc - 8, 0, 48), dr = t - myr + 7;
#pragma unroll
                    for (int r = 0; r < 16; ++r) { const int kc = crow(r, hi), kc2 = kc + 32;
                        const bool v1 = (kc >= qs) && (kc < qs + 16), v2 = (kc2 >= qs) && (kc2 < qs + 16);
                        c0[r] = v1 ? lut[dr * 31 + (kc - qc + 15)] + mneg : -1e30f; c1[r] = v2 ? lut[dr * 31 + (kc2 - qc + 15)] + mneg : -1e30f; }
                }
                __builtin_amdgcn_sched_barrier(0);
                f32x16 p0 = __builtin_amdgcn_mfma_f32_32x32x16_bf16(kf[0], qf[mp * FPM], c0, 0, 0, 0);
                f32x16 p1 = __builtin_amdgcn_mfma_f32_32x32x16_bf16(kf[1], qf[mp * FPM], c1, 0, 0, 0);
#pragma unroll
                for (int d = 1; d < FPM; ++d) { p0 = __builtin_amdgcn_mfma_f32_32x32x16_bf16(kf[2 * d], qf[mp * FPM + d], p0, 0, 0, 0); p1 = __builtin_amdgcn_mfma_f32_32x32x16_bf16(kf[2 * d + 1], qf[mp * FPM + d], p1, 0, 0, 0); }
                bf16x8 vf[8];
#pragma unroll
                for (int q8 = 0; q8 < 8; ++q8) vf[q8] = *(const LAS bf16x8*)(vs + (q8 & 3) * 2048 + (q8 >> 2) * 512);
                __builtin_amdgcn_sched_barrier(0);
                float ma = max2f(p0[0], p1[0]), mb = max2f(p0[1], p1[1]);
#pragma unroll
                for (int r = 2; r < 16; r += 2) { ma = max2f(ma, max2f(p0[r], p1[r])); mb = max2f(mb, max2f(p0[r + 1], p1[r + 1])); }
                float rm = max2f(ma, mb);
                { auto rr = __builtin_amdgcn_permlane32_swap(__float_as_uint(rm), __float_as_uint(rm), false, false); rm = max2f(__uint_as_float(rr[0]), __uint_as_float(rr[1])); }
                if (!started || __any(rm > THR)) {
                    const float dl = started ? fmaxf(rm, 0.f) : rm;
                    mrun[mp] += dl;
#pragma unroll
                    for (int r = 0; r < 16; ++r) { p0[r] -= dl; p1[r] -= dl; }
                    const float alpha = __builtin_amdgcn_exp2f(-dl);
                    lrun[mp] *= alpha; o[mp][0] = o[mp][0] * alpha; o[mp][1] = o[mp][1] * alpha;
                    if (MODE == 0) {
#pragma unroll
                        for (int r = 0; r < 16; ++r) negm[r] = -mrun[mp];
                    }
                }
                float rs0 = 0.f, rs1 = 0.f;
#pragma unroll
                for (int r = 0; r < 16; ++r) { p0[r] = __builtin_amdgcn_exp2f(p0[r]); p1[r] = __builtin_amdgcn_exp2f(p1[r]); rs0 += p0[r]; rs1 += p1[r]; }
                lrun[mp] += rs0 + rs1;
                u32x4 pw[4];
#pragma unroll
                for (int j = 0; j < 4; ++j) { pw[0][j] = pk2(p0[2 * j], p0[2 * j + 1]); pw[1][j] = pk2(p0[8 + 2 * j], p0[9 + 2 * j]); pw[2][j] = pk2(p1[2 * j], p1[2 * j + 1]); pw[3][j] = pk2(p1[8 + 2 * j], p1[9 + 2 * j]); }
#pragma unroll
                for (int k4 = 0; k4 < 4; ++k4) {
                    o[mp][0] = __builtin_amdgcn_mfma_f32_32x32x16_bf16(vf[k4], __builtin_bit_cast(bf16x8, pw[k4]), o[mp][0], 0, 0, 0);
                    o[mp][1] = __builtin_amdgcn_mfma_f32_32x32x16_bf16(vf[4 + k4], __builtin_bit_cast(bf16x8, pw[k4]), o[mp][1], 0, 0, 0); }
            }
            started = true;
        }
        slot = slot == 2 ? 0 : slot + 1;
    }
#undef ATT_ISSUE
#pragma unroll
    for (int mp = 0; mp < NMAP; ++mp) lrun[mp] += __shfl_xor(lrun[mp], 32);
    f32x16 val[2];
    if (MODE == 1) {
        float s1 = 0.f, s2 = 0.f;
        for (int i = 0; i < 32; ++i) { s1 += a.lam_src[i] * a.lam_src[32 + i]; s2 += a.lam_src[64 + i] * a.lam_src[96 + i]; }
        const float lam = expf(s1) - expf(s2) + a.lam_init;
        const float i0 = 1.0f / lrun[0], i1 = lam / lrun[NMAP - 1];
        val[0] = o[0][0] * i0 - o[NMAP - 1][0] * i1; val[1] = o[0][1] * i0 - o[NMAP - 1][1] * i1;
        float s = 0.f;
#pragma unroll
        for (int r = 0; r < 16; ++r) s += val[0][r] * val[0][r] + val[1][r] * val[1][r];
        s += __shfl_xor(s, 32);
        const float rn = 1.0f / sqrtf(s * (1.0f / 64.0f) + EPS);
        val[0] = val[0] * rn; val[1] = val[1] * rn;
    } else { const float i0 = 1.0f / lrun[0]; val[0] = o[0][0] * i0; val[1] = o[0][1] * i0; }
    bf16_t* yp = a.Y + ((size_t)(b * SEQ + qrow)) * DM + a.ycol + h * 64 + 4 * hi;
#pragma unroll
    for (int db = 0; db < 2; ++db)
#pragma unroll
        for (int g = 0; g < 4; ++g) { u32x2 wv; wv.x = pk2(val[db][4 * g], val[db][4 * g + 1]); wv.y = pk2(val[db][4 * g + 2], val[db][4 * g + 3]); *(u32x2*)(yp + 32 * db + 8 * g) = wv; }
    asm volatile("s_waitcnt lgkmcnt(0)" ::: "memory"); __builtin_amdgcn_s_barrier(); asm volatile("" ::: "memory");
}

#define ATT_WAITV(n) asm volatile("s_waitcnt vmcnt(" #n ") lgkmcnt(0)\n\ts_barrier" ::: "memory")
__device__ __forceinline__ void wait_bar_n(int n) {
    if (n == 0) ATT_WAITV(0); else if (n == 1) ATT_WAITV(1); else if (n == 2) ATT_WAITV(2); else if (n == 3) ATT_WAITV(3); else ATT_WAITV(4);
}
template <int DQK> struct PipeCfg {
    static constexpr int KSLOT = DQK * 128, VSLOT = 8192, KRING = 0, VRING = 3 * KSLOT, NKP = DQK / 8, NKW = (NKP + 7) / 8, KT_ELEMS = DQK * 64;
};
struct PipeState { float mrun, lrun, cb; f32x16 negm; };
__device__ __forceinline__ void bias_tile(f32x16& C0, f32x16& C1, const LAS float* lut, int t, int qrow, int hi, float mrun) {
#pragma unroll
    for (int r = 0; r < 16; ++r) { const int rel = 64 * t + crow(r, hi) - qrow; C0[r] = lut[iclamp(rel, -128, 128) + 128] - mrun; C1[r] = lut[iclamp(rel + 32, -128, 128) + 128] - mrun; }
}
template <int DQK, int F0, int NF, bool BIAS, bool NOMAX>
__device__ __forceinline__ void pipe_step(int t, f32x16& C0, f32x16& C1, f32x16& P0, f32x16& P1, f32x16 (&o)[2], bf16x8 (&kf)[2 * NF], const bf16x8 (&qf)[NF],
                                          PipeState& st, LAS unsigned char* lds, const bf16_t* Kt, const bf16_t* Vt, int lane, int w, int frag_off,
                                          const LAS float* lut, int qw0, int qrow, int hi, float cL, float cR) {
    typedef PipeCfg<DQK> Cf;
    constexpr int NKF = 2 * NF, NT = NTILE, GPG = (8 + NKF - 1) / NKF;
    constexpr float THR = 5.0f;
    const int sv_prev = (t - 1) & 3, sk_next = (t + 1) % 3;
    const LAS unsigned char* vs = lds + Cf::VRING + sv_prev * Cf::VSLOT + frag_off;
    const LAS unsigned char* kn = lds + Cf::KRING + sk_next * Cf::KSLOT + frag_off + F0 * 2048;
    bf16x8 vf[8]; u32x4 pw[4]; float sacc = 0.f;
    bool near = false;
    if (BIAS) {
        const int d_lo = 64 * t - (qw0 + 31), d_hi = 64 * t + 63 - qw0;
        near = !(d_hi <= -128 || d_lo >= 128);
        if (near) bias_tile(C0, C1, lut, t, qrow, hi, st.mrun);
        else { const float ct = d_lo >= 128 ? cR : cL;
            if (ct != st.cb) { st.cb = ct;
#pragma unroll
                for (int r = 0; r < 16; ++r) st.negm[r] = ct - st.mrun; } }
    }
    __builtin_amdgcn_sched_barrier(0);
#pragma unroll
    for (int g = 0; g < NKF; ++g) {
        if (g >= NKF - 4) { const int q8 = g - (NKF - 4); vf[q8] = *(const LAS bf16x8*)(vs + q8 * 2048); }
        __builtin_amdgcn_sched_barrier(0);
        const int d = g >> 1;
        if (d == 0) {
            if (BIAS && near) { if ((g & 1) == 0) C0 = __builtin_amdgcn_mfma_f32_32x32x16_bf16(kf[g], qf[d], C0, 0, 0, 0); else C1 = __builtin_amdgcn_mfma_f32_32x32x16_bf16(kf[g], qf[d], C1, 0, 0, 0); }
            else { if ((g & 1) == 0) C0 = __builtin_amdgcn_mfma_f32_32x32x16_bf16(kf[g], qf[d], st.negm, 0, 0, 0); else C1 = __builtin_amdgcn_mfma_f32_32x32x16_bf16(kf[g], qf[d], st.negm, 0, 0, 0); }
        } else { if ((g & 1) == 0) C0 = __builtin_amdgcn_mfma_f32_32x32x16_bf16(kf[g], qf[d], C0, 0, 0, 0); else C1 = __builtin_amdgcn_mfma_f32_32x32x16_bf16(kf[g], qf[d], C1, 0, 0, 0); }
#pragma unroll
        for (int gg = 0; gg < GPG; ++gg) { const int grp = g * GPG + gg;
            if (grp < 8) {
                if (grp < 4) { sacc += (P0[4 * grp] + P0[4 * grp + 1]) + (P0[4 * grp + 2] + P0[4 * grp + 3]); pw[grp >> 1][2 * (grp & 1)] = pk2(P0[4 * grp], P0[4 * grp + 1]); pw[grp >> 1][2 * (grp & 1) + 1] = pk2(P0[4 * grp + 2], P0[4 * grp + 3]); }
                else { const int e = 4 * (grp - 4); sacc += (P1[e] + P1[e + 1]) + (P1[e + 2] + P1[e + 3]); pw[grp >> 1][2 * (grp & 1)] = pk2(P1[e], P1[e + 1]); pw[grp >> 1][2 * (grp & 1) + 1] = pk2(P1[e + 2], P1[e + 3]); }
                asm volatile("" : "+v"(sacc)); asm volatile("" : "+v"(pw[grp >> 1]));
            } }
        __builtin_amdgcn_sched_barrier(0);
    }
    st.lrun += sacc;
    if (t + 3 < NT) {
#pragma unroll
        for (int j = 0; j < Cf::NKW; ++j) { int p = w + 8 * j; if (p >= Cf::NKP) p -= 8;
            glds16(Kt + (size_t)(t + 3) * Cf::KT_ELEMS + p * 512 + lane * 8, lds + Cf::KRING + (t % 3) * Cf::KSLOT + p * 1024); }
    }
    if (t + 2 < NT) glds16(Vt + (size_t)(t + 2) * 4096 + w * 512 + lane * 8, lds + Cf::VRING + ((t + 2) & 3) * Cf::VSLOT + w * 1024);
    float alpha = 1.0f; bool resc = false;
    if (!NOMAX) {
        int ia = max(max(__float_as_int(C0[0]), __float_as_int(C0[1])), __float_as_int(C1[0])), ib = max(max(__float_as_int(C0[2]), __float_as_int(C0[3])), __float_as_int(C1[1]));
        ia = max(max(ia, __float_as_int(C1[2])), __float_as_int(C1[3]));
#pragma unroll
        for (int r = 4; r < 16; r += 4) { ia = max(max(ia, __float_as_int(C0[r])), __float_as_int(C0[r + 1])); ib = max(max(ib, __float_as_int(C0[r + 2])), __float_as_int(C0[r + 3]));
            ia = max(max(ia, __float_as_int(C1[r])), __float_as_int(C1[r + 1])); ib = max(max(ib, __float_as_int(C1[r + 2])), __float_as_int(C1[r + 3])); }
        int im = max(ia, ib);
        { auto rr = __builtin_amdgcn_permlane32_swap((unsigned)im, (unsigned)im, false, false); im = max((int)rr[0], (int)rr[1]); }
        if (__builtin_expect(__any(im > __float_as_int(THR)), 0)) {
            const float rm = __int_as_float(im), dl = rm > 0.f ? rm : 0.f;
            st.mrun += dl;
#pragma unroll
            for (int r = 0; r < 16; ++r) { C0[r] -= dl; C1[r] -= dl; }
#pragma unroll
            for (int r = 0; r < 16; ++r) st.negm[r] = st.cb - st.mrun;
            alpha = __builtin_amdgcn_exp2f(-dl); st.lrun *= alpha; resc = true;
        }
    }
    __builtin_amdgcn_sched_barrier(0);
#pragma unroll
    for (int g = 0; g < 8; ++g) {
        if (t + 1 < NT) {
            constexpr int G0 = (NKF >= 12) ? 1 : 2;
            if (g >= G0 && 2 * (g - G0) < NKF) { const int f = g - G0; kf[2 * f] = *(const LAS bf16x8*)(kn + f * 2048); kf[2 * f + 1] = *(const LAS bf16x8*)(kn + f * 2048 + 512); }
        }
        if (g < 2) { vf[4 + 2 * g] = *(const LAS bf16x8*)(vs + (2 * g) * 2048 + 512); vf[5 + 2 * g] = *(const LAS bf16x8*)(vs + (2 * g + 1) * 2048 + 512); }
        __builtin_amdgcn_sched_barrier(0);
        const int k4 = g & 3, db = g >> 2;
        o[db] = __builtin_amdgcn_mfma_f32_32x32x16_bf16(vf[g], __builtin_bit_cast(bf16x8, pw[k4]), o[db], 0, 0, 0);
        if (g < 4) {
#pragma unroll
            for (int e = 0; e < 4; ++e) C0[4 * g + e] = __builtin_amdgcn_exp2f(C0[4 * g + e]);
        } else {
#pragma unroll
            for (int e = 0; e < 4; ++e) C1[4 * (g - 4) + e] = __builtin_amdgcn_exp2f(C1[4 * (g - 4) + e]);
        }
        if (g < 4) asm volatile("" : "+v"(C0)); else asm volatile("" : "+v"(C1));
        __builtin_amdgcn_sched_barrier(0);
    }
    wait_bar_n((t + 1 < NT ? 1 : 0) + (t + 3 < NT ? Cf::NKW : 0) + (t + 2 < NT ? 1 : 0));
    if (resc) { o[0] = o[0] * alpha; o[1] = o[1] * alpha; }
}
template <int DQK, int F0, int NF, bool BIAS, bool NOMAX>
__device__ __forceinline__ void pipe_run(const Args& a, int bh, int qb, LAS unsigned char* lds, const int tid, f32x16 (&o)[2], float& lsum) {
    typedef PipeCfg<DQK> Cf;
    constexpr int NKF = 2 * NF, NT = NTILE;
    const int lane = tid & 63, r32 = lane & 31, hi = lane >> 5, w = __builtin_amdgcn_readfirstlane(tid >> 6);
    const int b = bh >> 2, h = bh & 3, kvh = b * a.nkvh + (h >> a.kv_shift);
    const int qw0 = qb * 256 + 32 * w, qrow = qw0 + r32, frag_off = hi * 1024 + r32 * 16;
    const bf16_t* Kt = a.K + (size_t)kvh * NTILE * Cf::KT_ELEMS; const bf16_t* Vt = a.V + (size_t)kvh * NTILE * 4096;
    const LAS float* lut = (const LAS float*)(lds + LUT_OFF);
#define PIPE_DMA_K(t, slot) do { _Pragma("unroll") for (int j_ = 0; j_ < Cf::NKW; ++j_) { int p_ = w + 8 * j_; if (p_ >= Cf::NKP) p_ -= 8; \
        glds16(Kt + (size_t)(t) * Cf::KT_ELEMS + p_ * 512 + lane * 8, lds + Cf::KRING + (slot) * Cf::KSLOT + p_ * 1024); } } while (0)
#define PIPE_DMA_V(t, slot) glds16(Vt + (size_t)(t) * 4096 + w * 512 + lane * 8, lds + Cf::VRING + (slot) * Cf::VSLOT + w * 1024)
    PIPE_DMA_K(0, 0); PIPE_DMA_V(0, 0); PIPE_DMA_K(1, 1); PIPE_DMA_V(1, 1); PIPE_DMA_K(2, 2);
    bf16x8 qf[NF];
    { const bf16_t* qp = a.Q + ((size_t)bh * SEQ + qrow) * DQK + 8 * hi + 16 * F0;
#pragma unroll
      for (int d0 = 0; d0 < NF; ++d0) qf[d0] = *(const bf16x8*)(qp + 16 * d0); }
    PipeState st; st.mrun = 0.f; st.lrun = 0.f; st.cb = 0.f; st.negm = f32x16{};
    o[0] = f32x16{}; o[1] = f32x16{};
    f32x16 pA0, pA1, pB0, pB1; bf16x8 kf[NKF];
    if (Cf::NKW == 1) ATT_WAITV(4); else asm volatile("s_waitcnt vmcnt(6) lgkmcnt(0)\n\ts_barrier" ::: "memory");
    float cL = 0.f, cR = 0.f;
    if (BIAS) { cL = __int_as_float(__builtin_amdgcn_readfirstlane(__float_as_int(lut[0]))); cR = __int_as_float(__builtin_amdgcn_readfirstlane(__float_as_int(lut[256]))); }
    {
        const LAS unsigned char* k0 = lds + Cf::KRING + frag_off + F0 * 2048;
#pragma unroll
        for (int g = 0; g < NKF; ++g) kf[g] = *(const LAS bf16x8*)(k0 + (g >> 1) * 2048 + (g & 1) * 512);
        pA0 = f32x16{}; pA1 = f32x16{};
        if (BIAS) bias_tile(pA0, pA1, lut, 0, qrow, hi, 0.f);
#pragma unroll
        for (int d = 0; d < NF; ++d) { pA0 = __builtin_amdgcn_mfma_f32_32x32x16_bf16(kf[2 * d], qf[d], pA0, 0, 0, 0); pA1 = __builtin_amdgcn_mfma_f32_32x32x16_bf16(kf[2 * d + 1], qf[d], pA1, 0, 0, 0); }
        float rm = 0.f;
        if (!NOMAX) {
            rm = fmaxf(pA0[0], pA1[0]);
#pragma unroll
            for (int r = 1; r < 16; ++r) rm = fmaxf(rm, fmaxf(pA0[r], pA1[r]));
            { auto rr = __builtin_amdgcn_permlane32_swap(__float_as_uint(rm), __float_as_uint(rm), false, false); rm = fmaxf(__uint_as_float(rr[0]), __uint_as_float(rr[1])); }
        }
        st.mrun = rm;
#pragma unroll
        for (int r = 0; r < 16; ++r) { pA0[r] = __builtin_amdgcn_exp2f(pA0[r] - rm); pA1[r] = __builtin_amdgcn_exp2f(pA1[r] - rm); st.negm[r] = -rm; }
    }
    ATT_WAITV(0);
    PIPE_DMA_K(3, 0); PIPE_DMA_V(2, 2);
    {   const LAS unsigned char* k1 = lds + Cf::KRING + Cf::KSLOT + frag_off + F0 * 2048;
#pragma unroll
        for (int g = 0; g < NKF; ++g) kf[g] = *(const LAS bf16x8*)(k1 + (g >> 1) * 2048 + (g & 1) * 512); }
    if (Cf::NKW == 1) ATT_WAITV(2); else ATT_WAITV(3);
    int t = 1;
    for (; t + 1 < NT; t += 2) {
        pipe_step<DQK, F0, NF, BIAS, NOMAX>(t, pB0, pB1, pA0, pA1, o, kf, qf, st, lds, Kt, Vt, lane, w, frag_off, lut, qw0, qrow, hi, cL, cR);
        pipe_step<DQK, F0, NF, BIAS, NOMAX>(t + 1, pA0, pA1, pB0, pB1, o, kf, qf, st, lds, Kt, Vt, lane, w, frag_off, lut, qw0, qrow, hi, cL, cR);
    }
    pipe_step<DQK, F0, NF, BIAS, NOMAX>(NT - 1, pB0, pB1, pA0, pA1, o, kf, qf, st, lds, Kt, Vt, lane, w, frag_off, lut, qw0, qrow, hi, cL, cR);
    {
        float sacc = 0.f;
#pragma unroll
        for (int r = 0; r < 16; ++r) sacc += pB0[r] + pB1[r];
        st.lrun += sacc;
        u32x4 pw[4];
#pragma unroll
        for (int j = 0; j < 4; ++j) { pw[0][j] = pk2(pB0[2 * j], pB0[2 * j + 1]); pw[1][j] = pk2(pB0[8 + 2 * j], pB0[9 + 2 * j]); pw[2][j] = pk2(pB1[2 * j], pB1[2 * j + 1]); pw[3][j] = pk2(pB1[8 + 2 * j], pB1[9 + 2 * j]); }
        const LAS unsigned char* vs = lds + Cf::VRING + ((NT - 1) & 3) * Cf::VSLOT + frag_off;
#pragma unroll
        for (int k4 = 0; k4 < 4; ++k4)
#pragma unroll
            for (int db = 0; db < 2; ++db) { const bf16x8 vfr = *(const LAS bf16x8*)(vs + k4 * 2048 + db * 512);
                o[db] = __builtin_amdgcn_mfma_f32_32x32x16_bf16(vfr, __builtin_bit_cast(bf16x8, pw[k4]), o[db], 0, 0, 0); }
    }
#undef PIPE_DMA_K
#undef PIPE_DMA_V
    lsum = st.lrun + __shfl_xor(st.lrun, 32);
    asm volatile("s_waitcnt lgkmcnt(0)\n\ts_barrier" ::: "memory");
}
__device__ __forceinline__ void store_rows(const Args& a, int bh, int qb, int tid, const f32x16 (&val)[2]) {
    const int lane = tid & 63, r32 = lane & 31, hi = lane >> 5, w = __builtin_amdgcn_readfirstlane(tid >> 6), b = bh >> 2, h = bh & 3, qrow = qb * 256 + 32 * w + r32;
    bf16_t* yp = a.Y + ((size_t)(b * SEQ + qrow)) * DM + a.ycol + h * 64 + 4 * hi;
#pragma unroll
    for (int db = 0; db < 2; ++db)
#pragma unroll
        for (int g = 0; g < 4; ++g) { u32x2 wv; wv.x = pk2(val[db][4 * g], val[db][4 * g + 1]); wv.y = pk2(val[db][4 * g + 2], val[db][4 * g + 3]); *(u32x2*)(yp + 32 * db + 8 * g) = wv; }
}
__device__ __forceinline__ float score_bound(const Args& a, int tid) {
    const int lane = tid & 63; float bq = 0.f, bk = 0.f;
    for (int i = lane; i < a.ng; i += 64) { bq = fmaxf(bq, fabsf(a.gq[i])); bk = fmaxf(bk, fabsf(a.gk[i])); }
#pragma unroll
    for (int o = 1; o < 64; o <<= 1) { bq = fmaxf(bq, __shfl_xor(bq, o)); bk = fmaxf(bk, __shfl_xor(bk, o)); }
    return __int_as_float(__builtin_amdgcn_readfirstlane(__float_as_int(a.sqrtd * LOG2E * bq * bk)));
}
constexpr float NOMAX_BOUND = 40.0f;
template <int DQK>
__device__ __forceinline__ void unit_plain(const Args& a, int bh, int qb, LAS unsigned char* lds, const int tid) {
    f32x16 o[2]; float l;
    if (score_bound(a, tid) <= NOMAX_BOUND) pipe_run<DQK, 0, DQK / 16, false, true>(a, bh, qb, lds, tid, o, l);
    else pipe_run<DQK, 0, DQK / 16, false, false>(a, bh, qb, lds, tid, o, l);
    const float i0 = 1.0f / l; o[0] = o[0] * i0; o[1] = o[1] * i0;
    store_rows(a, bh, qb, tid, o);
}
__device__ __forceinline__ void unit_diff(const Args& a, int bh, int qb, LAS unsigned char* lds, const int tid) {
    const int h = bh & 3;
    LAS float* lut = (LAS float*)(lds + LUT_OFF);
    for (int i = tid; i < 257; i += NTHREADS) { const int rel = i - 128, n = rel < 0 ? -rel : rel;
        int large = 8 + (int)(logf((float)(n < 1 ? 1 : n) / 8.0f) / 2.772588722239781f * 8.0f); large = large > 15 ? 15 : large;
        const int bucket = (rel > 0 ? 16 : 0) + (n < 8 ? n : large);
        lut[i] = a.lut_src[bucket * 4 + h] * LOG2E; }
    f32x16 va[2], ob[2]; float la, lb;
    float bmax = 0.f; for (int i = 0; i < 32; ++i) bmax = fmaxf(bmax, fabsf(a.lut_src[i * 4 + h]));
    const bool nomax = score_bound(a, tid) + bmax * LOG2E <= NOMAX_BOUND;
    LAS float* park = (LAS float*)(lds + PARK_OFF) + (tid >> 6) * 2048 + (tid & 63);
    if (nomax) pipe_run<64, 0, 2, true, true>(a, bh, qb, lds, tid, va, la); else pipe_run<64, 0, 2, true, false>(a, bh, qb, lds, tid, va, la);
    { const float i0 = 1.0f / la;
#pragma unroll
      for (int r = 0; r < 16; ++r) { park[r * 64] = va[0][r] * i0; park[(16 + r) * 64] = va[1][r] * i0; } }
    if (nomax) pipe_run<64, 2, 2, true, true>(a, bh, qb, lds, tid, ob, lb); else pipe_run<64, 2, 2, true, false>(a, bh, qb, lds, tid, ob, lb);
#pragma unroll
    for (int r = 0; r < 16; ++r) { va[0][r] = park[r * 64]; va[1][r] = park[(16 + r) * 64]; }
    float s1 = 0.f, s2 = 0.f;
    for (int i = 0; i < 32; ++i) { s1 += a.lam_src[i] * a.lam_src[32 + i]; s2 += a.lam_src[64 + i] * a.lam_src[96 + i]; }
    const float lam = expf(s1) - expf(s2) + a.lam_init, i1 = lam / lb;
    va[0] = va[0] - ob[0] * i1; va[1] = va[1] - ob[1] * i1;
    float s = 0.f;
#pragma unroll
    for (int r = 0; r < 16; ++r) s += va[0][r] * va[0][r] + va[1][r] * va[1][r];
    s += __shfl_xor(s, 32);
    const float rn = 1.0f / sqrtf(s * (1.0f / 64.0f) + EPS);
    va[0] = va[0] * rn; va[1] = va[1] * rn;
    store_rows(a, bh, qb, tid, va);
}
}

__device__ __forceinline__ void attention_phase(const Ctx& c, int l) {
    bf16_t* Y = c.wsb(WS_R);
    for (int u = c.bid; u < 1024; u += c.G) {
        const int type = u >> 8, v = u & 255, bh = v & 7, qb = v >> 3;
        int tid_u = c.tid; asm volatile("" : "+v"(tid_u));
        if (type == 0 && EN(8)) { att::Args a{c.wsb(WS_QC), c.wsb(WS_KC), c.wsb(WS_VC), Y, 512, 0, 4, c.kp->in[I_T5], c.kp->in[I_DLAM] + l * 128, lambda_init(l), c.kp->in[I_DQN] + l * 32, c.kp->in[I_DKN] + l * 32, 32, 5.656854249f}; att::unit_diff(a, bh, qb, c.lds, tid_u); }
        else if (type == 1 && EN(9)) { att::Args a{c.wsb(WS_QB), c.wsb(WS_KB), c.wsb(WS_VB), Y, 256, 0, 4, nullptr, nullptr, 0.f, c.kp->in[I_MLAQN] + l * 96, c.kp->in[I_MLAKN] + l * 96, 96, 9.797958971f}; att::unit_plain<96>(a, bh, qb, c.lds, tid_u); }
        else if (type == 2 && EN(10)) { att::Args a{c.wsb(WS_QD), c.wsb(WS_KD), c.wsb(WS_VD), Y, 768, 1, 2, nullptr, nullptr, 0.f, c.kp->in[I_GQN] + l * 64, c.kp->in[I_GKN] + l * 64, 64, 8.0f}; att::unit_plain<64>(a, bh, qb, c.lds, tid_u); }
        else if (type == 3 && EN(11)) { att::Args a{c.wsb(WS_QA), c.wsb(WS_KA), c.wsb(WS_VA), Y, 0, 0, 4, c.kp->in[I_NARPB] + l * 4 * 465, nullptr, 0.f, nullptr, nullptr, 0, 0.f}; att::unit<2, 64>(a, bh, qb, c.lds, tid_u); }
    }
}

__device__ __forceinline__ void ynorm_phase(const Ctx& c) {
    const int gw = c.bid * NWAVES + c.wave, NGW = c.G * NWAVES; bf16_t* Y = c.wsb(WS_R);
    for (int row = gw; row < MROWS; row += NGW) {
        u32x4* yr = (u32x4*)(Y + (size_t)row * DM + c.lane * 16);
        const u32x4 u0 = yr[0], u1 = yr[1]; float v[16]; unpack8(u0, v); unpack8(u1, v + 8);
        float s = 0.f;
#pragma unroll
        for (int j = 0; j < 16; ++j) s += v[j] * v[j];
        s += __shfl_xor(s, 1); s += __shfl_xor(s, 2); s += __shfl_xor(s, 4); s += __shfl_xor(s, 8);
        const float rs = 1.0f / sqrtf(s * (1.0f / 256.0f) + EPS);
        if ((c.lane >> 4) != 2) {
#pragma unroll
            for (int j = 0; j < 16; ++j) v[j] *= rs;
            yr[0] = pack8(v); yr[1] = pack8(v + 8);
        }
    }
}
__device__ __forceinline__ void final_phase(const Ctx& c) {
    const int gw = c.bid * NWAVES + c.wave, NGW = c.G * NWAVES; float* X = c.kp->out; const float* ss3 = c.ssp(2); const float* gf = c.kp->in[I_FINN] + DM;
    for (int row = gw; row < MROWS; row += NGW) {
        const float rs = 1.0f / sqrtf(pg8::sum16(ss3 + (size_t)row * 16) * (1.0f / DM) + EPS);
        f32x4* xr = (f32x4*)(X + (size_t)row * DM) + c.lane;
#pragma unroll
        for (int j = 0; j < 4; ++j) { const f32x4 g = *((const f32x4*)gf + c.lane + 64 * j); xr[64 * j] = xr[64 * j] * g * rs; }
    }
}

constexpr int N_PHASES = 21;
__device__ __forceinline__ void run_kind(const Ctx& c, int kind, int l) {
    using namespace pg8;
    const int G = c.G, bid = c.bid;
    switch (kind) {
        case 0: case 7: if (EN(0)) {
            const bool second = kind == 7;
            Gemm g{c.wsb(WS_XB), c.wsb(second ? WS_WGU2 : WS_WGU1), MROWS, 2 * DFF, DM}; StaticOrder S; S.init(MROWS, 2 * DFF, G, bid);
            RowScale rsc; if (second) { rsc.ss1 = nullptr; rsc.ssp = c.ssp(1); rsc.ssgp = nullptr; } else if (l == 0) { rsc.ss1 = c.ss0(); rsc.ssp = nullptr; rsc.ssgp = nullptr; } else { rsc.ss1 = nullptr; rsc.ssp = c.ssp(2); rsc.ssgp = c.ssp(3); }
            EpiSwiGLU E{c.wsb(WS_R), rsc};
            gemm_phase<EpiSwiGLU, StaticOrder, true, true>(c.lds, g, S, E, c.tid);
        } break;
        case 1: case 8: if (EN(1)) {
            const bool second = kind == 8;
            Gemm g{c.wsb(WS_R), c.wsb(second ? WS_WD2 : WS_WD1), MROWS, DM, DFF}; StaticOrder S; S.init(MROWS, DM, G, bid);
            EpiResid E;
            E.alpha = 0.5f; E.out = c.kp->out; E.outb = c.wsb(WS_XB);
            if (second) { E.base = c.kp->out; E.bss = nullptr; E.bg = nullptr; E.ss_out = c.ssp(2); E.gf = c.kp->in[I_FINN] + l * DM; E.ssg_out = c.ssp(3); }
            else { E.ss_out = c.ssp(0); E.gf = nullptr; E.ssg_out = nullptr;
                   if (l == 0) { E.base = c.kp->in[I_X]; E.bss = nullptr; E.bg = nullptr; } else { E.base = c.kp->out; E.bss = c.ssp(2); E.bg = c.kp->in[I_FINN] + (l - 1) * DM; } }
            gemm_phase<EpiResid, StaticOrder, true, true>(c.lds, g, S, E, c.tid);
        } break;
        case 2: if (EN(2)) {
            Gemm g{c.wsb(WS_XB), c.wsb(WS_WIN), MROWS, NIN, DM}; StaticOrder S; S.init(MROWS, NIN, G, bid);
            RowScale rsc{nullptr, c.ssp(0), nullptr};
            EpiScaleBf16 E{c.wsb(WS_R), NIN, rsc};
            gemm_phase<EpiScaleBf16, StaticOrder, true, true>(c.lds, g, S, E, c.tid);
        } break;
        case 3: if (EN(3)) for (int T = bid; T < MROWS / 64; T += G) prep_unit(c, l, T); break;
        case 4: if (EN(4)) attention_phase(c, l); break;
        case 5: if (EN(5)) ynorm_phase(c); break;
        case 6: if (EN(6)) {
            Gemm g{c.wsb(WS_R), c.wsb(WS_WOUT), MROWS, DM, DM}; StaticOrder S; S.init(MROWS, DM, G, bid);
            EpiResid E; E.base = c.kp->out; E.bss = nullptr; E.bg = nullptr; E.alpha = 1.0f; E.out = c.kp->out; E.outb = c.wsb(WS_XB); E.ss_out = c.ssp(1); E.gf = nullptr; E.ssg_out = nullptr;
            gemm_phase<EpiResid, StaticOrder, true, true>(c.lds, g, S, E, c.tid);
        } break;
        default: break;
    }
}

__global__ void __launch_bounds__(NTHREADS, 2) fwd_megakernel(Params p) {
    extern __shared__ __attribute__((aligned(16))) unsigned char lds_raw[];
    cg::grid_group grid = cg::this_grid();
    const int ph_lo = p.ph_lo, ph_hi = p.ph_hi;
    const int wave_id = __builtin_amdgcn_readfirstlane((int)threadIdx.x >> 6);
    {
        volatile LAS unsigned* st0 = (volatile LAS unsigned*)((LAS unsigned char*)lds_raw + LDS_MISC);
        if (threadIdx.x < 4) st0[threadIdx.x] = 0u;
        __syncthreads();
        (void)xcd_barrier_post((unsigned*)p.ws, st0);
    }
    for (int ph = ph_lo; ph < ph_hi; ++ph) {
        if (ph == ph_lo + 1) grid.sync();
        else if (ph > ph_lo + 1) { XcdBarrier xb; xb.bar = (unsigned*)((KParams)__builtin_amdgcn_kernarg_segment_ptr())->ws; xb.x = xb_xcc_id(); xb.st = (volatile LAS unsigned*)((LAS unsigned char*)lds_raw + LDS_MISC); xcd_barrier(xb); }
        KParams kp = (KParams)__builtin_amdgcn_kernarg_segment_ptr();
        asm volatile("" : "+s"(kp));
        int lane_; asm volatile("v_mbcnt_lo_u32_b32 %0, -1, 0\n\tv_mbcnt_hi_u32_b32 %0, -1, %0" : "=v"(lane_));
        int tid_ = wave_id * 64 + lane_, bid_ = blockIdx.x, G_ = gridDim.x; unsigned lds_ = (unsigned)(uintptr_t)(LAS unsigned char*)lds_raw;
        asm volatile("" : "+v"(tid_)); asm volatile("" : "+s"(bid_)); asm volatile("" : "+s"(G_)); asm volatile("" : "+s"(lds_));
        Ctx c; c.kp = kp; c.lds = (LAS unsigned char*)(uintptr_t)lds_; c.tid = tid_; c.lane = c.tid & 63; c.wave = __builtin_amdgcn_readfirstlane(c.tid >> 6); c.G = G_; c.bid = bid_;
        if (ph == 0) { if (EN(16)) prologue(c); }
        else if (ph == 10) { if (EN(18)) wconv_layer(c, 1); }
        else if (ph == 20) { if (EN(17)) final_phase(c); }
        else { const int l = ph > 10 ? 1 : 0; run_kind(c, ph - 1 - 10 * l, l); if (MK_DUP >= 0 && ph - 1 - 10 * l == MK_DUP) { __syncthreads(); run_kind(c, ph - 1 - 10 * l, l); } }
    }
}

extern "C" void kernel_launch(void* const* d_in, const int* in_sizes, int n_in, void* d_out, int out_size, void* d_ws, size_t ws_size, hipStream_t stream) {
    static int grid = 0;
    if (grid == 0) {
        if (n_in != 32 || out_size != MROWS * DM || ws_size < WS_END) { fprintf(stderr, "kernel_launch: unexpected shapes (n_in %d, out %d, ws %zu)\n", n_in, out_size, ws_size); grid = -1; return; }
        int dev = 0, cus = 0, per_cu = 0;
        hipGetDevice(&dev); hipDeviceGetAttribute(&cus, hipDeviceAttributeMultiprocessorCount, dev);
        hipFuncSetAttribute((const void*)fwd_megakernel, hipFuncAttributeMaxDynamicSharedMemorySize, LDS_BYTES);
        hipOccupancyMaxActiveBlocksPerMultiprocessor(&per_cu, (const void*)fwd_megakernel, NTHREADS, LDS_BYTES);
        if (per_cu < 1) { fprintf(stderr, "kernel_launch: occupancy query says %d blocks per CU\n", per_cu); per_cu = 1; }
        (void)hipGetLastError();
        grid = cus * 1;
    }
    if (grid < 0) return;
    if (hipMemsetAsync((char*)d_ws + WS_BAR, 0, BAR_ZERO_BYTES, stream) != hipSuccess) { fprintf(stderr, "kernel_launch: memset of barrier words failed\n"); return; }
    Params p{};
    for (int i = 0; i < 32; ++i) p.in[i] = (const float*)d_in[i];
    p.out = (float*)d_out; p.ws = (unsigned char*)d_ws;
#if MK_SPLIT
    for (int ph = 0; ph < N_PHASES; ++ph) {
        p.ph_lo = ph; p.ph_hi = ph + 1; void* args[] = {&p};
        hipError_t e = hipLaunchCooperativeKernel((const void*)fwd_megakernel, dim3(grid), dim3(NTHREADS), args, LDS_BYTES, stream);
        if (e != hipSuccess) { fprintf(stderr, "cooperative launch failed: %s (grid %d)\n", hipGetErrorString(e), grid); break; }
    }
#else
    p.ph_lo = 0; p.ph_hi = N_PHASES; void* args[] = {&p};
    hipError_t e = hipLaunchCooperativeKernel((const void*)fwd_megakernel, dim3(grid), dim3(NTHREADS), args, LDS_BYTES, stream);
    if (e != hipSuccess) fprintf(stderr, "cooperative launch failed: %s (grid %d)\n", hipGetErrorString(e), grid);
#endif
}
```

```cpp
#include <hip/hip_runtime.h>
#include <hip/hip_cooperative_groups.h>
#include <cstdio>
#include <cstdint>
namespace cg = cooperative_groups;

#ifndef MK_ENABLE
#define MK_ENABLE 0xFFFFFF
#endif
#define EN(k) ((MK_ENABLE >> (k)) & 1)
#ifndef MK_DUP
#define MK_DUP -1
#endif
#ifndef MK_SPLIT
#define MK_SPLIT 0
#endif

#define LAS __attribute__((address_space(3)))
typedef unsigned short bf16_t;
typedef short bf16x8 __attribute__((ext_vector_type(8)));
typedef float f32x4 __attribute__((ext_vector_type(4)));
typedef float f32x16 __attribute__((ext_vector_type(16)));
typedef unsigned u32x4 __attribute__((ext_vector_type(4)));
typedef unsigned u32x2 __attribute__((ext_vector_type(2)));
typedef float f32x2_t __attribute__((ext_vector_type(2)));
typedef __bf16 bf16x2_t __attribute__((ext_vector_type(2)));

constexpr int BATCH = 2, SEQ = 8192, DM = 1024, MROWS = BATCH * SEQ, DFF = 2816, NIN = 2560, NTILE = SEQ / 64, DEPTH = 2;
constexpr float EPS = 1e-6f;
constexpr float LOG2E = 1.4426950408889634f;
constexpr int NWAVES = 8, NTHREADS = 512;

constexpr size_t MiB = 1u << 20;
constexpr size_t WS_SS0 = 65536;
constexpr size_t WS_SSP = 252 * MiB;
constexpr size_t WS_TAB = 1 * MiB;
constexpr size_t WS_WGU1 = 3 * MiB, WS_WD1 = 14 * MiB, WS_WIN = 19 * MiB + 512 * 1024, WS_WOUT = 24 * MiB + 512 * 1024, WS_WGU2 = 26 * MiB + 512 * 1024, WS_WD2 = 37 * MiB + 512 * 1024;
constexpr size_t WS_WUQ = 43 * MiB, WS_WUKV = 43 * MiB + 256 * 1024;
constexpr size_t WS_XB = 44 * MiB;
constexpr size_t WS_R = 76 * MiB;
constexpr size_t WS_QA = 156 * MiB, WS_KA = 164 * MiB, WS_VA = 172 * MiB, WS_QB = 180 * MiB, WS_KB = 192 * MiB, WS_VB = 204 * MiB;
constexpr size_t WS_QC = 212 * MiB, WS_KC = 220 * MiB, WS_VC = 228 * MiB, WS_QD = 236 * MiB, WS_KD = 244 * MiB, WS_VD = 248 * MiB, WS_END = 256 * MiB;
constexpr int LDS_BYTES = 147456;
constexpr int LDS_MISC = LDS_BYTES - 64;
constexpr size_t WS_BAR = 0, BAR_ZERO_BYTES = 16384;

__device__ __forceinline__ unsigned pk2(float lo, float hi) { f32x2_t v = {lo, hi}; bf16x2_t b = __builtin_convertvector(v, bf16x2_t); return __builtin_bit_cast(unsigned, b); }
__device__ __forceinline__ float bf2f(unsigned short u) { return __uint_as_float(((unsigned)u) << 16); }
__device__ __forceinline__ void unpack8(const u32x4 u, float* v) {
    v[0] = __uint_as_float(u.x << 16); v[1] = __uint_as_float(u.x & 0xffff0000u); v[2] = __uint_as_float(u.y << 16); v[3] = __uint_as_float(u.y & 0xffff0000u);
    v[4] = __uint_as_float(u.z << 16); v[5] = __uint_as_float(u.z & 0xffff0000u); v[6] = __uint_as_float(u.w << 16); v[7] = __uint_as_float(u.w & 0xffff0000u);
}
__device__ __forceinline__ u32x4 pack8(const float* v) { u32x4 u; u.x = pk2(v[0], v[1]); u.y = pk2(v[2], v[3]); u.z = pk2(v[4], v[5]); u.w = pk2(v[6], v[7]); return u; }
__device__ __forceinline__ float wave_sum(float v) {
#pragma unroll
    for (int o = 1; o < 64; o <<= 1) v += __shfl_xor(v, o);
    return v;
}

namespace pg8 {
constexpr int BM = 256, BK = 64, HALF = 128, HTB = HALF * BK * 2, STAGE_BYTES = 8 * HTB, NXCD = 8, WGM = 8;
__host__ __device__ __forceinline__ int lds_byte(int r, int c) { const int st = (r >> 4) * 2 + (c >> 5), rr = r & 15, cc = c & 31, ob = rr * 64 + cc * 2; return st * 1024 + (ob ^ (((ob >> 9) & 1) << 5)); }
__host__ __device__ __forceinline__ void stage_rc(int b, int& R, int& C) { const int st = b / 1024, sb = b % 1024, swz = sb ^ (((sb >> 9) & 1) << 5); R = (st >> 1) * 16 + swz / 64; C = (st & 1) * 32 + (swz % 64) / 2; }
__host__ __device__ __forceinline__ int perm32(int rho) { const int n = rho >> 4, i = rho & 15; return 8 * (i >> 2) + 4 * n + (i & 3); }
struct Unit { int pm, pn; };
struct Gemm { const bf16_t* A; const bf16_t* Bt; int M, N, K; };
struct StaticOrder {
    int nM, nN, nwg, G, c;
    __host__ __device__ void init(int M, int N, int G_, int c_) { nM = M / BM; nN = N / BM; nwg = nM * nN; G = G_; c = c_; }
    __host__ __device__ bool next(int i, Unit& u) const {
        const long L = (long)i * G + c; if (L >= nwg) return false;
        int wgid = (int)L; { const int q = nwg / NXCD, r = nwg % NXCD, xcd = wgid % NXCD, off = wgid / NXCD; wgid = (xcd < r ? xcd * (q + 1) : r * (q + 1) + (xcd - r) * q) + off; }
        const int nig = WGM * nN, gid = wgid / nig, fm = gid * WGM, gsz = (nM - fm) < WGM ? (nM - fm) : WGM;
        u.pm = fm + ((wgid % nig) % gsz); u.pn = (wgid % nig) / gsz; return true;
    }
    __device__ __forceinline__ void a_ready(const Unit&) const {}
    __device__ __forceinline__ void done(const Unit&) const {}
};

__device__ __forceinline__ float sum16(const float* p) {
    const f32x4 a = *(const f32x4*)p, b = *(const f32x4*)(p + 4), c = *(const f32x4*)(p + 8), d = *(const f32x4*)(p + 12);
    return (((a[0] + a[1]) + (a[2] + a[3])) + ((b[0] + b[1]) + (b[2] + b[3]))) + (((c[0] + c[1]) + (c[2] + c[3])) + ((d[0] + d[1]) + (d[2] + d[3])));
}
struct RowScale {
    const float* ss1; const float* ssp; const float* ssgp;
    __device__ __forceinline__ float get(int row) const {
        const float s = ss1 ? ss1[row] : sum16(ssp + (size_t)row * 16);
        float rs = 1.0f / sqrtf(s * (1.0f / DM) + EPS);
        if (ssgp) { const float rsn = 1.0f / sqrtf(rs * rs * sum16(ssgp + (size_t)row * 16) * (1.0f / DM) + EPS); rs *= rsn; }
        return rs;
    }
};

struct EpiSwiGLU {
    static constexpr bool PERM = true, AFTER_DRAIN = false;
    bf16_t* O; RowScale rsc;
    __device__ __forceinline__ void operator()(const f32x4 (&acc)[2][2][4][2], const Unit& u, int wr, int wc, int fr, int fq) const {
        const int row0 = u.pm * BM + wr * 64 + fr, col0 = u.pn * HALF + wc * 32 + 8 * fq;
#pragma unroll
        for (int ai = 0; ai < 2; ++ai)
#pragma unroll
            for (int m = 0; m < 4; ++m) {
                const int row = row0 + ai * HALF + m * 16; const float rs = rsc.get(row);
                float a[8];
#pragma unroll
                for (int n = 0; n < 2; ++n)
#pragma unroll
                    for (int i = 0; i < 4; ++i) {
                        const float g = acc[ai][0][m][n][i] * rs, up = acc[ai][1][m][n][i] * rs;
                        const float sg = g * __builtin_amdgcn_rcpf(1.0f + __builtin_amdgcn_exp2f(-g * LOG2E));
                        a[n * 4 + i] = sg * up;
                    }
                *(u32x4*)(O + (size_t)row * DFF + col0) = pack8(a);
            }
    }
};
struct EpiScaleBf16 {
    static constexpr bool PERM = true, AFTER_DRAIN = false;
    bf16_t* O; int ldo; RowScale rsc;
    __device__ __forceinline__ void operator()(const f32x4 (&acc)[2][2][4][2], const Unit& u, int wr, int wc, int fr, int fq) const {
        const int row0 = u.pm * BM + wr * 64 + fr, col0 = u.pn * BM + wc * 32 + 8 * fq;
#pragma unroll
        for (int ai = 0; ai < 2; ++ai)
#pragma unroll
            for (int m = 0; m < 4; ++m) {
                const int row = row0 + ai * HALF + m * 16; const float rs = rsc.get(row);
#pragma unroll
                for (int bj = 0; bj < 2; ++bj) {
                    float a[8];
#pragma unroll
                    for (int n = 0; n < 2; ++n)
#pragma unroll
                        for (int i = 0; i < 4; ++i) a[n * 4 + i] = acc[ai][bj][m][n][i] * rs;
                    *(u32x4*)(O + (size_t)row * ldo + col0 + bj * HALF) = pack8(a);
                }
            }
    }
};
struct EpiResid {
    static constexpr bool PERM = false, AFTER_DRAIN = false;
    const float* base; const float* bss; const float* bg; float alpha; float* out; bf16_t* outb; float* ss_out; const float* gf; float* ssg_out;
    __device__ __forceinline__ void operator()(const f32x4 (&acc)[2][2][4][2], const Unit& u, int wr, int wc, int fr, int fq) const {
        const int row0 = u.pm * BM + wr * 64 + fr, col0 = u.pn * BM + wc * 32 + 4 * fq;
#pragma unroll
        for (int ai = 0; ai < 2; ++ai)
#pragma unroll
            for (int m = 0; m < 4; ++m) {
                const int row = row0 + ai * HALF + m * 16; const size_t off = (size_t)row * DM + col0;
                float brs = 1.0f; if (bss) brs = 1.0f / sqrtf(sum16(bss + (size_t)row * 16) * (1.0f / DM) + EPS);
                float s = 0.f, sg = 0.f;
#pragma unroll
                for (int bj = 0; bj < 2; ++bj)
#pragma unroll
                    for (int n = 0; n < 2; ++n) {
                        const int co = bj * HALF + n * 16;
                        f32x4 b = *(const f32x4*)(base + off + co);
                        if (bss) { const f32x4 g = *(const f32x4*)(bg + col0 + co); b = b * g * brs; }
                        const f32x4 v = b + acc[ai][bj][m][n] * alpha;
                        *(f32x4*)(out + off + co) = v;
                        u32x2 w; w.x = pk2(v[0], v[1]); w.y = pk2(v[2], v[3]); *(u32x2*)(outb + off + co) = w;
                        s += (v[0] * v[0] + v[1] * v[1]) + (v[2] * v[2] + v[3] * v[3]);
                        if (gf) { const f32x4 g2 = *(const f32x4*)(gf + col0 + co); const f32x4 t = v * g2; sg += (t[0] * t[0] + t[1] * t[1]) + (t[2] * t[2] + t[3] * t[3]); }
                    }
                s += __shfl_xor(s, 16); s += __shfl_xor(s, 32);
                if (fq == 0) ss_out[(size_t)row * 16 + u.pn * 4 + wc] = s;
                if (gf) { sg += __shfl_xor(sg, 16); sg += __shfl_xor(sg, 32); if (fq == 0) ssg_out[(size_t)row * 16 + u.pn * 4 + wc] = sg; }
            }
    }
};

template <class Epi, class Sched, bool ALIGN_EPI = false, bool SP2 = false>
__device__ __forceinline__ void gemm_phase(LAS unsigned char* lds, const Gemm g, const Sched& S, const Epi& E, const int tid) {
    const int wid = __builtin_amdgcn_readfirstlane(tid >> 6), lane = tid & 63, wr = wid >> 2, wc = wid & 3, fr = lane & 15, fq = lane >> 4;
    const int K = g.K, nt = K / BK;
    unsigned voffA[2], voffB[2];
#pragma unroll
    for (int i = 0; i < 2; ++i) { int R, C; stage_rc(tid * 16 + i * 8192, R, C); const int Rb = Epi::PERM ? ((R & ~31) + perm32(R & 31)) : R;
        voffA[i] = (unsigned)(R * K + C) * 2u; voffB[i] = (unsigned)(Rb * K + C) * 2u; }
    const size_t kstep = (size_t)(BK * 2);
    const size_t hstep = (size_t)HALF * K * 2;
    const size_t tstep = 2 * hstep;
    const unsigned ldsw = (unsigned)wid * 1024u;
    const int aoff = lds_byte(wr * 64 + fr, fq * 8), boff = lds_byte(wc * 32 + fr, fq * 8);
#define PG8_SA(b, h) (((b) * 2 + (h)) * HTB)
#define PG8_SB(b, h) ((4 + (b) * 2 + (h)) * HTB)
#define PG8_STAGE(bufoff, gbase, voff) do { _Pragma("unroll") for (int _i = 0; _i < 2; ++_i) \
        __builtin_amdgcn_global_load_lds((const unsigned*)((const char*)(gbase) + (voff)[_i]), (LAS unsigned*)(lds + (bufoff) + ldsw + _i * 8192), 16, 0, 0); } while (0)
#define PG8_LDA(dst, b, h) do { _Pragma("unroll") for (int m = 0; m < 4; ++m) _Pragma("unroll") for (int k = 0; k < 2; ++k) dst[m][k] = *(const LAS bf16x8*)(lds + PG8_SA(b, h) + aoff + m * 2048 + k * 1024); } while (0)
#define PG8_LDB(dst, b, h) do { _Pragma("unroll") for (int n = 0; n < 2; ++n) _Pragma("unroll") for (int k = 0; k < 2; ++k) dst[n][k] = *(const LAS bf16x8*)(lds + PG8_SB(b, h) + boff + n * 2048 + k * 1024); } while (0)
#define PG8_MMA(ai, bj, At, Bt) do { __builtin_amdgcn_s_setprio(1); _Pragma("unroll") for (int m = 0; m < 4; ++m) _Pragma("unroll") for (int n = 0; n < 2; ++n) _Pragma("unroll") for (int k = 0; k < 2; ++k) \
        acc[ai][bj][m][n] = __builtin_amdgcn_mfma_f32_16x16x32_bf16(Bt[n][k], At[m][k], acc[ai][bj][m][n], 0, 0, 0); __builtin_amdgcn_s_setprio(0); } while (0)
#define PG8_WAIT_V(n) asm volatile("s_waitcnt vmcnt(" #n ")" ::: "memory")
#define PG8_WAIT_L(n) asm volatile("s_waitcnt lgkmcnt(" #n ")" ::: "memory")
#define PG8_BAR __builtin_amdgcn_s_barrier()
#define PG8_SCHED __builtin_amdgcn_sched_barrier(0)
    Unit cur, nxt; int ui = 0;
    if (!S.next(0, cur)) return;
    f32x4 acc[2][2][4][2];
#pragma unroll
    for (int a = 0; a < 2; ++a)
#pragma unroll
        for (int b = 0; b < 2; ++b)
#pragma unroll
            for (int m = 0; m < 4; ++m)
#pragma unroll
                for (int n = 0; n < 2; ++n) acc[a][b][m][n] = (f32x4){0.f, 0.f, 0.f, 0.f};
    bf16x8 At[4][2], B0[2][2], B1[2][2];
    const char* cA = (const char*)g.A + (size_t)cur.pm * tstep; const char* cB = (const char*)g.Bt + (size_t)cur.pn * tstep;
    S.a_ready(cur);
    if constexpr (SP2) {
        PG8_STAGE(PG8_SB(0, 0), cB, voffB); PG8_STAGE(PG8_SB(0, 1), cB + hstep, voffB); PG8_STAGE(PG8_SA(0, 0), cA, voffA); PG8_STAGE(PG8_SA(0, 1), cA + hstep, voffA);
        if (wr == 1) PG8_BAR;
        PG8_WAIT_V(2); PG8_BAR;
        PG8_STAGE(PG8_SB(1, 0), cB + kstep, voffB); PG8_STAGE(PG8_SA(1, 0), cA + kstep, voffA); PG8_STAGE(PG8_SB(1, 1), cB + hstep + kstep, voffB);
        PG8_WAIT_V(6); PG8_BAR;
    } else {
        PG8_STAGE(PG8_SB(0, 0), cB, voffB); PG8_STAGE(PG8_SA(0, 0), cA, voffA); PG8_STAGE(PG8_SB(0, 1), cB + hstep, voffB); PG8_STAGE(PG8_SA(0, 1), cA + hstep, voffA);
        if (wr == 1) PG8_BAR;
        PG8_WAIT_V(4); PG8_BAR;
        PG8_STAGE(PG8_SB(1, 0), cB + kstep, voffB); PG8_STAGE(PG8_SA(1, 0), cA + kstep, voffA); PG8_STAGE(PG8_SB(1, 1), cB + hstep + kstep, voffB);
        PG8_WAIT_V(6); PG8_BAR;
    }
    for (;;) {
        const bool has_next = S.next(ui + 1, nxt);
        const char* nA = has_next ? (const char*)g.A + (size_t)nxt.pm * tstep : cA; const char* nB = has_next ? (const char*)g.Bt + (size_t)nxt.pn * tstep : cB;
        for (int t = 0; t < nt; t += 2) {
            const bool last = (t == nt - 2);
            const char* a1 = cA + (size_t)(t + 1) * kstep;
            const char* a2 = last ? nA : cA + (size_t)(t + 2) * kstep; const char* b2 = last ? nB : cB + (size_t)(t + 2) * kstep;
            const char* a3 = a2 + kstep; const char* b3 = b2 + kstep;
            if (last && has_next) S.a_ready(nxt);
            if constexpr (SP2) {
            PG8_LDB(B0, 0, 0); PG8_LDB(B1, 0, 1); PG8_SCHED; PG8_LDA(At, 0, 0); PG8_STAGE(PG8_SA(1, 1), a1 + hstep, voffA);
            PG8_WAIT_V(8); PG8_WAIT_L(0); PG8_BAR; PG8_MMA(0, 0, At, B0); PG8_MMA(0, 1, At, B1); PG8_BAR; PG8_SCHED;
            PG8_LDA(At, 0, 1); PG8_STAGE(PG8_SB(0, 0), b2, voffB); PG8_STAGE(PG8_SB(0, 1), b2 + hstep, voffB); PG8_STAGE(PG8_SA(0, 0), a2, voffA);
            PG8_WAIT_V(8); PG8_WAIT_L(0); PG8_BAR; PG8_MMA(1, 0, At, B0); PG8_MMA(1, 1, At, B1); PG8_BAR; PG8_SCHED;
            PG8_LDB(B0, 1, 0); PG8_LDB(B1, 1, 1); PG8_SCHED; PG8_LDA(At, 1, 0); PG8_STAGE(PG8_SA(0, 1), a2 + hstep, voffA);
            PG8_WAIT_V(8); PG8_WAIT_L(0); PG8_BAR; PG8_MMA(0, 0, At, B0); PG8_MMA(0, 1, At, B1); PG8_BAR; PG8_SCHED;
            PG8_LDA(At, 1, 1); PG8_STAGE(PG8_SB(1, 0), b3, voffB); PG8_STAGE(PG8_SB(1, 1), b3 + hstep, voffB); PG8_STAGE(PG8_SA(1, 0), a3, voffA);
            PG8_WAIT_V(8); PG8_WAIT_L(0); PG8_BAR; PG8_MMA(1, 0, At, B0); PG8_MMA(1, 1, At, B1); PG8_BAR; PG8_SCHED;
            } else {
            PG8_LDB(B0, 0, 0); PG8_SCHED; PG8_LDA(At, 0, 0); PG8_STAGE(PG8_SA(1, 1), a1 + hstep, voffA);
            PG8_WAIT_L(8); PG8_BAR; PG8_WAIT_L(0); PG8_MMA(0, 0, At, B0); PG8_BAR; PG8_SCHED;
            PG8_LDB(B1, 0, 1); PG8_STAGE(PG8_SB(0, 0), b2, voffB);
            PG8_BAR; PG8_WAIT_L(0); PG8_MMA(0, 1, At, B1); PG8_BAR;
            PG8_LDA(At, 0, 1); PG8_STAGE(PG8_SA(0, 0), a2, voffA);
            PG8_BAR; PG8_WAIT_L(0); PG8_MMA(1, 0, At, B0); PG8_BAR; PG8_SCHED;
            PG8_STAGE(PG8_SB(0, 1), b2 + hstep, voffB);
            PG8_WAIT_V(6); PG8_BAR; PG8_MMA(1, 1, At, B1); PG8_BAR;
            PG8_LDB(B0, 1, 0); PG8_SCHED; PG8_LDA(At, 1, 0); PG8_STAGE(PG8_SA(0, 1), a2 + hstep, voffA);
            PG8_WAIT_L(8); PG8_BAR; PG8_WAIT_L(0); PG8_MMA(0, 0, At, B0); PG8_BAR; PG8_SCHED;
            PG8_LDB(B1, 1, 1); PG8_STAGE(PG8_SB(1, 0), b3, voffB);
            PG8_BAR; PG8_WAIT_L(0); PG8_MMA(0, 1, At, B1); PG8_BAR;
            PG8_LDA(At, 1, 1); PG8_STAGE(PG8_SA(1, 0), a3, voffA);
            PG8_BAR; PG8_WAIT_L(0); PG8_MMA(1, 0, At, B0); PG8_BAR; PG8_SCHED;
            PG8_STAGE(PG8_SB(1, 1), b3 + hstep, voffB);
            PG8_WAIT_V(6); PG8_BAR; PG8_MMA(1, 1, At, B1); PG8_BAR;
            }
        }
        if constexpr (ALIGN_EPI) { if (wr == 0) PG8_BAR; }
        if constexpr (!Epi::AFTER_DRAIN) { E(acc, cur, wr, wc, fr, fq); S.done(cur); }
        if (!has_next) break;
#pragma unroll
        for (int a = 0; a < 2; ++a)
#pragma unroll
            for (int b = 0; b < 2; ++b)
#pragma unroll
                for (int m = 0; m < 4; ++m)
#pragma unroll
                    for (int n = 0; n < 2; ++n) acc[a][b][m][n] = (f32x4){0.f, 0.f, 0.f, 0.f};
        cur = nxt; cA = nA; cB = nB; ++ui;
        if constexpr (ALIGN_EPI) { if (wr == 1) PG8_BAR; }
    }
    PG8_WAIT_V(0);
    if constexpr (!ALIGN_EPI) { if (wr == 0) PG8_BAR; }
    PG8_BAR;
#undef PG8_SA
#undef PG8_SB
#undef PG8_STAGE
#undef PG8_LDA
#undef PG8_LDB
#undef PG8_MMA
#undef PG8_WAIT_V
#undef PG8_WAIT_L
#undef PG8_BAR
#undef PG8_SCHED
}
}

#define RLX_AGENT __ATOMIC_RELAXED, __HIP_MEMORY_SCOPE_AGENT
#define XB_TMO      128
#define XB_XCNT(j)  (256  + 64 * (j))
#define XB_XSUB(j)  (1280 + 64 * (j))
#define XB_XGEN(j)  (2304 + 64 * (j))
#define XB_TOP      3328
#define XB_TOPGEN   3392
#define XCD_BAR_WORDS 3456
#define XB_SPIN_CAP (1u << 20)

__device__ __forceinline__ unsigned xb_ld(unsigned* p)              { return __hip_atomic_load(p, __ATOMIC_RELAXED, __HIP_MEMORY_SCOPE_AGENT); }
__device__ __forceinline__ unsigned xb_add(unsigned* p, unsigned v) { return __hip_atomic_fetch_add(p, v, __ATOMIC_RELAXED, __HIP_MEMORY_SCOPE_AGENT); }
__device__ __forceinline__ unsigned xb_xcc_id() { return (unsigned)__builtin_amdgcn_s_getreg((3 << 11) | 20) & 0xFu; }
#define XB_SPIN(cond, bar) do { unsigned _sp = 0; while (cond) { __builtin_amdgcn_s_sleep(1); \
    if ((++_sp & 255u) == 0u) { if (xb_ld(&(bar)[XB_TMO])) break; if (_sp > XB_SPIN_CAP) { atomicAdd(&(bar)[XB_TMO], 1u); break; } } } } while (0)

struct XcdBarrier {
    unsigned* bar; unsigned x;
    volatile LAS unsigned* st;
};

__device__ __forceinline__ XcdBarrier xcd_barrier_post(unsigned* bar, volatile LAS unsigned* st) {
    XcdBarrier b; b.bar = bar; b.x = xb_xcc_id(); b.st = st;
    if (threadIdx.x == 0) (void)xb_add(&bar[XB_XCNT(b.x)], 1u);
    return b;
}
__device__ __forceinline__ void xcd_barrier_complete(unsigned* bar, unsigned x, unsigned& nloc, unsigned& nx) {
    const unsigned G = gridDim.x * gridDim.y * gridDim.z;
    unsigned sum, cnt, mine, sp = 0u;
    for (;;) {
        sum = 0u; cnt = 0u; mine = 0u;
#pragma unroll
        for (unsigned j = 0; j < 16; ++j) { const unsigned c = xb_ld(&bar[XB_XCNT(j)]); sum += c; cnt += (c > 0u) ? 1u : 0u; mine = (j == x) ? c : mine; }
        if (sum == G) break;
        __builtin_amdgcn_s_sleep(1);
        if ((++sp & 255u) == 0u) { if (xb_ld(&bar[XB_TMO])) break; if (sp > XB_SPIN_CAP) { atomicAdd(&bar[XB_TMO], 1u); break; } }
    }
    nloc = mine > 0u ? mine : 1u; nx = cnt > 0u ? cnt : 1u;
}

__device__ __forceinline__ void xcd_barrier(const XcdBarrier& b) {
    asm volatile("s_waitcnt vmcnt(0)" ::: "memory");
    __syncthreads();
    if (threadIdx.x == 0) {
        unsigned* bar = b.bar;
        __builtin_amdgcn_s_waitcnt(0);
        unsigned nloc = b.st[0], nx = b.st[1];
        if (nloc == 0u) { xcd_barrier_complete(bar, b.x, nloc, nx); b.st[0] = nloc; b.st[1] = nx; }
        const unsigned old = xb_add(&bar[XB_XSUB(b.x)], 1u);
        const unsigned gen = old / nloc;
        if (old + 1u == (gen + 1u) * nloc) {
            __builtin_amdgcn_fence(__ATOMIC_RELEASE, "agent");
            asm volatile("s_waitcnt vmcnt(0)" ::: "memory");
            const unsigned og = xb_add(&bar[XB_TOP], 1u);
            const unsigned tg = og / nx;
            if (og + 1u == (tg + 1u) * nx) xb_add(&bar[XB_TOPGEN], 1u);
            else XB_SPIN(xb_ld(&bar[XB_TOPGEN]) == tg, bar);
            __builtin_amdgcn_fence(__ATOMIC_ACQUIRE, "agent");
            xb_add(&bar[XB_XGEN(b.x)], 1u);
            asm volatile("s_waitcnt vmcnt(0)" ::: "memory");
        } else {
            XB_SPIN(xb_ld(&bar[XB_XGEN(b.x)]) == gen, bar);
            __builtin_amdgcn_fence(__ATOMIC_ACQUIRE, "agent");
            asm volatile("s_waitcnt vmcnt(0)" ::: "memory");
        }
    }
    __syncthreads();
}


struct Params { const float* in[32]; float* out; unsigned char* ws; int ph_lo, ph_hi; };
enum { I_X = 0, I_F1N, I_F1G, I_F1U, I_F1D, I_MIXN, I_WIN, I_NAQN, I_NAKN, I_NARPB, I_NABETA, I_MLAQLN, I_MLAWUQ, I_MLAKVLN, I_MLAWUKV, I_MLAQN, I_MLAKN, I_MLABETA,
       I_DQN, I_DKN, I_DLAM, I_DSUBLN, I_GQN, I_GKN, I_GBETA, I_WOUT, I_F2N, I_F2G, I_F2U, I_F2D, I_FINN, I_T5 };
__host__ __device__ __forceinline__ float lambda_init(int l) { return l == 0 ? 0.2f : 0.35550906f; }

typedef const __attribute__((address_space(4))) Params* KParams;
typedef const float* const __attribute__((address_space(4)))* InPtr;
struct Ctx {
    KParams kp; LAS unsigned char* lds; int tid, lane, wave, G, bid;
    __device__ __forceinline__ float* ssp(int k) const { return (float*)(kp->ws + WS_SSP + (size_t)k * MiB); }
    __device__ __forceinline__ float* ss0() const { return (float*)(kp->ws + WS_SS0); }
    __device__ __forceinline__ bf16_t* wsb(size_t off) const { return (bf16_t*)(kp->ws + off); }
};

__device__ __forceinline__ float gain_for(const Ctx& c, int job, int l, int k) {
    InPtr in = c.kp->in;
    switch (job) {
        case 0: { float g = in[I_F1N][l * DM + k]; if (l > 0) g *= in[I_FINN][(l - 1) * DM + k]; return g; }
        case 2: return in[I_MIXN][l * DM + k];
        case 3: { const int gidx = k >> 8, kk = k & 255;
                  if (gidx == 0) return in[I_NABETA][l * 256 + kk];
                  if (gidx == 1) return in[I_MLABETA][l * 256 + kk];
                  if (gidx == 2) return in[I_DSUBLN][l * 64 + (kk & 63)] * (1.0f - lambda_init(l));
                  return in[I_GBETA][l * 256 + kk]; }
        case 4: return in[I_F2N][l * DM + k];
        case 6: return in[I_MLAQLN][l * 256 + k];
        case 7: return in[I_MLAKVLN][l * 128 + k];
        default: return 1.0f;
    }
}
__device__ __forceinline__ void tr_item64(const Ctx& c, const float* W0, const float* W1, int Nsrc, int sc0, int sc1, bf16_t* WT, int K, int n0, int k0, int job, int l, LAS float* scr) {
    const int lane = c.lane, hh = (lane & 15) >> 3, cc = 4 * (lane & 7);
    const float* W = hh ? W1 : W0; const int sc = hh ? sc1 : sc0;
    f32x4 v[16];
#pragma unroll
    for (int i = 0; i < 16; ++i) { const int kk = 4 * i + (lane >> 4);
        v[i] = (f32x4){0.f, 0.f, 0.f, 0.f}; if (sc >= 0) v[i] = *(const f32x4*)(W + (size_t)(k0 + kk) * Nsrc + sc + cc); }
#pragma unroll
    for (int i = 0; i < 16; ++i) { const int kk = 4 * i + (lane >> 4); LAS float* d = scr + kk * 65 + 4 * (lane & 15);
        d[0] = v[i][0]; d[1] = v[i][1]; d[2] = v[i][2]; d[3] = v[i][3]; }
    asm volatile("s_waitcnt lgkmcnt(0)" ::: "memory");
    const int ch = lane & 7;
    float g[8];
#pragma unroll
    for (int i = 0; i < 8; ++i) g[i] = gain_for(c, job, l, k0 + 8 * ch + i);
#pragma unroll
    for (int j = 0; j < 8; ++j) { const int n = (lane >> 3) + 8 * j; const LAS float* s = scr + (8 * ch) * 65 + n;
        u32x4 o; o.x = pk2(s[0 * 65] * g[0], s[1 * 65] * g[1]); o.y = pk2(s[2 * 65] * g[2], s[3 * 65] * g[3]); o.z = pk2(s[4 * 65] * g[4], s[5 * 65] * g[5]); o.w = pk2(s[6 * 65] * g[6], s[7 * 65] * g[7]);
        *(u32x4*)(WT + (size_t)(n0 + n) * K + k0 + 8 * ch) = o; }
    asm volatile("s_waitcnt lgkmcnt(0)" ::: "memory");
}
__device__ __forceinline__ void wconv_layer(const Ctx& c, int l) {
    LAS float* scr = (LAS float*)(c.lds + c.wave * 16640);
    const int gw = c.bid * NWAVES + c.wave, NGW = c.G * NWAVES;
    constexpr int C0 = 16 * 88, C1 = 44 * 16, C2 = 16 * 40, C3 = 16 * 16, C6 = 4 * 6, C7 = 2 * 8;
    constexpr int NITEMS = 2 * C0 + 2 * C1 + C2 + C3 + C6 + C7;
    InPtr in = c.kp->in;
    for (int it = gw; it < NITEMS; it += NGW) {
        int r = it;
        if (r < C0 || (r >= C0 + C1 + C2 + C3 && r < 2 * C0 + C1 + C2 + C3)) {
            const bool second = r >= C0; if (second) r -= C0 + C1 + C2 + C3;
            const int nblk = 88, kb = r / nblk, nb = r % nblk, pn = nb >> 2, blk = nb & 3;
            const float* Wg = second ? in[I_F2G] : in[I_F1G]; const float* Wu = second ? in[I_F2U] : in[I_F1U];
            const float* W = (blk < 2 ? Wg : Wu) + (size_t)l * DM * DFF; const int sc = 128 * pn + 64 * (blk & 1);
            tr_item64(c, W, W, DFF, sc, sc + 32, c.wsb(second ? WS_WGU2 : WS_WGU1), DM, 64 * nb, 64 * kb, second ? 4 : 0, l, scr);
            continue;
        }
        r -= C0;
        if (r < C1) { const int kb = r / 16, nb = r % 16; const float* W = in[I_F1D] + (size_t)l * DFF * DM; tr_item64(c, W, W, DM, 64 * nb, 64 * nb + 32, c.wsb(WS_WD1), DFF, 64 * nb, 64 * kb, 1, l, scr); continue; }
        r -= C1;
        if (r < C2) { const int kb = r / 40, nb = r % 40, n0 = 64 * nb;
            const float* W = in[I_WIN] + (size_t)l * DM * 2464; int sc[2];
#pragma unroll
            for (int hh = 0; hh < 2; ++hh) { const int n = n0 + 32 * hh; sc[hh] = n < 1184 ? n : (n < 1280 ? -1 : n - 96); }
            tr_item64(c, W, W, 2464, sc[0], sc[1], c.wsb(WS_WIN), DM, n0, 64 * kb, 2, l, scr); continue; }
        r -= C2;
        if (r < C3) { const int kb = r / 16, nb = r % 16; const float* W = in[I_WOUT] + (size_t)l * DM * DM; tr_item64(c, W, W, DM, 64 * nb, 64 * nb + 32, c.wsb(WS_WOUT), DM, 64 * nb, 64 * kb, 3, l, scr); continue; }
        r -= C3; r -= C0;
        if (r < C1) { const int kb = r / 16, nb = r % 16; const float* W = in[I_F2D] + (size_t)l * DFF * DM; tr_item64(c, W, W, DM, 64 * nb, 64 * nb + 32, c.wsb(WS_WD2), DFF, 64 * nb, 64 * kb, 5, l, scr); continue; }
        r -= C1;
        if (r < C6) { const int kb = r / 6, nb = r % 6; const float* W = in[I_MLAWUQ] + (size_t)l * 256 * 384; tr_item64(c, W, W, 384, 64 * nb, 64 * nb + 32, c.wsb(WS_WUQ), 256, 64 * nb, 64 * kb, 6, l, scr); continue; }
        r -= C6;
        { const int kb = r / 8, nb = r % 8; const float* W = in[I_MLAWUKV] + (size_t)l * 128 * 512; tr_item64(c, W, W, 512, 64 * nb, 64 * nb + 32, c.wsb(WS_WUKV), 128, 64 * nb, 64 * kb, 7, l, scr); }
    }
}
__device__ __forceinline__ void prologue(const Ctx& c) {
    const int gt = c.bid * NTHREADS + c.tid, NGT = c.G * NTHREADS;
    for (int i = gt; i < SEQ * 16; i += NGT) {
        const int pos = i >> 4, fi = i & 15;
        const float inv = expf(-9.210340371976184f * (float)(2 * fi) / 32.0f);
        const float ang = (float)pos * inv;
        const double a = (double)ang * 0.15915494309189535;
        const double fr = a - rint(a);
        const float f = (float)fr;
        float2 cs; cs.x = __builtin_amdgcn_cosf(f); cs.y = __builtin_amdgcn_sinf(f);
        ((float2*)(c.kp->ws + WS_TAB))[i] = cs;
    }
    const int gw = c.bid * NWAVES + c.wave, NGW = c.G * NWAVES;
    const float* x = c.kp->in[I_X]; bf16_t* xb = c.wsb(WS_XB); float* ss0 = c.ss0();
    for (int row = gw; row < MROWS; row += NGW) {
        const f32x4* xr = (const f32x4*)(x + (size_t)row * DM) + c.lane; float s = 0.f;
#pragma unroll
        for (int j = 0; j < 4; ++j) { const f32x4 v = xr[64 * j]; s += (v[0] * v[0] + v[1] * v[1]) + (v[2] * v[2] + v[3] * v[3]);
            u32x2 w; w.x = pk2(v[0], v[1]); w.y = pk2(v[2], v[3]); *((u32x2*)(xb + (size_t)row * DM) + c.lane + 64 * j) = w; }
        s = wave_sum(s); if (c.lane == 0) ss0[row] = s;
    }
    wconv_layer(c, 0);
}

constexpr int PL_VS = 0, PL_CQ = 73728, PL_CKV = 107520, PL_KR = 124928, PL_RSQ = 133120, PL_RSKV = 133376;
__device__ __forceinline__ void vt_write(const Ctx& c, int slot0, int nh, bf16_t* Vbase, int kvh0, int tt) {
    const LAS bf16_t* VS = (const LAS bf16_t*)(c.lds + PL_VS);
    const int kc = c.tid >> 6, d = c.tid & 63;
    for (int h = 0; h < nh; ++h) {
        unsigned short e[8];
#pragma unroll
        for (int j = 0; j < 8; ++j) { const int key = 16 * (kc >> 1) + 8 * (j >> 2) + 4 * (kc & 1) + (j & 3); e[j] = VS[((slot0 + h) * 64 + key) * 72 + d]; }
        u32x4 o; o.x = e[0] | ((unsigned)e[1] << 16); o.y = e[2] | ((unsigned)e[3] << 16); o.z = e[4] | ((unsigned)e[5] << 16); o.w = e[6] | ((unsigned)e[7] << 16);
        *(u32x4*)(Vbase + ((size_t)(kvh0 + h) * NTILE + tt) * 4096 + (kc * 64 + d) * 8) = o;
    }
}
template <int LG>
__device__ __forceinline__ void norm8(const u32x4 raw, const float* g, float inv_n, float post, float* o) {
    float v[8]; unpack8(raw, v); float s = 0.f;
#pragma unroll
    for (int j = 0; j < 8; ++j) s += v[j] * v[j];
#pragma unroll
    for (int k = 0; k < LG; ++k) s += __shfl_xor(s, 1 << k);
    const float rs = (1.0f / sqrtf(s * inv_n + EPS)) * post;
#pragma unroll
    for (int j = 0; j < 8; ++j) o[j] = v[j] * rs * g[j];
}
__device__ __forceinline__ void prep_unit(const Ctx& c, int l, int T) {
    InPtr in = c.kp->in;
    const int tid = c.tid, tok = tid >> 3, sub = tid & 7, b = T >> 7, tt = T & 127, t = tt * 64 + tok;
    const bf16_t* prow = c.wsb(WS_R) + (size_t)(T * 64 + tok) * NIN;
    LAS bf16_t* VS = (LAS bf16_t*)(c.lds + PL_VS);
    LAS bf16_t* CQ = (LAS bf16_t*)(c.lds + PL_CQ);
    LAS bf16_t* CKV = (LAS bf16_t*)(c.lds + PL_CKV);
    LAS float* KR = (LAS float*)(c.lds + PL_KR);
    LAS float* RSQ = (LAS float*)(c.lds + PL_RSQ);
    LAS float* RSKV = (LAS float*)(c.lds + PL_RSKV);
    const float2* tab = (const float2*)(c.kp->ws + WS_TAB);
    u32x4 ra[12], rc[12], rd[8], rq[4], rkv[2], rkr = (u32x4){0u, 0u, 0u, 0u};
#pragma unroll
    for (int i = 0; i < 12; ++i) ra[i] = *(const u32x4*)(prow + i * 64 + sub * 8);
#pragma unroll
    for (int i = 0; i < 4; ++i) rq[i] = *(const u32x4*)(prow + 768 + 64 * i + 8 * sub);
#pragma unroll
    for (int i = 0; i < 2; ++i) rkv[i] = *(const u32x4*)(prow + 1024 + 64 * i + 8 * sub);
    if (sub < 4) rkr = *(const u32x4*)(prow + 1152 + 8 * sub);
    {
        float ssq = 0.f;
#pragma unroll
        for (int i = 0; i < 4; ++i) { float v[8]; unpack8(rq[i], v);
#pragma unroll
            for (int j = 0; j < 8; ++j) ssq += v[j] * v[j];
            *(LAS u32x4*)(CQ + tok * 264 + 64 * i + 8 * sub) = rq[i]; }
        ssq += __shfl_xor(ssq, 1); ssq += __shfl_xor(ssq, 2); ssq += __shfl_xor(ssq, 4);
        if (sub == 0) RSQ[tok] = 1.0f / sqrtf(ssq * (1.0f / 256.0f) + EPS);
        float ssk = 0.f;
#pragma unroll
        for (int i = 0; i < 2; ++i) { float v[8]; unpack8(rkv[i], v);
#pragma unroll
            for (int j = 0; j < 8; ++j) ssk += v[j] * v[j];
            *(LAS u32x4*)(CKV + tok * 136 + 64 * i + 8 * sub) = rkv[i]; }
        ssk += __shfl_xor(ssk, 1); ssk += __shfl_xor(ssk, 2); ssk += __shfl_xor(ssk, 4);
        if (sub == 0) RSKV[tok] = 1.0f / sqrtf(ssk * (1.0f / 128.0f) + EPS);
        if (sub < 4) { float v[8]; unpack8(rkr, v);
#pragma unroll
            for (int j = 0; j < 8; ++j) KR[tok * 32 + 8 * sub + j] = v[j]; }
    }
#pragma unroll
    for (int i = 0; i < 8; ++i) rd[i] = *(const u32x4*)(prow + 2048 + i * 64 + sub * 8);
    {
        const float* qg = in[I_NAQN] + l * 64 + sub * 8; const float* kg = in[I_NAKN] + l * 64 + sub * 8;
        bf16_t* QA = c.wsb(WS_QA); bf16_t* KA = c.wsb(WS_KA);
#pragma unroll
        for (int h = 0; h < 4; ++h) {
            float o[8];
            norm8<3>(ra[h], qg, 1.0f / 64.0f, 0.125f * LOG2E, o);
            *(u32x4*)(QA + ((size_t)(b * 4 + h) * SEQ + t) * 64 + sub * 8) = pack8(o);
            norm8<3>(ra[4 + h], kg, 1.0f / 64.0f, 1.0f, o);
            *(u32x4*)(KA + ((size_t)(b * 4 + h) * NTILE + tt) * 4096 + (sub * 64 + tok) * 8) = pack8(o);
            *(LAS u32x4*)(VS + (h * 64 + tok) * 72 + sub * 8) = ra[8 + h];
        }
    }
    {
        const float* qg = in[I_GQN] + l * 64 + sub * 8; const float* kg = in[I_GKN] + l * 64 + sub * 8;
        bf16_t* QD = c.wsb(WS_QD); bf16_t* KD = c.wsb(WS_KD);
        const int pos = (sub < 4) ? (t >> 6) : (t & 63); const bool first = (sub & 2) == 0;
        float cs_c[8], cs_s[8];
#pragma unroll
        for (int j = 0; j < 8; ++j) { const float2 cs = tab[pos * 16 + 8 * (sub & 1) + j]; cs_c[j] = cs.x; cs_s[j] = cs.y; }
#pragma unroll
        for (int h = 0; h < 6; ++h) {
            const bool isq = h < 4;
            float v[8], o[8];
            norm8<3>(rd[h], isq ? qg : kg, 1.0f / 64.0f, 1.0f, v);
            const float sc = isq ? 0.125f * LOG2E : 1.0f;
#pragma unroll
            for (int j = 0; j < 8; ++j) { const float pv = __shfl_xor(v[j], 2); o[j] = (first ? (v[j] * cs_c[j] - pv * cs_s[j]) : (pv * cs_s[j] + v[j] * cs_c[j])) * sc; }
            if (isq) *(u32x4*)(QD + ((size_t)(b * 4 + h) * SEQ + t) * 64 + sub * 8) = pack8(o);
            else *(u32x4*)(KD + ((size_t)(b * 2 + (h - 4)) * NTILE + tt) * 4096 + (sub * 64 + tok) * 8) = pack8(o);
        }
#pragma unroll
        for (int h = 0; h < 2; ++h) *(LAS u32x4*)(VS + ((4 + h) * 64 + tok) * 72 + sub * 8) = rd[6 + h];
    }
#pragma unroll
    for (int i = 0; i < 12; ++i) rc[i] = *(const u32x4*)(prow + 1280 + i * 64 + sub * 8);
    __syncthreads();
    vt_write(c, 0, 4, c.wsb(WS_VA), b * 4, tt);
    vt_write(c, 4, 2, c.wsb(WS_VD), b * 2, tt);
    __syncthreads();
    {
        const float* qg = in[I_DQN] + l * 32 + (sub & 3) * 8; const float* kg = in[I_DKN] + l * 32 + (sub & 3) * 8;
        bf16_t* QC = c.wsb(WS_QC); bf16_t* KC = c.wsb(WS_KC);
#pragma unroll
        for (int h = 0; h < 4; ++h) {
            float o[8];
            norm8<2>(rc[h], qg, 1.0f / 32.0f, 0.17677669529663687f * LOG2E, o);
            *(u32x4*)(QC + ((size_t)(b * 4 + h) * SEQ + t) * 64 + sub * 8) = pack8(o);
            norm8<2>(rc[4 + h], kg, 1.0f / 32.0f, 1.0f, o);
            *(u32x4*)(KC + ((size_t)(b * 4 + h) * NTILE + tt) * 4096 + (sub * 64 + tok) * 8) = pack8(o);
            *(LAS u32x4*)(VS + (h * 64 + tok) * 72 + sub * 8) = rc[8 + h];
        }
    }
    asm volatile("" ::: "memory"); __builtin_amdgcn_sched_barrier(0);
    {
        const int lane = c.lane, l15 = lane & 15, fq = lane >> 4;
        if (c.wave < 4) {
            const int h = c.wave, bh = b * 4 + h; const bf16_t* Wuq = c.wsb(WS_WUQ) + (size_t)(h * 96 + l15) * 256 + 8 * fq;
            f32x4 acc[4][6];
#pragma unroll
            for (int mt = 0; mt < 4; ++mt)
#pragma unroll
                for (int nt = 0; nt < 6; ++nt) acc[mt][nt] = (f32x4){0.f, 0.f, 0.f, 0.f};
#pragma unroll 2
            for (int ks = 0; ks < 8; ++ks) {
                bf16x8 af[6], bfr[4];
#pragma unroll
                for (int nt = 0; nt < 6; ++nt) af[nt] = *(const bf16x8*)(Wuq + (size_t)(16 * nt) * 256 + 32 * ks);
#pragma unroll
                for (int mt = 0; mt < 4; ++mt) bfr[mt] = *(const LAS bf16x8*)(CQ + (16 * mt + l15) * 264 + 32 * ks + 8 * fq);
#pragma unroll
                for (int mt = 0; mt < 4; ++mt)
#pragma unroll
                    for (int nt = 0; nt < 6; ++nt) acc[mt][nt] = __builtin_amdgcn_mfma_f32_16x16x32_bf16(af[nt], bfr[mt], acc[mt][nt], 0, 0, 0);
            }
            asm volatile("" ::: "memory"); __builtin_amdgcn_sched_barrier(0);
            const float* gq = in[I_MLAQN] + l * 96 + 4 * fq; const float sc = 0.10206207261596577f * LOG2E;
#pragma unroll
            for (int mt = 0; mt < 4; ++mt) {
                const int tokl = 16 * mt + l15, tq = tt * 64 + tokl;
                const float rsq = RSQ[tokl]; float s = 0.f;
#pragma unroll
                for (int nt = 0; nt < 6; ++nt) { acc[mt][nt] = acc[mt][nt] * rsq; s += (acc[mt][nt][0] * acc[mt][nt][0] + acc[mt][nt][1] * acc[mt][nt][1]) + (acc[mt][nt][2] * acc[mt][nt][2] + acc[mt][nt][3] * acc[mt][nt][3]); }
                s += __shfl_xor(s, 16); s += __shfl_xor(s, 32);
                const float rh = 1.0f / sqrtf(s * (1.0f / 96.0f) + EPS);
#pragma unroll
                for (int nt = 0; nt < 6; ++nt) { const f32x4 g = *(const f32x4*)(gq + 16 * nt); acc[mt][nt] = acc[mt][nt] * g * rh; }
#pragma unroll
                for (int r = 0; r < 4; ++r) { const float2 cs = tab[tq * 16 + 4 * fq + r]; const float x1 = acc[mt][4][r], x2 = acc[mt][5][r]; acc[mt][4][r] = x1 * cs.x - x2 * cs.y; acc[mt][5][r] = x1 * cs.y + x2 * cs.x; }
                bf16_t* qo = c.wsb(WS_QB) + ((size_t)bh * SEQ + tq) * 96 + 4 * fq;
#pragma unroll
                for (int nt = 0; nt < 6; ++nt) { u32x2 w; w.x = pk2(acc[mt][nt][0] * sc, acc[mt][nt][1] * sc); w.y = pk2(acc[mt][nt][2] * sc, acc[mt][nt][3] * sc); *(u32x2*)(qo + 16 * nt) = w; }
                asm volatile("" ::: "memory"); __builtin_amdgcn_sched_barrier(0);
            }
        } else {
            const int h = c.wave - 4, bh = b * 4 + h; const bf16_t* Wukv = c.wsb(WS_WUKV) + (size_t)(h * 128 + l15) * 128 + 8 * fq;
            const float* gk = in[I_MLAKN] + l * 96 + 4 * fq;
#pragma unroll
            for (int half = 0; half < 2; ++half) {
                f32x4 acc[4][4];
#pragma unroll
                for (int mt = 0; mt < 4; ++mt)
#pragma unroll
                    for (int nt = 0; nt < 4; ++nt) acc[mt][nt] = (f32x4){0.f, 0.f, 0.f, 0.f};
#pragma unroll 2
                for (int ks = 0; ks < 4; ++ks) {
                    bf16x8 af[4], bfr[4];
#pragma unroll
                    for (int nt = 0; nt < 4; ++nt) af[nt] = *(const bf16x8*)(Wukv + (size_t)(64 * half + 16 * nt) * 128 + 32 * ks);
#pragma unroll
                    for (int mt = 0; mt < 4; ++mt) bfr[mt] = *(const LAS bf16x8*)(CKV + (16 * mt + l15) * 136 + 32 * ks + 8 * fq);
#pragma unroll
                    for (int mt = 0; mt < 4; ++mt)
#pragma unroll
                        for (int nt = 0; nt < 4; ++nt) acc[mt][nt] = __builtin_amdgcn_mfma_f32_16x16x32_bf16(af[nt], bfr[mt], acc[mt][nt], 0, 0, 0);
                }
                asm volatile("" ::: "memory"); __builtin_amdgcn_sched_barrier(0);
#pragma unroll
                for (int mt = 0; mt < 4; ++mt) {
                    const int tokl = 16 * mt + l15, tq = tt * 64 + tokl;
                    const float rskv = RSKV[tokl];
#pragma unroll
                    for (int nt = 0; nt < 4; ++nt) acc[mt][nt] = acc[mt][nt] * rskv;
                    if (half == 0) {
                        f32x4 kr1 = *(const LAS f32x4*)(KR + tokl * 32 + 4 * fq), kr2 = *(const LAS f32x4*)(KR + tokl * 32 + 16 + 4 * fq);
                        float s = (kr1[0] * kr1[0] + kr1[1] * kr1[1]) + (kr1[2] * kr1[2] + kr1[3] * kr1[3]) + (kr2[0] * kr2[0] + kr2[1] * kr2[1]) + (kr2[2] * kr2[2] + kr2[3] * kr2[3]);
#pragma unroll
                        for (int nt = 0; nt < 4; ++nt) s += (acc[mt][nt][0] * acc[mt][nt][0] + acc[mt][nt][1] * acc[mt][nt][1]) + (acc[mt][nt][2] * acc[mt][nt][2] + acc[mt][nt][3] * acc[mt][nt][3]);
                        s += __shfl_xor(s, 16); s += __shfl_xor(s, 32);
                        const float rh = 1.0f / sqrtf(s * (1.0f / 96.0f) + EPS);
#pragma unroll
                        for (int nt = 0; nt < 4; ++nt) { const f32x4 g = *(const f32x4*)(gk + 16 * nt); acc[mt][nt] = acc[mt][nt] * g * rh; }
                        kr1 = kr1 * *(const f32x4*)(gk + 64) * rh; kr2 = kr2 * *(const f32x4*)(gk + 80) * rh;
#pragma unroll
                        for (int r = 0; r < 4; ++r) { const float2 cs = tab[tq * 16 + 4 * fq + r]; const float x1 = kr1[r], x2 = kr2[r]; kr1[r] = x1 * cs.x - x2 * cs.y; kr2[r] = x1 * cs.y + x2 * cs.x; }
                        bf16_t* kt = c.wsb(WS_KB) + ((size_t)bh * NTILE + tt) * 6144 + tokl * 8 + (fq & 1) * 4;
#pragma unroll
                        for (int nt = 0; nt < 4; ++nt) { u32x2 w; w.x = pk2(acc[mt][nt][0], acc[mt][nt][1]); w.y = pk2(acc[mt][nt][2], acc[mt][nt][3]); *(u32x2*)(kt + (2 * nt + (fq >> 1)) * 512) = w; }
                        { u32x2 w; w.x = pk2(kr1[0], kr1[1]); w.y = pk2(kr1[2], kr1[3]); *(u32x2*)(kt + (8 + (fq >> 1)) * 512) = w;
                          w.x = pk2(kr2[0], kr2[1]); w.y = pk2(kr2[2], kr2[3]); *(u32x2*)(kt + (10 + (fq >> 1)) * 512) = w; }
                    } else {
#pragma unroll
                        for (int nt = 0; nt < 4; ++nt) { u32x2 w; w.x = pk2(acc[mt][nt][0], acc[mt][nt][1]); w.y = pk2(acc[mt][nt][2], acc[mt][nt][3]); *(LAS u32x2*)(VS + ((4 + h) * 64 + tokl) * 72 + 16 * nt + 4 * fq) = w; }
                    }
                    asm volatile("" ::: "memory"); __builtin_amdgcn_sched_barrier(0);
                }
            }
        }
    }
    __syncthreads();
    vt_write(c, 0, 4, c.wsb(WS_VC), b * 4, tt);
    vt_write(c, 4, 4, c.wsb(WS_VB), b * 4, tt);
    __syncthreads();
}

namespace att {
constexpr int SLOT_K = 12288, SLOT = 20480, LUT_OFF = 69632, PARK_OFF = 73728;
struct Args { const bf16_t* Q; const bf16_t* K; const bf16_t* V; bf16_t* Y; int ycol, kv_shift, nkvh; const float* lut_src; const float* lam_src; float lam_init; const float* gq; const float* gk; int ng; float sqrtd; };
__device__ __forceinline__ int crow(int r, int hi) { return (r & 3) + 8 * (r >> 2) + 4 * hi; }
__device__ __forceinline__ int iclamp(int v, int lo, int hi) { return v < lo ? lo : (v > hi ? hi : v); }
__device__ __forceinline__ void glds16(const bf16_t* src, LAS unsigned char* dst) { __builtin_amdgcn_global_load_lds((const unsigned*)src, (LAS unsigned*)dst, 16, 0, 0); }

__device__ __forceinline__ float max2f(float a, float b) { return __builtin_amdgcn_fmed3f(a, b, __builtin_inff()); }
template <int MODE, int DQK>
__device__ __forceinline__ void unit(const Args& a, int bh, int qb, LAS unsigned char* lds, const int tid) {
    constexpr int NQF = DQK / 16, NMAP = (MODE == 1) ? 2 : 1, FPM = NQF / NMAP, NKP = DQK / 8, NP = NKP + 8, NPW = (NP + 7) / 8, KT_ELEMS = DQK * 64;
    constexpr float THR = 5.0f;
    const int lane = tid & 63, r32 = lane & 31, hi = lane >> 5, w = __builtin_amdgcn_readfirstlane(tid >> 6);
    const int b = bh >> 2, h = bh & 3, kvh = b * a.nkvh + (h >> a.kv_shift);
    const int qrow = qb * 256 + 32 * w + r32;
    int t_lo = 0, t_hi = NTILE, my_lo = 0, my_hi = NTILE, myr = 0;
    if (MODE == 2) { const int r0 = qb * 4; t_lo = iclamp(r0 - 4, 0, 120); t_hi = iclamp(r0 + 3 - 4, 0, 120) + 8; myr = r0 + (w >> 1); my_lo = iclamp(myr - 4, 0, 120); my_hi = my_lo + 8; }
    const int NT = t_hi - t_lo;
    LAS float* lut = (LAS float*)(lds + LUT_OFF);
    if (MODE == 1) {
        for (int i = tid; i < 257; i += NTHREADS) { const int rel = i - 128, n = rel < 0 ? -rel : rel;
            int large = 8 + (int)(logf((float)(n < 1 ? 1 : n) / 8.0f) / 2.772588722239781f * 8.0f); large = large > 15 ? 15 : large;
            const int bucket = (rel > 0 ? 16 : 0) + (n < 8 ? n : large);
            lut[i] = a.lut_src[bucket * 4 + h] * LOG2E; }
    }
    if (MODE == 2) { for (int i = tid; i < 465; i += NTHREADS) lut[i] = a.lut_src[h * 465 + i] * LOG2E; }
    bf16x8 qf[NQF];
    { const bf16_t* qp = a.Q + ((size_t)bh * SEQ + qrow) * DQK + 8 * hi;
#pragma unroll
      for (int d0 = 0; d0 < NQF; ++d0) qf[d0] = *(const bf16x8*)(qp + 16 * d0); }
    float mrun[NMAP], lrun[NMAP]; f32x16 o[NMAP][2]; f32x16 negm = f32x16{};
#pragma unroll
    for (int mp = 0; mp < NMAP; ++mp) { mrun[mp] = 0.f; lrun[mp] = 0.f; o[mp][0] = f32x16{}; o[mp][1] = f32x16{}; }
    bool started = false;
    const bf16_t* Kt = a.K + (size_t)kvh * NTILE * KT_ELEMS; const bf16_t* Vt = a.V + (size_t)kvh * NTILE * 4096;
#define ATT_ISSUE(t, slot) do { _Pragma("unroll") for (int j_ = 0; j_ < NPW; ++j_) { int p_ = w + 8 * j_; if (p_ >= NP) p_ -= 8; \
        if (p_ < NKP) glds16(Kt + (size_t)(t) * KT_ELEMS + p_ * 512 + lane * 8, lds + (slot) * SLOT + p_ * 1024); \
        else glds16(Vt + (size_t)(t) * 4096 + (p_ - NKP) * 512 + lane * 8, lds + (slot) * SLOT + SLOT_K + (p_ - NKP) * 1024); } } while (0)
    ATT_ISSUE(t_lo, 0);
    if (NT > 1) ATT_ISSUE(t_lo + 1, 1);
    int slot = 0;
    for (int i = 0; i < NT; ++i) {
        if (i + 1 < NT) { if constexpr (NPW == 2) asm volatile("s_waitcnt vmcnt(2)" ::: "memory"); else asm volatile("s_waitcnt vmcnt(3)" ::: "memory"); }
        else asm volatile("s_waitcnt vmcnt(0)" ::: "memory");
        asm volatile("s_waitcnt lgkmcnt(0)" ::: "memory"); __builtin_amdgcn_s_barrier(); asm volatile("" ::: "memory");
        if (i + 2 < NT) { const int s2 = slot >= 1 ? slot - 1 : 2; ATT_ISSUE(t_lo + i + 2, s2); }
        const int t = t_lo + i;
        if (MODE != 2 || (t >= my_lo && t < my_hi)) {
            const LAS unsigned char* ks = lds + slot * SLOT + hi * 1024 + r32 * 16;
            const LAS unsigned char* vs = lds + slot * SLOT + SLOT_K + hi * 1024 + r32 * 16;
#pragma unroll
            for (int mp = 0; mp < NMAP; ++mp) {
                bf16x8 kf[2 * FPM];
#pragma unroll
                for (int d = 0; d < FPM; ++d) { const int d0 = mp * FPM + d; kf[2 * d] = *(const LAS bf16x8*)(ks + d0 * 2048); kf[2 * d + 1] = *(const LAS bf16x8*)(ks + d0 * 2048 + 512); }
                f32x16 c0, c1; const float mneg = -mrun[mp];
                if (MODE == 0) { c0 = negm; c1 = negm; }
                if (MODE == 1) {
                    const int qw0 = qb * 256 + 32 * w, d_lo = 64 * t - (qw0 + 31), d_hi = 64 * t + 63 - qw0;
                    if (d_hi <= -128 || d_lo >= 128) { const float v = lut[d_lo >= 128 ? 256 : 0] + mneg;
#pragma unroll
                        for (int r = 0; r < 16; ++r) c0[r] = v;
                        c1 = c0; }
                    else {
#pragma unroll
                        for (int r = 0; r < 16; ++r) { const int rel = 64 * t + crow(r, hi) - qrow; c0[r] = lut[iclamp(rel, -128, 128) + 128] + mneg; c1[r] = lut[iclamp(rel + 32, -128, 128) + 128] + mneg; } }
                }
                if (MODE == 2) {
                    const int qc = 32 * (w & 1) + r32, qs = iclamp(qc - 8, 0, 48), dr = t - myr + 7;
#pragma unroll
                    for (int r = 0; r < 16; ++r) { const int kc = crow(r, hi), kc2 = kc + 32;
                        const bool v1 = (kc >= qs) && (kc < qs + 16), v2 = (kc2 >= qs) && (kc2 < qs + 16);
                        c0[r] = v1 ? lut[dr * 31 + (kc - qc + 15)] + mneg : -1e30f; c1[r] = v2 ? lut[dr * 31 + (kc2 - qc + 15)] + mneg : -1e30f; }
                }
                __builtin_amdgcn_sched_barrier(0);
                f32x16 p0 = __builtin_amdgcn_mfma_f32_32x32x16_bf16(kf[0], qf[mp * FPM], c0, 0, 0, 0);
                f32x16 p1 = __builtin_amdgcn_mfma_f32_32x32x16_bf16(kf[1], qf[mp * FPM], c1, 0, 0, 0);
#pragma unroll
                for (int d = 1; d < FPM; ++d) { p0 = __builtin_amdgcn_mfma_f32_32x32x16_bf16(kf[2 * d], qf[mp * FPM + d], p0, 0, 0, 0); p1 = __builtin_amdgcn_mfma_f32_32x32x16_bf16(kf[2 * d + 1], qf[mp * FPM + d], p1, 0, 0, 0); }
                bf16x8 vf[8];
#pragma unroll
                for (int q8 = 0; q8 < 8; ++q8) vf[q8] = *(const LAS bf16x8*)(vs + (q8 & 3) * 2048 + (q8 >> 2) * 512);
                __builtin_amdgcn_sched_barrier(0);
                float ma = max2f(p0[0], p1[0]), mb = max2f(p0[1], p1[1]);
#pragma unroll
                for (int r = 2; r < 16; r += 2) { ma = max2f(ma, max2f(p0[r], p1[r])); mb = max2f(mb, max2f(p0[r + 1], p1[r + 1])); }
                float rm = max2f(ma, mb);
                { auto rr = __builtin_amdgcn_permlane32_swap(__float_as_uint(rm), __float_as_uint(rm), false, false); rm = max2f(__uint_as_float(rr[0]), __uint_as_float(rr[1])); }
                if (!started || __any(rm > THR)) {
                    const float dl = started ? fmaxf(rm, 0.f) : rm;
                    mrun[mp] += dl;
#pragma unroll
                    for (int r = 0; r < 16; ++r) { p0[r] -= dl; p1[r] -= dl; }
                    const float alpha = __builtin_amdgcn_exp2f(-dl);
                    lrun[mp] *= alpha; o[mp][0] = o[mp][0] * alpha; o[mp][1] = o[mp][1] * alpha;
                    if (MODE == 0) {
#pragma unroll
                        for (int r = 0; r < 16; ++r) negm[r] = -mrun[mp];
                    }
                }
                float rs0 = 0.f, rs1 = 0.f;
#pragma unroll
                for (int r = 0; r < 16; ++r) { p0[r] = __builtin_amdgcn_exp2f(p0[r]); p1[r] = __builtin_amdgcn_exp2f(p1[r]); rs0 += p0[r]; rs1 += p1[r]; }
                lrun[mp] += rs0 + rs1;
                u32x4 pw[4];
#pragma unroll
                for (int j = 0; j < 4; ++j) { pw[0][j] = pk2(p0[2 * j], p0[2 * j + 1]); pw[1][j] = pk2(p0[8 + 2 * j], p0[9 + 2 * j]); pw[2][j] = pk2(p1[2 * j], p1[2 * j + 1]); pw[3][j] = pk2(p1[8 + 2 * j], p1[9 + 2 * j]); }
#pragma unroll
                for (int k4 = 0; k4 < 4; ++k4) {
                    o[mp][0] = __builtin_amdgcn_mfma_f32_32x32x16_bf16(vf[k4], __builtin_bit_cast(bf16x8, pw[k4]), o[mp][0], 0, 0, 0);
                    o[mp][1] = __builtin_amdgcn_mfma_f32_32x32x16_bf16(vf[4 + k4], __builtin_bit_cast(bf16x8, pw[k4]), o[mp][1], 0, 0, 0); }
            }
            started = true;
        }
        slot = slot == 2 ? 0 : slot + 1;
    }
#undef ATT_ISSUE
#pragma unroll
    for (int mp = 0; mp < NMAP; ++mp) lrun[mp] += __shfl_xor(lrun[mp], 32);
    f32x16 val[2];
    if (MODE == 1) {
        float s1 = 0.f, s2 = 0.f;
        for (int i = 0; i < 32; ++i) { s1 += a.lam_src[i] * a.lam_src[32 + i]; s2 += a.lam_src[64 + i] * a.lam_src[96 + i]; }
        const float lam = expf(s1) - expf(s2) + a.lam_init;
        const float i0 = 1.0f / lrun[0], i1 = lam / lrun[NMAP - 1];
        val[0] = o[0][0] * i0 - o[NMAP - 1][0] * i1; val[1] = o[0][1] * i0 - o[NMAP - 1][1] * i1;
        float s = 0.f;
#pragma unroll
        for (int r = 0; r < 16; ++r) s += val[0][r] * val[0][r] + val[1][r] * val[1][r];
        s += __shfl_xor(s, 32);
        const float rn = 1.0f / sqrtf(s * (1.0f / 64.0f) + EPS);
        val[0] = val[0] * rn; val[1] = val[1] * rn;
    } else { const float i0 = 1.0f / lrun[0]; val[0] = o[0][0] * i0; val[1] = o[0][1] * i0; }
    bf16_t* yp = a.Y + ((size_t)(b * SEQ + qrow)) * DM + a.ycol + h * 64 + 4 * hi;
#pragma unroll
    for (int db = 0; db < 2; ++db)
#pragma unroll
        for (int g = 0; g < 4; ++g) { u32x2 wv; wv.x = pk2(val[db][4 * g], val[db][4 * g + 1]); wv.y = pk2(val[db][4 * g + 2], val[db][4 * g + 3]); *(u32x2*)(yp + 32 * db + 8 * g) = wv; }
    asm volatile("s_waitcnt lgkmcnt(0)" ::: "memory"); __builtin_amdgcn_s_barrier(); asm volatile("" ::: "memory");
}

#define ATT_WAITV(n) asm volatile("s_waitcnt vmcnt(" #n ") lgkmcnt(0)\n\ts_barrier" ::: "memory")
__device__ __forceinline__ void wait_bar_n(int n) {
    if (n == 0) ATT_WAITV(0); else if (n == 1) ATT_WAITV(1); else if (n == 2) ATT_WAITV(2); else if (n == 3) ATT_WAITV(3); else ATT_WAITV(4);
}
template <int DQK> struct PipeCfg {
    static constexpr int KSLOT = DQK * 128, VSLOT = 8192, KRING = 0, VRING = 3 * KSLOT, NKP = DQK / 8, NKW = (NKP + 7) / 8, KT_ELEMS = DQK * 64;
};
struct PipeState { float mrun, lrun, cb; f32x16 negm; };
__device__ __forceinline__ void bias_tile(f32x16& C0, f32x16& C1, const LAS float* lut, int t, int qrow, int hi, float mrun) {
#pragma unroll
    for (int r = 0; r < 16; ++r) { const int rel = 64 * t + crow(r, hi) - qrow; C0[r] = lut[iclamp(rel, -128, 128) + 128] - mrun; C1[r] = lut[iclamp(rel + 32, -128, 128) + 128] - mrun; }
}
template <int DQK, int F0, int NF, bool BIAS, bool NOMAX>
__device__ __forceinline__ void pipe_step(int t, f32x16& C0, f32x16& C1, f32x16& P0, f32x16& P1, f32x16 (&o)[2], bf16x8 (&kf)[2 * NF], const bf16x8 (&qf)[NF],
                                          PipeState& st, LAS unsigned char* lds, const bf16_t* Kt, const bf16_t* Vt, int lane, int w, int frag_off,
                                          const LAS float* lut, int qw0, int qrow, int hi, float cL, float cR) {
    typedef PipeCfg<DQK> Cf;
    constexpr int NKF = 2 * NF, NT = NTILE, GPG = (8 + NKF - 1) / NKF;
    constexpr float THR = 5.0f;
    const int sv_prev = (t - 1) & 3, sk_next = (t + 1) % 3;
    const LAS unsigned char* vs = lds + Cf::VRING + sv_prev * Cf::VSLOT + frag_off;
    const LAS unsigned char* kn = lds + Cf::KRING + sk_next * Cf::KSLOT + frag_off + F0 * 2048;
    bf16x8 vf[8]; u32x4 pw[4]; float sacc = 0.f;
    bool near = false;
    if (BIAS) {
        const int d_lo = 64 * t - (qw0 + 31), d_hi = 64 * t + 63 - qw0;
        near = !(d_hi <= -128 || d_lo >= 128);
        if (!near) { const float ct = d_lo >= 128 ? cR : cL;
            if (ct != st.cb) { st.cb = ct;
#pragma unroll
                for (int r = 0; r < 16; ++r) st.negm[r] = ct - st.mrun; } }
    }
    __builtin_amdgcn_sched_barrier(0);
#pragma unroll
    for (int g = 0; g < NKF; ++g) {
        if (g >= NKF - 4) { const int q8 = g - (NKF - 4); vf[q8] = *(const LAS bf16x8*)(vs + q8 * 2048); }
        __builtin_amdgcn_sched_barrier(0);
        const int d = g >> 1;
        if (d == 0) {
            if ((g & 1) == 0) C0 = __builtin_amdgcn_mfma_f32_32x32x16_bf16(kf[g], qf[d], st.negm, 0, 0, 0); else C1 = __builtin_amdgcn_mfma_f32_32x32x16_bf16(kf[g], qf[d], st.negm, 0, 0, 0);
        } else { if ((g & 1) == 0) C0 = __builtin_amdgcn_mfma_f32_32x32x16_bf16(kf[g], qf[d], C0, 0, 0, 0); else C1 = __builtin_amdgcn_mfma_f32_32x32x16_bf16(kf[g], qf[d], C1, 0, 0, 0); }
#pragma unroll
        for (int gg = 0; gg < GPG; ++gg) { const int grp = g * GPG + gg;
            if (grp < 8) {
                if (grp < 4) { sacc += (P0[4 * grp] + P0[4 * grp + 1]) + (P0[4 * grp + 2] + P0[4 * grp + 3]); pw[grp >> 1][2 * (grp & 1)] = pk2(P0[4 * grp], P0[4 * grp + 1]); pw[grp >> 1][2 * (grp & 1) + 1] = pk2(P0[4 * grp + 2], P0[4 * grp + 3]); }
                else { const int e = 4 * (grp - 4); sacc += (P1[e] + P1[e + 1]) + (P1[e + 2] + P1[e + 3]); pw[grp >> 1][2 * (grp & 1)] = pk2(P1[e], P1[e + 1]); pw[grp >> 1][2 * (grp & 1) + 1] = pk2(P1[e + 2], P1[e + 3]); }
                asm volatile("" : "+v"(sacc)); asm volatile("" : "+v"(pw[grp >> 1]));
            } }
        __builtin_amdgcn_sched_barrier(0);
    }
    st.lrun += sacc;
    if (BIAS && near) {
#pragma unroll
        for (int r = 0; r < 16; ++r) { const int rel = 64 * t + crow(r, hi) - qrow; C0[r] += lut[iclamp(rel, -128, 128) + 128] - st.cb; C1[r] += lut[iclamp(rel + 32, -128, 128) + 128] - st.cb; }
    }
    if (t + 3 < NT) {
#pragma unroll
        for (int j = 0; j < Cf::NKW; ++j) { int p = w + 8 * j; if (p >= Cf::NKP) p -= 8;
            glds16(Kt + (size_t)(t + 3) * Cf::KT_ELEMS + p * 512 + lane * 8, lds + Cf::KRING + (t % 3) * Cf::KSLOT + p * 1024); }
    }
    if (t + 2 < NT) glds16(Vt + (size_t)(t + 2) * 4096 + w * 512 + lane * 8, lds + Cf::VRING + ((t + 2) & 3) * Cf::VSLOT + w * 1024);
    float alpha = 1.0f; bool resc = false;
    if (!NOMAX) {
        int ia = max(max(__float_as_int(C0[0]), __float_as_int(C0[1])), __float_as_int(C1[0])), ib = max(max(__float_as_int(C0[2]), __float_as_int(C0[3])), __float_as_int(C1[1]));
        ia = max(max(ia, __float_as_int(C1[2])), __float_as_int(C1[3]));
#pragma unroll
        for (int r = 4; r < 16; r += 4) { ia = max(max(ia, __float_as_int(C0[r])), __float_as_int(C0[r + 1])); ib = max(max(ib, __float_as_int(C0[r + 2])), __float_as_int(C0[r + 3]));
            ia = max(max(ia, __float_as_int(C1[r])), __float_as_int(C1[r + 1])); ib = max(max(ib, __float_as_int(C1[r + 2])), __float_as_int(C1[r + 3])); }
        int im = max(ia, ib);
        { auto rr = __builtin_amdgcn_permlane32_swap((unsigned)im, (unsigned)im, false, false); im = max((int)rr[0], (int)rr[1]); }
        if (__builtin_expect(__any(im > __float_as_int(THR)), 0)) {
            const float rm = __int_as_float(im), dl = rm > 0.f ? rm : 0.f;
            st.mrun += dl;
#pragma unroll
            for (int r = 0; r < 16; ++r) { C0[r] -= dl; C1[r] -= dl; }
#pragma unroll
            for (int r = 0; r < 16; ++r) st.negm[r] = st.cb - st.mrun;
            alpha = __builtin_amdgcn_exp2f(-dl); st.lrun *= alpha; resc = true;
        }
    }
    __builtin_amdgcn_sched_barrier(0);
#pragma unroll
    for (int g = 0; g < 8; ++g) {
        if (t + 1 < NT) {
            constexpr int G0 = (NKF >= 12) ? 1 : 2;
            if (g >= G0 && 2 * (g - G0) < NKF) { const int f = g - G0; kf[2 * f] = *(const LAS bf16x8*)(kn + f * 2048); kf[2 * f + 1] = *(const LAS bf16x8*)(kn + f * 2048 + 512); }
        }
        if (g < 2) { vf[4 + 2 * g] = *(const LAS bf16x8*)(vs + (2 * g) * 2048 + 512); vf[5 + 2 * g] = *(const LAS bf16x8*)(vs + (2 * g + 1) * 2048 + 512); }
        __builtin_amdgcn_sched_barrier(0);
        const int k4 = g & 3, db = g >> 2;
        o[db] = __builtin_amdgcn_mfma_f32_32x32x16_bf16(vf[g], __builtin_bit_cast(bf16x8, pw[k4]), o[db], 0, 0, 0);
        if (g < 4) {
#pragma unroll
            for (int e = 0; e < 4; ++e) C0[4 * g + e] = __builtin_amdgcn_exp2f(C0[4 * g + e]);
        } else {
#pragma unroll
            for (int e = 0; e < 4; ++e) C1[4 * (g - 4) + e] = __builtin_amdgcn_exp2f(C1[4 * (g - 4) + e]);
        }
        if (g < 4) asm volatile("" : "+v"(C0)); else asm volatile("" : "+v"(C1));
        __builtin_amdgcn_sched_barrier(0);
    }
    wait_bar_n((t + 1 < NT ? 1 : 0) + (t + 3 < NT ? Cf::NKW : 0) + (t + 2 < NT ? 1 : 0));
    if (resc) { o[0] = o[0] * alpha; o[1] = o[1] * alpha; }
}
template <int DQK, int F0, int NF, bool BIAS, bool NOMAX>
__device__ __forceinline__ void pipe_run(const Args& a, int bh, int qb, LAS unsigned char* lds, const int tid, f32x16 (&o)[2], float& lsum) {
    typedef PipeCfg<DQK> Cf;
    constexpr int NKF = 2 * NF, NT = NTILE;
    const int lane = tid & 63, r32 = lane & 31, hi = lane >> 5, w = __builtin_amdgcn_readfirstlane(tid >> 6);
    const int b = bh >> 2, h = bh & 3, kvh = b * a.nkvh + (h >> a.kv_shift);
    const int qw0 = qb * 256 + 32 * w, qrow = qw0 + r32, frag_off = hi * 1024 + r32 * 16;
    const bf16_t* Kt = a.K + (size_t)kvh * NTILE * Cf::KT_ELEMS; const bf16_t* Vt = a.V + (size_t)kvh * NTILE * 4096;
    const LAS float* lut = (const LAS float*)(lds + LUT_OFF);
#define PIPE_DMA_K(t, slot) do { _Pragma("unroll") for (int j_ = 0; j_ < Cf::NKW; ++j_) { int p_ = w + 8 * j_; if (p_ >= Cf::NKP) p_ -= 8; \
        glds16(Kt + (size_t)(t) * Cf::KT_ELEMS + p_ * 512 + lane * 8, lds + Cf::KRING + (slot) * Cf::KSLOT + p_ * 1024); } } while (0)
#define PIPE_DMA_V(t, slot) glds16(Vt + (size_t)(t) * 4096 + w * 512 + lane * 8, lds + Cf::VRING + (slot) * Cf::VSLOT + w * 1024)
    PIPE_DMA_K(0, 0); PIPE_DMA_V(0, 0); PIPE_DMA_K(1, 1); PIPE_DMA_V(1, 1); PIPE_DMA_K(2, 2);
    bf16x8 qf[NF];
    { const bf16_t* qp = a.Q + ((size_t)bh * SEQ + qrow) * DQK + 8 * hi + 16 * F0;
#pragma unroll
      for (int d0 = 0; d0 < NF; ++d0) qf[d0] = *(const bf16x8*)(qp + 16 * d0); }
    PipeState st; st.mrun = 0.f; st.lrun = 0.f; st.cb = 0.f; st.negm = f32x16{};
    o[0] = f32x16{}; o[1] = f32x16{};
    f32x16 pA0, pA1, pB0, pB1; bf16x8 kf[NKF];
    if (Cf::NKW == 1) ATT_WAITV(4); else asm volatile("s_waitcnt vmcnt(6) lgkmcnt(0)\n\ts_barrier" ::: "memory");
    float cL = 0.f, cR = 0.f;
    if (BIAS) { cL = __int_as_float(__builtin_amdgcn_readfirstlane(__float_as_int(lut[0]))); cR = __int_as_float(__builtin_amdgcn_readfirstlane(__float_as_int(lut[256]))); }
    {
        const LAS unsigned char* k0 = lds + Cf::KRING + frag_off + F0 * 2048;
#pragma unroll
        for (int g = 0; g < NKF; ++g) kf[g] = *(const LAS bf16x8*)(k0 + (g >> 1) * 2048 + (g & 1) * 512);
        pA0 = f32x16{}; pA1 = f32x16{};
        if (BIAS) bias_tile(pA0, pA1, lut, 0, qrow, hi, 0.f);
#pragma unroll
        for (int d = 0; d < NF; ++d) { pA0 = __builtin_amdgcn_mfma_f32_32x32x16_bf16(kf[2 * d], qf[d], pA0, 0, 0, 0); pA1 = __builtin_amdgcn_mfma_f32_32x32x16_bf16(kf[2 * d + 1], qf[d], pA1, 0, 0, 0); }
        float rm = 0.f;
        if (!NOMAX) {
            rm = fmaxf(pA0[0], pA1[0]);
#pragma unroll
            for (int r = 1; r < 16; ++r) rm = fmaxf(rm, fmaxf(pA0[r], pA1[r]));
            { auto rr = __builtin_amdgcn_permlane32_swap(__float_as_uint(rm), __float_as_uint(rm), false, false); rm = fmaxf(__uint_as_float(rr[0]), __uint_as_float(rr[1])); }
        }
        st.mrun = rm;
#pragma unroll
        for (int r = 0; r < 16; ++r) { pA0[r] = __builtin_amdgcn_exp2f(pA0[r] - rm); pA1[r] = __builtin_amdgcn_exp2f(pA1[r] - rm); st.negm[r] = -rm; }
    }
    ATT_WAITV(0);
    PIPE_DMA_K(3, 0); PIPE_DMA_V(2, 2);
    {   const LAS unsigned char* k1 = lds + Cf::KRING + Cf::KSLOT + frag_off + F0 * 2048;
#pragma unroll
        for (int g = 0; g < NKF; ++g) kf[g] = *(const LAS bf16x8*)(k1 + (g >> 1) * 2048 + (g & 1) * 512); }
    if (Cf::NKW == 1) ATT_WAITV(2); else ATT_WAITV(3);
    int t = 1;
    for (; t + 1 < NT; t += 2) {
        pipe_step<DQK, F0, NF, BIAS, NOMAX>(t, pB0, pB1, pA0, pA1, o, kf, qf, st, lds, Kt, Vt, lane, w, frag_off, lut, qw0, qrow, hi, cL, cR);
        pipe_step<DQK, F0, NF, BIAS, NOMAX>(t + 1, pA0, pA1, pB0, pB1, o, kf, qf, st, lds, Kt, Vt, lane, w, frag_off, lut, qw0, qrow, hi, cL, cR);
    }
    pipe_step<DQK, F0, NF, BIAS, NOMAX>(NT - 1, pB0, pB1, pA0, pA1, o, kf, qf, st, lds, Kt, Vt, lane, w, frag_off, lut, qw0, qrow, hi, cL, cR);
    {
        float sacc = 0.f;
#pragma unroll
        for (int r = 0; r < 16; ++r) sacc += pB0[r] + pB1[r];
        st.lrun += sacc;
        u32x4 pw[4];
#pragma unroll
        for (int j = 0; j < 4; ++j) { pw[0][j] = pk2(pB0[2 * j], pB0[2 * j + 1]); pw[1][j] = pk2(pB0[8 + 2 * j], pB0[9 + 2 * j]); pw[2][j] = pk2(pB1[2 * j], pB1[2 * j + 1]); pw[3][j] = pk2(pB1[8 + 2 * j], pB1[9 + 2 * j]); }
        const LAS unsigned char* vs = lds + Cf::VRING + ((NT - 1) & 3) * Cf::VSLOT + frag_off;
#pragma unroll
        for (int k4 = 0; k4 < 4; ++k4)
#pragma unroll
            for (int db = 0; db < 2; ++db) { const bf16x8 vfr = *(const LAS bf16x8*)(vs + k4 * 2048 + db * 512);
                o[db] = __builtin_amdgcn_mfma_f32_32x32x16_bf16(vfr, __builtin_bit_cast(bf16x8, pw[k4]), o[db], 0, 0, 0); }
    }
#undef PIPE_DMA_K
#undef PIPE_DMA_V
    lsum = st.lrun + __shfl_xor(st.lrun, 32);
    asm volatile("s_waitcnt lgkmcnt(0)\n\ts_barrier" ::: "memory");
}
__device__ __forceinline__ void store_rows(const Args& a, int bh, int qb, int tid, const f32x16 (&val)[2]) {
    const int lane = tid & 63, r32 = lane & 31, hi = lane >> 5, w = __builtin_amdgcn_readfirstlane(tid >> 6), b = bh >> 2, h = bh & 3, qrow = qb * 256 + 32 * w + r32;
    bf16_t* yp = a.Y + ((size_t)(b * SEQ + qrow)) * DM + a.ycol + h * 64 + 4 * hi;
#pragma unroll
    for (int db = 0; db < 2; ++db)
#pragma unroll
        for (int g = 0; g < 4; ++g) { u32x2 wv; wv.x = pk2(val[db][4 * g], val[db][4 * g + 1]); wv.y = pk2(val[db][4 * g + 2], val[db][4 * g + 3]); *(u32x2*)(yp + 32 * db + 8 * g) = wv; }
}
__device__ __forceinline__ float score_bound(const Args& a, int tid) {
    const int lane = tid & 63; float bq = 0.f, bk = 0.f;
    for (int i = lane; i < a.ng; i += 64) { bq = fmaxf(bq, fabsf(a.gq[i])); bk = fmaxf(bk, fabsf(a.gk[i])); }
#pragma unroll
    for (int o = 1; o < 64; o <<= 1) { bq = fmaxf(bq, __shfl_xor(bq, o)); bk = fmaxf(bk, __shfl_xor(bk, o)); }
    return __int_as_float(__builtin_amdgcn_readfirstlane(__float_as_int(a.sqrtd * LOG2E * bq * bk)));
}
constexpr float NOMAX_BOUND = 40.0f;
template <int DQK>
__device__ __forceinline__ void unit_plain(const Args& a, int bh, int qb, LAS unsigned char* lds, const int tid) {
    f32x16 o[2]; float l;
    if (score_bound(a, tid) <= NOMAX_BOUND) pipe_run<DQK, 0, DQK / 16, false, true>(a, bh, qb, lds, tid, o, l);
    else pipe_run<DQK, 0, DQK / 16, false, false>(a, bh, qb, lds, tid, o, l);
    const float i0 = 1.0f / l; o[0] = o[0] * i0; o[1] = o[1] * i0;
    store_rows(a, bh, qb, tid, o);
}
__device__ __forceinline__ void unit_diff(const Args& a, int bh, int qb, LAS unsigned char* lds, const int tid) {
    const int h = bh & 3;
    LAS float* lut = (LAS float*)(lds + LUT_OFF);
    for (int i = tid; i < 257; i += NTHREADS) { const int rel = i - 128, n = rel < 0 ? -rel : rel;
        int large = 8 + (int)(logf((float)(n < 1 ? 1 : n) / 8.0f) / 2.772588722239781f * 8.0f); large = large > 15 ? 15 : large;
        const int bucket = (rel > 0 ? 16 : 0) + (n < 8 ? n : large);
        lut[i] = a.lut_src[bucket * 4 + h] * LOG2E; }
    f32x16 va[2], ob[2]; float la, lb;
    float bmax = 0.f; for (int i = 0; i < 32; ++i) bmax = fmaxf(bmax, fabsf(a.lut_src[i * 4 + h]));
    const bool nomax = score_bound(a, tid) + bmax * LOG2E <= NOMAX_BOUND;
    LAS float* park = (LAS float*)(lds + PARK_OFF) + (tid >> 6) * 2048 + (tid & 63);
    if (nomax) pipe_run<64, 0, 2, true, true>(a, bh, qb, lds, tid, va, la); else pipe_run<64, 0, 2, true, false>(a, bh, qb, lds, tid, va, la);
    { const float i0 = 1.0f / la;
#pragma unroll
      for (int r = 0; r < 16; ++r) { park[r * 64] = va[0][r] * i0; park[(16 + r) * 64] = va[1][r] * i0; } }
    if (nomax) pipe_run<64, 2, 2, true, true>(a, bh, qb, lds, tid, ob, lb); else pipe_run<64, 2, 2, true, false>(a, bh, qb, lds, tid, ob, lb);
#pragma unroll
    for (int r = 0; r < 16; ++r) { va[0][r] = park[r * 64]; va[1][r] = park[(16 + r) * 64]; }
    float s1 = 0.f, s2 = 0.f;
    for (int i = 0; i < 32; ++i) { s1 += a.lam_src[i] * a.lam_src[32 + i]; s2 += a.lam_src[64 + i] * a.lam_src[96 + i]; }
    const float lam = expf(s1) - expf(s2) + a.lam_init, i1 = lam / lb;
    va[0] = va[0] - ob[0] * i1; va[1] = va[1] - ob[1] * i1;
    float s = 0.f;
#pragma unroll
    for (int r = 0; r < 16; ++r) s += va[0][r] * va[0][r] + va[1][r] * va[1][r];
    s += __shfl_xor(s, 32);
    const float rn = 1.0f / sqrtf(s * (1.0f / 64.0f) + EPS);
    va[0] = va[0] * rn; va[1] = va[1] * rn;
    store_rows(a, bh, qb, tid, va);
}
}

__device__ __forceinline__ void attention_phase(const Ctx& c, int l) {
    bf16_t* Y = c.wsb(WS_R);
    for (int u = c.bid; u < 1024; u += c.G) {
        const int type = u >> 8, v = u & 255, bh = v & 7, qb = v >> 3;
        int tid_u = c.tid; asm volatile("" : "+v"(tid_u));
        if (type == 0 && EN(8)) { att::Args a{c.wsb(WS_QC), c.wsb(WS_KC), c.wsb(WS_VC), Y, 512, 0, 4, c.kp->in[I_T5], c.kp->in[I_DLAM] + l * 128, lambda_init(l), c.kp->in[I_DQN] + l * 32, c.kp->in[I_DKN] + l * 32, 32, 5.656854249f}; att::unit_diff(a, bh, qb, c.lds, tid_u); }
        else if (type == 1 && EN(9)) { att::Args a{c.wsb(WS_QB), c.wsb(WS_KB), c.wsb(WS_VB), Y, 256, 0, 4, nullptr, nullptr, 0.f, c.kp->in[I_MLAQN] + l * 96, c.kp->in[I_MLAKN] + l * 96, 96, 9.797958971f}; att::unit_plain<96>(a, bh, qb, c.lds, tid_u); }
        else if (type == 2 && EN(10)) { att::Args a{c.wsb(WS_QD), c.wsb(WS_KD), c.wsb(WS_VD), Y, 768, 1, 2, nullptr, nullptr, 0.f, c.kp->in[I_GQN] + l * 64, c.kp->in[I_GKN] + l * 64, 64, 8.0f}; att::unit_plain<64>(a, bh, qb, c.lds, tid_u); }
        else if (type == 3 && EN(11)) { att::Args a{c.wsb(WS_QA), c.wsb(WS_KA), c.wsb(WS_VA), Y, 0, 0, 4, c.kp->in[I_NARPB] + l * 4 * 465, nullptr, 0.f, nullptr, nullptr, 0, 0.f}; att::unit<2, 64>(a, bh, qb, c.lds, tid_u); }
    }
}

__device__ __forceinline__ void ynorm_phase(const Ctx& c) {
    const int gw = c.bid * NWAVES + c.wave, NGW = c.G * NWAVES; bf16_t* Y = c.wsb(WS_R);
    for (int row = gw; row < MROWS; row += NGW) {
        u32x4* yr = (u32x4*)(Y + (size_t)row * DM + c.lane * 16);
        const u32x4 u0 = yr[0], u1 = yr[1]; float v[16]; unpack8(u0, v); unpack8(u1, v + 8);
        float s = 0.f;
#pragma unroll
        for (int j = 0; j < 16; ++j) s += v[j] * v[j];
        s += __shfl_xor(s, 1); s += __shfl_xor(s, 2); s += __shfl_xor(s, 4); s += __shfl_xor(s, 8);
        const float rs = 1.0f / sqrtf(s * (1.0f / 256.0f) + EPS);
        if ((c.lane >> 4) != 2) {
#pragma unroll
            for (int j = 0; j < 16; ++j) v[j] *= rs;
            yr[0] = pack8(v); yr[1] = pack8(v + 8);
        }
    }
}
__device__ __forceinline__ void final_phase(const Ctx& c) {
    const int gw = c.bid * NWAVES + c.wave, NGW = c.G * NWAVES; float* X = c.kp->out; const float* ss3 = c.ssp(2); const float* gf = c.kp->in[I_FINN] + DM;
    for (int row = gw; row < MROWS; row += NGW) {
        const float rs = 1.0f / sqrtf(pg8::sum16(ss3 + (size_t)row * 16) * (1.0f / DM) + EPS);
        f32x4* xr = (f32x4*)(X + (size_t)row * DM) + c.lane;
#pragma unroll
        for (int j = 0; j < 4; ++j) { const f32x4 g = *((const f32x4*)gf + c.lane + 64 * j); xr[64 * j] = xr[64 * j] * g * rs; }
    }
}

constexpr int N_PHASES = 21;
__device__ __forceinline__ void run_kind(const Ctx& c, int kind, int l) {
    using namespace pg8;
    const int G = c.G, bid = c.bid;
    switch (kind) {
        case 0: case 7: if (EN(0)) {
            const bool second = kind == 7;
            Gemm g{c.wsb(WS_XB), c.wsb(second ? WS_WGU2 : WS_WGU1), MROWS, 2 * DFF, DM}; StaticOrder S; S.init(MROWS, 2 * DFF, G, bid);
            RowScale rsc; if (second) { rsc.ss1 = nullptr; rsc.ssp = c.ssp(1); rsc.ssgp = nullptr; } else if (l == 0) { rsc.ss1 = c.ss0(); rsc.ssp = nullptr; rsc.ssgp = nullptr; } else { rsc.ss1 = nullptr; rsc.ssp = c.ssp(2); rsc.ssgp = c.ssp(3); }
            EpiSwiGLU E{c.wsb(WS_R), rsc};
            gemm_phase<EpiSwiGLU, StaticOrder, true, true>(c.lds, g, S, E, c.tid);
        } break;
        case 1: case 8: if (EN(1)) {
            const bool second = kind == 8;
            Gemm g{c.wsb(WS_R), c.wsb(second ? WS_WD2 : WS_WD1), MROWS, DM, DFF}; StaticOrder S; S.init(MROWS, DM, G, bid);
            EpiResid E;
            E.alpha = 0.5f; E.out = c.kp->out; E.outb = c.wsb(WS_XB);
            if (second) { E.base = c.kp->out; E.bss = nullptr; E.bg = nullptr; E.ss_out = c.ssp(2); E.gf = c.kp->in[I_FINN] + l * DM; E.ssg_out = c.ssp(3); }
            else { E.ss_out = c.ssp(0); E.gf = nullptr; E.ssg_out = nullptr;
                   if (l == 0) { E.base = c.kp->in[I_X]; E.bss = nullptr; E.bg = nullptr; } else { E.base = c.kp->out; E.bss = c.ssp(2); E.bg = c.kp->in[I_FINN] + (l - 1) * DM; } }
            gemm_phase<EpiResid, StaticOrder, true, true>(c.lds, g, S, E, c.tid);
        } break;
        case 2: if (EN(2)) {
            Gemm g{c.wsb(WS_XB), c.wsb(WS_WIN), MROWS, NIN, DM}; StaticOrder S; S.init(MROWS, NIN, G, bid);
            RowScale rsc{nullptr, c.ssp(0), nullptr};
            EpiScaleBf16 E{c.wsb(WS_R), NIN, rsc};
            gemm_phase<EpiScaleBf16, StaticOrder, true, true>(c.lds, g, S, E, c.tid);
        } break;
        case 3: if (EN(3)) for (int T = bid; T < MROWS / 64; T += G) prep_unit(c, l, T); break;
        case 4: if (EN(4)) attention_phase(c, l); break;
        case 5: if (EN(5)) ynorm_phase(c); break;
        case 6: if (EN(6)) {
            Gemm g{c.wsb(WS_R), c.wsb(WS_WOUT), MROWS, DM, DM}; StaticOrder S; S.init(MROWS, DM, G, bid);
            EpiResid E; E.base = c.kp->out; E.bss = nullptr; E.bg = nullptr; E.alpha = 1.0f; E.out = c.kp->out; E.outb = c.wsb(WS_XB); E.ss_out = c.ssp(1); E.gf = nullptr; E.ssg_out = nullptr;
            gemm_phase<EpiResid, StaticOrder, true, true>(c.lds, g, S, E, c.tid);
        } break;
        default: break;
    }
}

__global__ void __launch_bounds__(NTHREADS, 2) fwd_megakernel(Params p) {
    extern __shared__ __attribute__((aligned(16))) unsigned char lds_raw[];
    cg::grid_group grid = cg::this_grid();
    const int ph_lo = p.ph_lo, ph_hi = p.ph_hi;
    const int wave_id = __builtin_amdgcn_readfirstlane((int)threadIdx.x >> 6);
    {
        volatile LAS unsigned* st0 = (volatile LAS unsigned*)((LAS unsigned char*)lds_raw + LDS_MISC);
        if (threadIdx.x < 4) st0[threadIdx.x] = 0u;
        __syncthreads();
        (void)xcd_barrier_post((unsigned*)p.ws, st0);
    }
    for (int ph = ph_lo; ph < ph_hi; ++ph) {
        if (ph == ph_lo + 1) grid.sync();
        else if (ph > ph_lo + 1) { XcdBarrier xb; xb.bar = (unsigned*)((KParams)__builtin_amdgcn_kernarg_segment_ptr())->ws; xb.x = xb_xcc_id(); xb.st = (volatile LAS unsigned*)((LAS unsigned char*)lds_raw + LDS_MISC); xcd_barrier(xb); }
        KParams kp = (KParams)__builtin_amdgcn_kernarg_segment_ptr();
        asm volatile("" : "+s"(kp));
        int lane_; asm volatile("v_mbcnt_lo_u32_b32 %0, -1, 0\n\tv_mbcnt_hi_u32_b32 %0, -1, %0" : "=v"(lane_));
        int tid_ = wave_id * 64 + lane_, bid_ = blockIdx.x, G_ = gridDim.x; unsigned lds_ = (unsigned)(uintptr_t)(LAS unsigned char*)lds_raw;
        asm volatile("" : "+v"(tid_)); asm volatile("" : "+s"(bid_)); asm volatile("" : "+s"(G_)); asm volatile("" : "+s"(lds_));
        Ctx c; c.kp = kp; c.lds = (LAS unsigned char*)(uintptr_t)lds_; c.tid = tid_; c.lane = c.tid & 63; c.wave = __builtin_amdgcn_readfirstlane(c.tid >> 6); c.G = G_; c.bid = bid_;
        if (ph == 0) { if (EN(16)) prologue(c); }
        else if (ph == 10) { if (EN(18)) wconv_layer(c, 1); }
        else if (ph == 20) { if (EN(17)) final_phase(c); }
        else { const int l = ph > 10 ? 1 : 0; run_kind(c, ph - 1 - 10 * l, l); if (MK_DUP >= 0 && ph - 1 - 10 * l == MK_DUP) { __syncthreads(); run_kind(c, ph - 1 - 10 * l, l); } }
    }
}

extern "C" void kernel_launch(void* const* d_in, const int* in_sizes, int n_in, void* d_out, int out_size, void* d_ws, size_t ws_size, hipStream_t stream) {
    static int grid = 0;
    if (grid == 0) {
        if (n_in != 32 || out_size != MROWS * DM || ws_size < WS_END) { fprintf(stderr, "kernel_launch: unexpected shapes (n_in %d, out %d, ws %zu)\n", n_in, out_size, ws_size); grid = -1; return; }
        int dev = 0, cus = 0, per_cu = 0;
        hipGetDevice(&dev); hipDeviceGetAttribute(&cus, hipDeviceAttributeMultiprocessorCount, dev);
        hipFuncSetAttribute((const void*)fwd_megakernel, hipFuncAttributeMaxDynamicSharedMemorySize, LDS_BYTES);
        hipOccupancyMaxActiveBlocksPerMultiprocessor(&per_cu, (const void*)fwd_megakernel, NTHREADS, LDS_BYTES);
        if (per_cu < 1) { fprintf(stderr, "kernel_launch: occupancy query says %d blocks per CU\n", per_cu); per_cu = 1; }
        (void)hipGetLastError();
        grid = cus * 1;
    }
    if (grid < 0) return;
    if (hipMemsetAsync((char*)d_ws + WS_BAR, 0, BAR_ZERO_BYTES, stream) != hipSuccess) { fprintf(stderr, "kernel_launch: memset of barrier words failed\n"); return; }
    Params p{};
    for (int i = 0; i < 32; ++i) p.in[i] = (const float*)d_in[i];
    p.out = (float*)d_out; p.ws = (unsigned char*)d_ws;
#if MK_SPLIT
    for (int ph = 0; ph < N_PHASES; ++ph) {
        p.ph_lo = ph; p.ph_hi = ph + 1; void* args[] = {&p};
        hipError_t e = hipLaunchCooperativeKernel((const void*)fwd_megakernel, dim3(grid), dim3(NTHREADS), args, LDS_BYTES, stream);
        if (e != hipSuccess) { fprintf(stderr, "cooperative launch failed: %s (grid %d)\n", hipGetErrorString(e), grid); break; }
    }
#else
    p.ph_lo = 0; p.ph_hi = N_PHASES; void* args[] = {&p};
    hipError_t e = hipLaunchCooperativeKernel((const void*)fwd_megakernel, dim3(grid), dim3(NTHREADS), args, LDS_BYTES, stream);
    if (e != hipSuccess) fprintf(stderr, "cooperative launch failed: %s (grid %d)\n", hipGetErrorString(e), grid);
#endif
}
```

```cpp
#include <hip/hip_runtime.h>
#include <hip/hip_cooperative_groups.h>
#include <cstdio>
#include <cstdint>
namespace cg = cooperative_groups;

#ifndef MK_ENABLE
#define MK_ENABLE 0xFFFFFF
#endif
#define EN(k) ((MK_ENABLE >> (k)) & 1)
#ifndef MK_DUP
#define MK_DUP -1
#endif
#ifndef MK_SPLIT
#define MK_SPLIT 0
#endif

#define LAS __attribute__((address_space(3)))
typedef unsigned short bf16_t;
typedef short bf16x8 __attribute__((ext_vector_type(8)));
typedef float f32x4 __attribute__((ext_vector_type(4)));
typedef float f32x16 __attribute__((ext_vector_type(16)));
typedef unsigned u32x4 __attribute__((ext_vector_type(4)));
typedef unsigned u32x2 __attribute__((ext_vector_type(2)));
typedef float f32x2_t __attribute__((ext_vector_type(2)));
typedef __bf16 bf16x2_t __attribute__((ext_vector_type(2)));

constexpr int BATCH = 2, SEQ = 8192, DM = 1024, MROWS = BATCH * SEQ, DFF = 2816, NIN = 2560, NTILE = SEQ / 64, DEPTH = 2;
constexpr float EPS = 1e-6f;
constexpr float LOG2E = 1.4426950408889634f;
constexpr int NWAVES = 8, NTHREADS = 512;

constexpr size_t MiB = 1u << 20;
constexpr size_t WS_SS0 = 65536;
constexpr size_t WS_SSP = 252 * MiB;
constexpr size_t WS_TAB = 1 * MiB;
constexpr size_t WS_WGU1 = 3 * MiB, WS_WD1 = 14 * MiB, WS_WIN = 19 * MiB + 512 * 1024, WS_WOUT = 24 * MiB + 512 * 1024, WS_WGU2 = 26 * MiB + 512 * 1024, WS_WD2 = 37 * MiB + 512 * 1024;
constexpr size_t WS_WUQ = 43 * MiB, WS_WUKV = 43 * MiB + 256 * 1024;
constexpr size_t WS_XB = 44 * MiB;
constexpr size_t WS_R = 76 * MiB;
constexpr size_t WS_QA = 156 * MiB, WS_KA = 164 * MiB, WS_VA = 172 * MiB, WS_QB = 180 * MiB, WS_KB = 192 * MiB, WS_VB = 204 * MiB;
constexpr size_t WS_QC = 212 * MiB, WS_KC = 220 * MiB, WS_VC = 228 * MiB, WS_QD = 236 * MiB, WS_KD = 244 * MiB, WS_VD = 248 * MiB, WS_END = 256 * MiB;
constexpr int LDS_BYTES = 147456;
constexpr int LDS_RSTAB = 131072;
constexpr int LDS_MISC = LDS_BYTES - 64;
constexpr size_t WS_BAR = 0, BAR_ZERO_BYTES = 16384;

__device__ __forceinline__ unsigned pk2(float lo, float hi) { f32x2_t v = {lo, hi}; bf16x2_t b = __builtin_convertvector(v, bf16x2_t); return __builtin_bit_cast(unsigned, b); }
__device__ __forceinline__ float bf2f(unsigned short u) { return __uint_as_float(((unsigned)u) << 16); }
__device__ __forceinline__ void unpack8(const u32x4 u, float* v) {
    v[0] = __uint_as_float(u.x << 16); v[1] = __uint_as_float(u.x & 0xffff0000u); v[2] = __uint_as_float(u.y << 16); v[3] = __uint_as_float(u.y & 0xffff0000u);
    v[4] = __uint_as_float(u.z << 16); v[5] = __uint_as_float(u.z & 0xffff0000u); v[6] = __uint_as_float(u.w << 16); v[7] = __uint_as_float(u.w & 0xffff0000u);
}
__device__ __forceinline__ u32x4 pack8(const float* v) { u32x4 u; u.x = pk2(v[0], v[1]); u.y = pk2(v[2], v[3]); u.z = pk2(v[4], v[5]); u.w = pk2(v[6], v[7]); return u; }
__device__ __forceinline__ float wave_sum(float v) {
#pragma unroll
    for (int o = 1; o < 64; o <<= 1) v += __shfl_xor(v, o);
    return v;
}

namespace pg8 {
constexpr int BM = 256, BK = 64, HALF = 128, HTB = HALF * BK * 2, STAGE_BYTES = 8 * HTB, NXCD = 8, WGM = 8;
__host__ __device__ __forceinline__ int lds_byte(int r, int c) { const int st = (r >> 4) * 2 + (c >> 5), rr = r & 15, cc = c & 31, ob = rr * 64 + cc * 2; return st * 1024 + (ob ^ (((ob >> 9) & 1) << 5)); }
__host__ __device__ __forceinline__ void stage_rc(int b, int& R, int& C) { const int st = b / 1024, sb = b % 1024, swz = sb ^ (((sb >> 9) & 1) << 5); R = (st >> 1) * 16 + swz / 64; C = (st & 1) * 32 + (swz % 64) / 2; }
__host__ __device__ __forceinline__ int perm32(int rho) { const int n = rho >> 4, i = rho & 15; return 8 * (i >> 2) + 4 * n + (i & 3); }
struct Unit { int pm, pn; };
struct Gemm { const bf16_t* A; const bf16_t* Bt; int M, N, K; };
struct StaticOrder {
    int nM, nN, nwg, G, c;
    __host__ __device__ void init(int M, int N, int G_, int c_) { nM = M / BM; nN = N / BM; nwg = nM * nN; G = G_; c = c_; }
    __host__ __device__ bool next(int i, Unit& u) const {
        const long L = (long)i * G + c; if (L >= nwg) return false;
        int wgid = (int)L; { const int q = nwg / NXCD, r = nwg % NXCD, xcd = wgid % NXCD, off = wgid / NXCD; wgid = (xcd < r ? xcd * (q + 1) : r * (q + 1) + (xcd - r) * q) + off; }
        const int nig = WGM * nN, gid = wgid / nig, fm = gid * WGM, gsz = (nM - fm) < WGM ? (nM - fm) : WGM;
        u.pm = fm + ((wgid % nig) % gsz); u.pn = (wgid % nig) / gsz; return true;
    }
    __device__ __forceinline__ void a_ready(const Unit&) const {}
    __device__ __forceinline__ void done(const Unit&) const {}
};

__device__ __forceinline__ float sum16(const float* p) {
    const f32x4 a = *(const f32x4*)p, b = *(const f32x4*)(p + 4), c = *(const f32x4*)(p + 8), d = *(const f32x4*)(p + 12);
    return (((a[0] + a[1]) + (a[2] + a[3])) + ((b[0] + b[1]) + (b[2] + b[3]))) + (((c[0] + c[1]) + (c[2] + c[3])) + ((d[0] + d[1]) + (d[2] + d[3])));
}
struct RowScale {
    const float* ss1; const float* ssp; const float* ssgp;
    __device__ __forceinline__ float get(int row) const {
        const float s = ss1 ? ss1[row] : sum16(ssp + (size_t)row * 16);
        float rs = 1.0f / sqrtf(s * (1.0f / DM) + EPS);
        if (ssgp) { const float rsn = 1.0f / sqrtf(rs * rs * sum16(ssgp + (size_t)row * 16) * (1.0f / DM) + EPS); rs *= rsn; }
        return rs;
    }
};

struct EpiSwiGLU {
    static constexpr bool PERM = true, AFTER_DRAIN = false;
    bf16_t* O; const LAS float* rstab;
    __device__ __forceinline__ void operator()(const f32x4 (&acc)[2][2][4][2], const Unit& u, int ui, int wr, int wc, int fr, int fq) const {
        const int row0 = u.pm * BM + wr * 64 + fr, col0 = u.pn * HALF + wc * 32 + 8 * fq;
#pragma unroll
        for (int ai = 0; ai < 2; ++ai)
#pragma unroll
            for (int m = 0; m < 4; ++m) {
                const int row = row0 + ai * HALF + m * 16; const float rs = rstab[ui * BM + (row - u.pm * BM)];
                float a[8];
#pragma unroll
                for (int n = 0; n < 2; ++n)
#pragma unroll
                    for (int i = 0; i < 4; ++i) {
                        const float g = acc[ai][0][m][n][i] * rs, up = acc[ai][1][m][n][i] * rs;
                        const float sg = g * __builtin_amdgcn_rcpf(1.0f + __builtin_amdgcn_exp2f(-g * LOG2E));
                        a[n * 4 + i] = sg * up;
                    }
                *(u32x4*)(O + (size_t)row * DFF + col0) = pack8(a);
            }
    }
};
struct EpiScaleBf16 {
    static constexpr bool PERM = true, AFTER_DRAIN = false;
    bf16_t* O; int ldo; const LAS float* rstab;
    __device__ __forceinline__ void operator()(const f32x4 (&acc)[2][2][4][2], const Unit& u, int ui, int wr, int wc, int fr, int fq) const {
        const int row0 = u.pm * BM + wr * 64 + fr, col0 = u.pn * BM + wc * 32 + 8 * fq;
#pragma unroll
        for (int ai = 0; ai < 2; ++ai)
#pragma unroll
            for (int m = 0; m < 4; ++m) {
                const int row = row0 + ai * HALF + m * 16; const float rs = rstab[ui * BM + (row - u.pm * BM)];
#pragma unroll
                for (int bj = 0; bj < 2; ++bj) {
                    float a[8];
#pragma unroll
                    for (int n = 0; n < 2; ++n)
#pragma unroll
                        for (int i = 0; i < 4; ++i) a[n * 4 + i] = acc[ai][bj][m][n][i] * rs;
                    *(u32x4*)(O + (size_t)row * ldo + col0 + bj * HALF) = pack8(a);
                }
            }
    }
};
struct EpiResid {
    static constexpr bool PERM = false, AFTER_DRAIN = false;
    const float* base; const float* bss; const float* bg; float alpha; float* out; bf16_t* outb; float* ss_out; const float* gf; float* ssg_out;
    __device__ __forceinline__ void operator()(const f32x4 (&acc)[2][2][4][2], const Unit& u, int ui, int wr, int wc, int fr, int fq) const {
        const int row0 = u.pm * BM + wr * 64 + fr, col0 = u.pn * BM + wc * 32 + 4 * fq;
#pragma unroll
        for (int ai = 0; ai < 2; ++ai)
#pragma unroll
            for (int m = 0; m < 4; ++m) {
                const int row = row0 + ai * HALF + m * 16; const size_t off = (size_t)row * DM + col0;
                float brs = 1.0f; if (bss) brs = 1.0f / sqrtf(sum16(bss + (size_t)row * 16) * (1.0f / DM) + EPS);
                float s = 0.f, sg = 0.f;
#pragma unroll
                for (int bj = 0; bj < 2; ++bj)
#pragma unroll
                    for (int n = 0; n < 2; ++n) {
                        const int co = bj * HALF + n * 16;
                        f32x4 b = *(const f32x4*)(base + off + co);
                        if (bss) { const f32x4 g = *(const f32x4*)(bg + col0 + co); b = b * g * brs; }
                        const f32x4 v = b + acc[ai][bj][m][n] * alpha;
                        *(f32x4*)(out + off + co) = v;
                        u32x2 w; w.x = pk2(v[0], v[1]); w.y = pk2(v[2], v[3]); *(u32x2*)(outb + off + co) = w;
                        s += (v[0] * v[0] + v[1] * v[1]) + (v[2] * v[2] + v[3] * v[3]);
                        if (gf) { const f32x4 g2 = *(const f32x4*)(gf + col0 + co); const f32x4 t = v * g2; sg += (t[0] * t[0] + t[1] * t[1]) + (t[2] * t[2] + t[3] * t[3]); }
                    }
                s += __shfl_xor(s, 16); s += __shfl_xor(s, 32);
                if (fq == 0) ss_out[(size_t)row * 16 + u.pn * 4 + wc] = s;
                if (gf) { sg += __shfl_xor(sg, 16); sg += __shfl_xor(sg, 32); if (fq == 0) ssg_out[(size_t)row * 16 + u.pn * 4 + wc] = sg; }
            }
    }
};

template <class Epi, class Sched, bool ALIGN_EPI = false, bool SP2 = false>
__device__ __forceinline__ void gemm_phase(LAS unsigned char* lds, const Gemm g, const Sched& S, const Epi& E, const int tid) {
    const int wid = __builtin_amdgcn_readfirstlane(tid >> 6), lane = tid & 63, wr = wid >> 2, wc = wid & 3, fr = lane & 15, fq = lane >> 4;
    const int K = g.K, nt = K / BK;
    unsigned voffA[2], voffB[2];
#pragma unroll
    for (int i = 0; i < 2; ++i) { int R, C; stage_rc(tid * 16 + i * 8192, R, C); const int Rb = Epi::PERM ? ((R & ~31) + perm32(R & 31)) : R;
        voffA[i] = (unsigned)(R * K + C) * 2u; voffB[i] = (unsigned)(Rb * K + C) * 2u; }
    const size_t kstep = (size_t)(BK * 2);
    const size_t hstep = (size_t)HALF * K * 2;
    const size_t tstep = 2 * hstep;
    const unsigned ldsw = (unsigned)wid * 1024u;
    const int aoff = lds_byte(wr * 64 + fr, fq * 8), boff = lds_byte(wc * 32 + fr, fq * 8);
#define PG8_SA(b, h) (((b) * 2 + (h)) * HTB)
#define PG8_SB(b, h) ((4 + (b) * 2 + (h)) * HTB)
#define PG8_STAGE(bufoff, gbase, voff) do { _Pragma("unroll") for (int _i = 0; _i < 2; ++_i) \
        __builtin_amdgcn_global_load_lds((const unsigned*)((const char*)(gbase) + (voff)[_i]), (LAS unsigned*)(lds + (bufoff) + ldsw + _i * 8192), 16, 0, 0); } while (0)
#define PG8_LDA(dst, b, h) do { _Pragma("unroll") for (int m = 0; m < 4; ++m) _Pragma("unroll") for (int k = 0; k < 2; ++k) dst[m][k] = *(const LAS bf16x8*)(lds + PG8_SA(b, h) + aoff + m * 2048 + k * 1024); } while (0)
#define PG8_LDB(dst, b, h) do { _Pragma("unroll") for (int n = 0; n < 2; ++n) _Pragma("unroll") for (int k = 0; k < 2; ++k) dst[n][k] = *(const LAS bf16x8*)(lds + PG8_SB(b, h) + boff + n * 2048 + k * 1024); } while (0)
#define PG8_MMA(ai, bj, At, Bt) do { __builtin_amdgcn_s_setprio(1); _Pragma("unroll") for (int m = 0; m < 4; ++m) _Pragma("unroll") for (int n = 0; n < 2; ++n) _Pragma("unroll") for (int k = 0; k < 2; ++k) \
        acc[ai][bj][m][n] = __builtin_amdgcn_mfma_f32_16x16x32_bf16(Bt[n][k], At[m][k], acc[ai][bj][m][n], 0, 0, 0); __builtin_amdgcn_s_setprio(0); } while (0)
#define PG8_WAIT_V(n) asm volatile("s_waitcnt vmcnt(" #n ")" ::: "memory")
#define PG8_WAIT_L(n) asm volatile("s_waitcnt lgkmcnt(" #n ")" ::: "memory")
#define PG8_BAR __builtin_amdgcn_s_barrier()
#define PG8_SCHED __builtin_amdgcn_sched_barrier(0)
    Unit cur, nxt; int ui = 0;
    if (!S.next(0, cur)) return;
    f32x4 acc[2][2][4][2];
#pragma unroll
    for (int a = 0; a < 2; ++a)
#pragma unroll
        for (int b = 0; b < 2; ++b)
#pragma unroll
            for (int m = 0; m < 4; ++m)
#pragma unroll
                for (int n = 0; n < 2; ++n) acc[a][b][m][n] = (f32x4){0.f, 0.f, 0.f, 0.f};
    bf16x8 At[4][2], B0[2][2], B1[2][2];
    const char* cA = (const char*)g.A + (size_t)cur.pm * tstep; const char* cB = (const char*)g.Bt + (size_t)cur.pn * tstep;
    S.a_ready(cur);
    if constexpr (SP2) {
        PG8_STAGE(PG8_SB(0, 0), cB, voffB); PG8_STAGE(PG8_SB(0, 1), cB + hstep, voffB); PG8_STAGE(PG8_SA(0, 0), cA, voffA); PG8_STAGE(PG8_SA(0, 1), cA + hstep, voffA);
        if (wr == 1) PG8_BAR;
        PG8_WAIT_V(2); PG8_BAR;
        PG8_STAGE(PG8_SB(1, 0), cB + kstep, voffB); PG8_STAGE(PG8_SA(1, 0), cA + kstep, voffA); PG8_STAGE(PG8_SB(1, 1), cB + hstep + kstep, voffB);
        PG8_WAIT_V(6); PG8_BAR;
    } else {
        PG8_STAGE(PG8_SB(0, 0), cB, voffB); PG8_STAGE(PG8_SA(0, 0), cA, voffA); PG8_STAGE(PG8_SB(0, 1), cB + hstep, voffB); PG8_STAGE(PG8_SA(0, 1), cA + hstep, voffA);
        if (wr == 1) PG8_BAR;
        PG8_WAIT_V(4); PG8_BAR;
        PG8_STAGE(PG8_SB(1, 0), cB + kstep, voffB); PG8_STAGE(PG8_SA(1, 0), cA + kstep, voffA); PG8_STAGE(PG8_SB(1, 1), cB + hstep + kstep, voffB);
        PG8_WAIT_V(6); PG8_BAR;
    }
    for (;;) {
        const bool has_next = S.next(ui + 1, nxt);
        const char* nA = has_next ? (const char*)g.A + (size_t)nxt.pm * tstep : cA; const char* nB = has_next ? (const char*)g.Bt + (size_t)nxt.pn * tstep : cB;
        for (int t = 0; t < nt; t += 2) {
            const bool last = (t == nt - 2);
            const char* a1 = cA + (size_t)(t + 1) * kstep;
            const char* a2 = last ? nA : cA + (size_t)(t + 2) * kstep; const char* b2 = last ? nB : cB + (size_t)(t + 2) * kstep;
            const char* a3 = a2 + kstep; const char* b3 = b2 + kstep;
            if (last && has_next) S.a_ready(nxt);
            if constexpr (SP2) {
            PG8_LDB(B0, 0, 0); PG8_LDB(B1, 0, 1); PG8_SCHED; PG8_LDA(At, 0, 0); PG8_STAGE(PG8_SA(1, 1), a1 + hstep, voffA);
            PG8_WAIT_V(8); PG8_WAIT_L(0); PG8_BAR; PG8_MMA(0, 0, At, B0); PG8_MMA(0, 1, At, B1); PG8_BAR; PG8_SCHED;
            PG8_LDA(At, 0, 1); PG8_STAGE(PG8_SB(0, 0), b2, voffB); PG8_STAGE(PG8_SB(0, 1), b2 + hstep, voffB); PG8_STAGE(PG8_SA(0, 0), a2, voffA);
            PG8_WAIT_V(8); PG8_WAIT_L(0); PG8_BAR; PG8_MMA(1, 0, At, B0); PG8_MMA(1, 1, At, B1); PG8_BAR; PG8_SCHED;
            PG8_LDB(B0, 1, 0); PG8_LDB(B1, 1, 1); PG8_SCHED; PG8_LDA(At, 1, 0); PG8_STAGE(PG8_SA(0, 1), a2 + hstep, voffA);
            PG8_WAIT_V(8); PG8_WAIT_L(0); PG8_BAR; PG8_MMA(0, 0, At, B0); PG8_MMA(0, 1, At, B1); PG8_BAR; PG8_SCHED;
            PG8_LDA(At, 1, 1); PG8_STAGE(PG8_SB(1, 0), b3, voffB); PG8_STAGE(PG8_SB(1, 1), b3 + hstep, voffB); PG8_STAGE(PG8_SA(1, 0), a3, voffA);
            PG8_WAIT_V(8); PG8_WAIT_L(0); PG8_BAR; PG8_MMA(1, 0, At, B0); PG8_MMA(1, 1, At, B1); PG8_BAR; PG8_SCHED;
            } else {
            PG8_LDB(B0, 0, 0); PG8_SCHED; PG8_LDA(At, 0, 0); PG8_STAGE(PG8_SA(1, 1), a1 + hstep, voffA);
            PG8_WAIT_L(8); PG8_BAR; PG8_WAIT_L(0); PG8_MMA(0, 0, At, B0); PG8_BAR; PG8_SCHED;
            PG8_LDB(B1, 0, 1); PG8_STAGE(PG8_SB(0, 0), b2, voffB);
            PG8_BAR; PG8_WAIT_L(0); PG8_MMA(0, 1, At, B1); PG8_BAR;
            PG8_LDA(At, 0, 1); PG8_STAGE(PG8_SA(0, 0), a2, voffA);
            PG8_BAR; PG8_WAIT_L(0); PG8_MMA(1, 0, At, B0); PG8_BAR; PG8_SCHED;
            PG8_STAGE(PG8_SB(0, 1), b2 + hstep, voffB);
            PG8_WAIT_V(6); PG8_BAR; PG8_MMA(1, 1, At, B1); PG8_BAR;
            PG8_LDB(B0, 1, 0); PG8_SCHED; PG8_LDA(At, 1, 0); PG8_STAGE(PG8_SA(0, 1), a2 + hstep, voffA);
            PG8_WAIT_L(8); PG8_BAR; PG8_WAIT_L(0); PG8_MMA(0, 0, At, B0); PG8_BAR; PG8_SCHED;
            PG8_LDB(B1, 1, 1); PG8_STAGE(PG8_SB(1, 0), b3, voffB);
            PG8_BAR; PG8_WAIT_L(0); PG8_MMA(0, 1, At, B1); PG8_BAR;
            PG8_LDA(At, 1, 1); PG8_STAGE(PG8_SA(1, 0), a3, voffA);
            PG8_BAR; PG8_WAIT_L(0); PG8_MMA(1, 0, At, B0); PG8_BAR; PG8_SCHED;
            PG8_STAGE(PG8_SB(1, 1), b3 + hstep, voffB);
            PG8_WAIT_V(6); PG8_BAR; PG8_MMA(1, 1, At, B1); PG8_BAR;
            }
        }
        if constexpr (ALIGN_EPI) { if (wr == 0) PG8_BAR; }
        if constexpr (!Epi::AFTER_DRAIN) { E(acc, cur, ui, wr, wc, fr, fq); S.done(cur); }
        if (!has_next) break;
#pragma unroll
        for (int a = 0; a < 2; ++a)
#pragma unroll
            for (int b = 0; b < 2; ++b)
#pragma unroll
                for (int m = 0; m < 4; ++m)
#pragma unroll
                    for (int n = 0; n < 2; ++n) acc[a][b][m][n] = (f32x4){0.f, 0.f, 0.f, 0.f};
        cur = nxt; cA = nA; cB = nB; ++ui;
        if constexpr (ALIGN_EPI) { if (wr == 1) PG8_BAR; }
    }
    PG8_WAIT_V(0);
    if constexpr (!ALIGN_EPI) { if (wr == 0) PG8_BAR; }
    PG8_BAR;
#undef PG8_SA
#undef PG8_SB
#undef PG8_STAGE
#undef PG8_LDA
#undef PG8_LDB
#undef PG8_MMA
#undef PG8_WAIT_V
#undef PG8_WAIT_L
#undef PG8_BAR
#undef PG8_SCHED
}
}

#define RLX_AGENT __ATOMIC_RELAXED, __HIP_MEMORY_SCOPE_AGENT
#define XB_TMO      128
#define XB_XCNT(j)  (256  + 64 * (j))
#define XB_XSUB(j)  (1280 + 64 * (j))
#define XB_XGEN(j)  (2304 + 64 * (j))
#define XB_TOP      3328
#define XB_TOPGEN   3392
#define XCD_BAR_WORDS 3456
#define XB_SPIN_CAP (1u << 20)

__device__ __forceinline__ unsigned xb_ld(unsigned* p)              { return __hip_atomic_load(p, __ATOMIC_RELAXED, __HIP_MEMORY_SCOPE_AGENT); }
__device__ __forceinline__ unsigned xb_add(unsigned* p, unsigned v) { return __hip_atomic_fetch_add(p, v, __ATOMIC_RELAXED, __HIP_MEMORY_SCOPE_AGENT); }
__device__ __forceinline__ unsigned xb_xcc_id() { return (unsigned)__builtin_amdgcn_s_getreg((3 << 11) | 20) & 0xFu; }
#define XB_SPIN(cond, bar) do { unsigned _sp = 0; while (cond) { __builtin_amdgcn_s_sleep(1); \
    if ((++_sp & 255u) == 0u) { if (xb_ld(&(bar)[XB_TMO])) break; if (_sp > XB_SPIN_CAP) { atomicAdd(&(bar)[XB_TMO], 1u); break; } } } } while (0)

struct XcdBarrier {
    unsigned* bar; unsigned x;
    volatile LAS unsigned* st;
};

__device__ __forceinline__ XcdBarrier xcd_barrier_post(unsigned* bar, volatile LAS unsigned* st) {
    XcdBarrier b; b.bar = bar; b.x = xb_xcc_id(); b.st = st;
    if (threadIdx.x == 0) (void)xb_add(&bar[XB_XCNT(b.x)], 1u);
    return b;
}
__device__ __forceinline__ void xcd_barrier_complete(unsigned* bar, unsigned x, unsigned& nloc, unsigned& nx) {
    const unsigned G = gridDim.x * gridDim.y * gridDim.z;
    unsigned sum, cnt, mine, sp = 0u;
    for (;;) {
        sum = 0u; cnt = 0u; mine = 0u;
#pragma unroll
        for (unsigned j = 0; j < 16; ++j) { const unsigned c = xb_ld(&bar[XB_XCNT(j)]); sum += c; cnt += (c > 0u) ? 1u : 0u; mine = (j == x) ? c : mine; }
        if (sum == G) break;
        __builtin_amdgcn_s_sleep(1);
        if ((++sp & 255u) == 0u) { if (xb_ld(&bar[XB_TMO])) break; if (sp > XB_SPIN_CAP) { atomicAdd(&bar[XB_TMO], 1u); break; } }
    }
    nloc = mine > 0u ? mine : 1u; nx = cnt > 0u ? cnt : 1u;
}

__device__ __forceinline__ void xcd_barrier(const XcdBarrier& b) {
    asm volatile("s_waitcnt vmcnt(0)" ::: "memory");
    __syncthreads();
    if (threadIdx.x == 0) {
        unsigned* bar = b.bar;
        __builtin_amdgcn_s_waitcnt(0);
        unsigned nloc = b.st[0], nx = b.st[1];
        if (nloc == 0u) { xcd_barrier_complete(bar, b.x, nloc, nx); b.st[0] = nloc; b.st[1] = nx; }
        const unsigned old = xb_add(&bar[XB_XSUB(b.x)], 1u);
        const unsigned gen = old / nloc;
        if (old + 1u == (gen + 1u) * nloc) {
            __builtin_amdgcn_fence(__ATOMIC_RELEASE, "agent");
            asm volatile("s_waitcnt vmcnt(0)" ::: "memory");
            const unsigned og = xb_add(&bar[XB_TOP], 1u);
            const unsigned tg = og / nx;
            if (og + 1u == (tg + 1u) * nx) xb_add(&bar[XB_TOPGEN], 1u);
            else XB_SPIN(xb_ld(&bar[XB_TOPGEN]) == tg, bar);
            __builtin_amdgcn_fence(__ATOMIC_ACQUIRE, "agent");
            xb_add(&bar[XB_XGEN(b.x)], 1u);
            asm volatile("s_waitcnt vmcnt(0)" ::: "memory");
        } else {
            XB_SPIN(xb_ld(&bar[XB_XGEN(b.x)]) == gen, bar);
            __builtin_amdgcn_fence(__ATOMIC_ACQUIRE, "agent");
            asm volatile("s_waitcnt vmcnt(0)" ::: "memory");
        }
    }
    __syncthreads();
}


struct Params { const float* in[32]; float* out; unsigned char* ws; int ph_lo, ph_hi; };
enum { I_X = 0, I_F1N, I_F1G, I_F1U, I_F1D, I_MIXN, I_WIN, I_NAQN, I_NAKN, I_NARPB, I_NABETA, I_MLAQLN, I_MLAWUQ, I_MLAKVLN, I_MLAWUKV, I_MLAQN, I_MLAKN, I_MLABETA,
       I_DQN, I_DKN, I_DLAM, I_DSUBLN, I_GQN, I_GKN, I_GBETA, I_WOUT, I_F2N, I_F2G, I_F2U, I_F2D, I_FINN, I_T5 };
__host__ __device__ __forceinline__ float lambda_init(int l) { return l == 0 ? 0.2f : 0.35550906f; }

typedef const __attribute__((address_space(4))) Params* KParams;
typedef const float* const __attribute__((address_space(4)))* InPtr;
struct Ctx {
    KParams kp; LAS unsigned char* lds; int tid, lane, wave, G, bid;
    __device__ __forceinline__ float* ssp(int k) const { return (float*)(kp->ws + WS_SSP + (size_t)k * MiB); }
    __device__ __forceinline__ float* ss0() const { return (float*)(kp->ws + WS_SS0); }
    __device__ __forceinline__ bf16_t* wsb(size_t off) const { return (bf16_t*)(kp->ws + off); }
};

__device__ __forceinline__ float gain_for(const Ctx& c, int job, int l, int k) {
    InPtr in = c.kp->in;
    switch (job) {
        case 0: { float g = in[I_F1N][l * DM + k]; if (l > 0) g *= in[I_FINN][(l - 1) * DM + k]; return g; }
        case 2: return in[I_MIXN][l * DM + k];
        case 3: { const int gidx = k >> 8, kk = k & 255;
                  if (gidx == 0) return in[I_NABETA][l * 256 + kk];
                  if (gidx == 1) return in[I_MLABETA][l * 256 + kk];
                  if (gidx == 2) return in[I_DSUBLN][l * 64 + (kk & 63)] * (1.0f - lambda_init(l));
                  return in[I_GBETA][l * 256 + kk]; }
        case 4: return in[I_F2N][l * DM + k];
        case 6: return in[I_MLAQLN][l * 256 + k];
        case 7: return in[I_MLAKVLN][l * 128 + k];
        default: return 1.0f;
    }
}
__device__ __forceinline__ void tr_item64(const Ctx& c, const float* W0, const float* W1, int Nsrc, int sc0, int sc1, bf16_t* WT, int K, int n0, int k0, int job, int l, LAS float* scr) {
    const int lane = c.lane, hh = (lane & 15) >> 3, cc = 4 * (lane & 7);
    const float* W = hh ? W1 : W0; const int sc = hh ? sc1 : sc0;
    f32x4 v[16];
#pragma unroll
    for (int i = 0; i < 16; ++i) { const int kk = 4 * i + (lane >> 4);
        v[i] = (f32x4){0.f, 0.f, 0.f, 0.f}; if (sc >= 0) v[i] = *(const f32x4*)(W + (size_t)(k0 + kk) * Nsrc + sc + cc); }
#pragma unroll
    for (int i = 0; i < 16; ++i) { const int kk = 4 * i + (lane >> 4); LAS float* d = scr + kk * 65 + 4 * (lane & 15);
        d[0] = v[i][0]; d[1] = v[i][1]; d[2] = v[i][2]; d[3] = v[i][3]; }
    asm volatile("s_waitcnt lgkmcnt(0)" ::: "memory");
    const int ch = lane & 7;
    float g[8];
#pragma unroll
    for (int i = 0; i < 8; ++i) g[i] = gain_for(c, job, l, k0 + 8 * ch + i);
#pragma unroll
    for (int j = 0; j < 8; ++j) { const int n = (lane >> 3) + 8 * j; const LAS float* s = scr + (8 * ch) * 65 + n;
        u32x4 o; o.x = pk2(s[0 * 65] * g[0], s[1 * 65] * g[1]); o.y = pk2(s[2 * 65] * g[2], s[3 * 65] * g[3]); o.z = pk2(s[4 * 65] * g[4], s[5 * 65] * g[5]); o.w = pk2(s[6 * 65] * g[6], s[7 * 65] * g[7]);
        *(u32x4*)(WT + (size_t)(n0 + n) * K + k0 + 8 * ch) = o; }
    asm volatile("s_waitcnt lgkmcnt(0)" ::: "memory");
}
__device__ __forceinline__ void wconv_layer(const Ctx& c, int l) {
    LAS float* scr = (LAS float*)(c.lds + c.wave * 16640);
    const int gw = c.bid * NWAVES + c.wave, NGW = c.G * NWAVES;
    constexpr int C0 = 16 * 88, C1 = 44 * 16, C2 = 16 * 40, C3 = 16 * 16, C6 = 4 * 6, C7 = 2 * 8;
    constexpr int NITEMS = 2 * C0 + 2 * C1 + C2 + C3 + C6 + C7;
    InPtr in = c.kp->in;
    for (int it = gw; it < NITEMS; it += NGW) {
        int r = it;
        if (r < C0 || (r >= C0 + C1 + C2 + C3 && r < 2 * C0 + C1 + C2 + C3)) {
            const bool second = r >= C0; if (second) r -= C0 + C1 + C2 + C3;
            const int nblk = 88, kb = r / nblk, nb = r % nblk, pn = nb >> 2, blk = nb & 3;
            const float* Wg = second ? in[I_F2G] : in[I_F1G]; const float* Wu = second ? in[I_F2U] : in[I_F1U];
            const float* W = (blk < 2 ? Wg : Wu) + (size_t)l * DM * DFF; const int sc = 128 * pn + 64 * (blk & 1);
            tr_item64(c, W, W, DFF, sc, sc + 32, c.wsb(second ? WS_WGU2 : WS_WGU1), DM, 64 * nb, 64 * kb, second ? 4 : 0, l, scr);
            continue;
        }
        r -= C0;
        if (r < C1) { const int kb = r / 16, nb = r % 16; const float* W = in[I_F1D] + (size_t)l * DFF * DM; tr_item64(c, W, W, DM, 64 * nb, 64 * nb + 32, c.wsb(WS_WD1), DFF, 64 * nb, 64 * kb, 1, l, scr); continue; }
        r -= C1;
        if (r < C2) { const int kb = r / 40, nb = r % 40, n0 = 64 * nb;
            const float* W = in[I_WIN] + (size_t)l * DM * 2464; int sc[2];
#pragma unroll
            for (int hh = 0; hh < 2; ++hh) { const int n = n0 + 32 * hh; sc[hh] = n < 1184 ? n : (n < 1280 ? -1 : n - 96); }
            tr_item64(c, W, W, 2464, sc[0], sc[1], c.wsb(WS_WIN), DM, n0, 64 * kb, 2, l, scr); continue; }
        r -= C2;
        if (r < C3) { const int kb = r / 16, nb = r % 16; const float* W = in[I_WOUT] + (size_t)l * DM * DM; tr_item64(c, W, W, DM, 64 * nb, 64 * nb + 32, c.wsb(WS_WOUT), DM, 64 * nb, 64 * kb, 3, l, scr); continue; }
        r -= C3; r -= C0;
        if (r < C1) { const int kb = r / 16, nb = r % 16; const float* W = in[I_F2D] + (size_t)l * DFF * DM; tr_item64(c, W, W, DM, 64 * nb, 64 * nb + 32, c.wsb(WS_WD2), DFF, 64 * nb, 64 * kb, 5, l, scr); continue; }
        r -= C1;
        if (r < C6) { const int kb = r / 6, nb = r % 6; const float* W = in[I_MLAWUQ] + (size_t)l * 256 * 384; tr_item64(c, W, W, 384, 64 * nb, 64 * nb + 32, c.wsb(WS_WUQ), 256, 64 * nb, 64 * kb, 6, l, scr); continue; }
        r -= C6;
        { const int kb = r / 8, nb = r % 8; const float* W = in[I_MLAWUKV] + (size_t)l * 128 * 512; tr_item64(c, W, W, 512, 64 * nb, 64 * nb + 32, c.wsb(WS_WUKV), 128, 64 * nb, 64 * kb, 7, l, scr); }
    }
}
__device__ __forceinline__ void prologue(const Ctx& c) {
    const int gt = c.bid * NTHREADS + c.tid, NGT = c.G * NTHREADS;
    for (int i = gt; i < SEQ * 16; i += NGT) {
        const int pos = i >> 4, fi = i & 15;
        const float inv = expf(-9.210340371976184f * (float)(2 * fi) / 32.0f);
        const float ang = (float)pos * inv;
        const double a = (double)ang * 0.15915494309189535;
        const double fr = a - rint(a);
        const float f = (float)fr;
        float2 cs; cs.x = __builtin_amdgcn_cosf(f); cs.y = __builtin_amdgcn_sinf(f);
        ((float2*)(c.kp->ws + WS_TAB))[i] = cs;
    }
    const int gw = c.bid * NWAVES + c.wave, NGW = c.G * NWAVES;
    const float* x = c.kp->in[I_X]; bf16_t* xb = c.wsb(WS_XB); float* ss0 = c.ss0();
    for (int row = gw; row < MROWS; row += NGW) {
        const f32x4* xr = (const f32x4*)(x + (size_t)row * DM) + c.lane; float s = 0.f;
#pragma unroll
        for (int j = 0; j < 4; ++j) { const f32x4 v = xr[64 * j]; s += (v[0] * v[0] + v[1] * v[1]) + (v[2] * v[2] + v[3] * v[3]);
            u32x2 w; w.x = pk2(v[0], v[1]); w.y = pk2(v[2], v[3]); *((u32x2*)(xb + (size_t)row * DM) + c.lane + 64 * j) = w; }
        s = wave_sum(s); if (c.lane == 0) ss0[row] = s;
    }
    wconv_layer(c, 0);
}

constexpr int PL_VS = 0, PL_CQ = 73728, PL_CKV = 107520, PL_KR = 124928, PL_RSQ = 133120, PL_RSKV = 133376;
__device__ __forceinline__ void vt_write(const Ctx& c, int slot0, int nh, bf16_t* Vbase, int kvh0, int tt) {
    const LAS bf16_t* VS = (const LAS bf16_t*)(c.lds + PL_VS);
    const int kc = c.tid >> 6, d = c.tid & 63;
    for (int h = 0; h < nh; ++h) {
        unsigned short e[8];
#pragma unroll
        for (int j = 0; j < 8; ++j) { const int key = 16 * (kc >> 1) + 8 * (j >> 2) + 4 * (kc & 1) + (j & 3); e[j] = VS[((slot0 + h) * 64 + key) * 72 + d]; }
        u32x4 o; o.x = e[0] | ((unsigned)e[1] << 16); o.y = e[2] | ((unsigned)e[3] << 16); o.z = e[4] | ((unsigned)e[5] << 16); o.w = e[6] | ((unsigned)e[7] << 16);
        *(u32x4*)(Vbase + ((size_t)(kvh0 + h) * NTILE + tt) * 4096 + (kc * 64 + d) * 8) = o;
    }
}
template <int LG>
__device__ __forceinline__ void norm8(const u32x4 raw, const float* g, float inv_n, float post, float* o) {
    float v[8]; unpack8(raw, v); float s = 0.f;
#pragma unroll
    for (int j = 0; j < 8; ++j) s += v[j] * v[j];
#pragma unroll
    for (int k = 0; k < LG; ++k) s += __shfl_xor(s, 1 << k);
    const float rs = (1.0f / sqrtf(s * inv_n + EPS)) * post;
#pragma unroll
    for (int j = 0; j < 8; ++j) o[j] = v[j] * rs * g[j];
}
__device__ __forceinline__ void prep_unit(const Ctx& c, int l, int T) {
    InPtr in = c.kp->in;
    const int tid = c.tid, tok = tid >> 3, sub = tid & 7, b = T >> 7, tt = T & 127, t = tt * 64 + tok;
    const bf16_t* prow = c.wsb(WS_R) + (size_t)(T * 64 + tok) * NIN;
    LAS bf16_t* VS = (LAS bf16_t*)(c.lds + PL_VS);
    LAS bf16_t* CQ = (LAS bf16_t*)(c.lds + PL_CQ);
    LAS bf16_t* CKV = (LAS bf16_t*)(c.lds + PL_CKV);
    LAS float* KR = (LAS float*)(c.lds + PL_KR);
    LAS float* RSQ = (LAS float*)(c.lds + PL_RSQ);
    LAS float* RSKV = (LAS float*)(c.lds + PL_RSKV);
    const float2* tab = (const float2*)(c.kp->ws + WS_TAB);
    u32x4 ra[12], rc[12], rd[8], rq[4], rkv[2], rkr = (u32x4){0u, 0u, 0u, 0u};
#pragma unroll
    for (int i = 0; i < 12; ++i) ra[i] = *(const u32x4*)(prow + i * 64 + sub * 8);
#pragma unroll
    for (int i = 0; i < 4; ++i) rq[i] = *(const u32x4*)(prow + 768 + 64 * i + 8 * sub);
#pragma unroll
    for (int i = 0; i < 2; ++i) rkv[i] = *(const u32x4*)(prow + 1024 + 64 * i + 8 * sub);
    if (sub < 4) rkr = *(const u32x4*)(prow + 1152 + 8 * sub);
    {
        float ssq = 0.f;
#pragma unroll
        for (int i = 0; i < 4; ++i) { float v[8]; unpack8(rq[i], v);
#pragma unroll
            for (int j = 0; j < 8; ++j) ssq += v[j] * v[j];
            *(LAS u32x4*)(CQ + tok * 264 + 64 * i + 8 * sub) = rq[i]; }
        ssq += __shfl_xor(ssq, 1); ssq += __shfl_xor(ssq, 2); ssq += __shfl_xor(ssq, 4);
        if (sub == 0) RSQ[tok] = 1.0f / sqrtf(ssq * (1.0f / 256.0f) + EPS);
        float ssk = 0.f;
#pragma unroll
        for (int i = 0; i < 2; ++i) { float v[8]; unpack8(rkv[i], v);
#pragma unroll
            for (int j = 0; j < 8; ++j) ssk += v[j] * v[j];
            *(LAS u32x4*)(CKV + tok * 136 + 64 * i + 8 * sub) = rkv[i]; }
        ssk += __shfl_xor(ssk, 1); ssk += __shfl_xor(ssk, 2); ssk += __shfl_xor(ssk, 4);
        if (sub == 0) RSKV[tok] = 1.0f / sqrtf(ssk * (1.0f / 128.0f) + EPS);
        if (sub < 4) { float v[8]; unpack8(rkr, v);
#pragma unroll
            for (int j = 0; j < 8; ++j) KR[tok * 32 + 8 * sub + j] = v[j]; }
    }
#pragma unroll
    for (int i = 0; i < 8; ++i) rd[i] = *(const u32x4*)(prow + 2048 + i * 64 + sub * 8);
    {
        const float* qg = in[I_NAQN] + l * 64 + sub * 8; const float* kg = in[I_NAKN] + l * 64 + sub * 8;
        bf16_t* QA = c.wsb(WS_QA); bf16_t* KA = c.wsb(WS_KA);
#pragma unroll
        for (int h = 0; h < 4; ++h) {
            float o[8];
            norm8<3>(ra[h], qg, 1.0f / 64.0f, 0.125f * LOG2E, o);
            *(u32x4*)(QA + ((size_t)(b * 4 + h) * SEQ + t) * 64 + sub * 8) = pack8(o);
            norm8<3>(ra[4 + h], kg, 1.0f / 64.0f, 1.0f, o);
            *(u32x4*)(KA + ((size_t)(b * 4 + h) * NTILE + tt) * 4096 + (sub * 64 + tok) * 8) = pack8(o);
            *(LAS u32x4*)(VS + (h * 64 + tok) * 72 + sub * 8) = ra[8 + h];
        }
    }
    {
        const float* qg = in[I_GQN] + l * 64 + sub * 8; const float* kg = in[I_GKN] + l * 64 + sub * 8;
        bf16_t* QD = c.wsb(WS_QD); bf16_t* KD = c.wsb(WS_KD);
        const int pos = (sub < 4) ? (t >> 6) : (t & 63); const bool first = (sub & 2) == 0;
        float cs_c[8], cs_s[8];
#pragma unroll
        for (int j = 0; j < 8; ++j) { const float2 cs = tab[pos * 16 + 8 * (sub & 1) + j]; cs_c[j] = cs.x; cs_s[j] = cs.y; }
#pragma unroll
        for (int h = 0; h < 6; ++h) {
            const bool isq = h < 4;
            float v[8], o[8];
            norm8<3>(rd[h], isq ? qg : kg, 1.0f / 64.0f, 1.0f, v);
            const float sc = isq ? 0.125f * LOG2E : 1.0f;
#pragma unroll
            for (int j = 0; j < 8; ++j) { const float pv = __shfl_xor(v[j], 2); o[j] = (first ? (v[j] * cs_c[j] - pv * cs_s[j]) : (pv * cs_s[j] + v[j] * cs_c[j])) * sc; }
            if (isq) *(u32x4*)(QD + ((size_t)(b * 4 + h) * SEQ + t) * 64 + sub * 8) = pack8(o);
            else *(u32x4*)(KD + ((size_t)(b * 2 + (h - 4)) * NTILE + tt) * 4096 + (sub * 64 + tok) * 8) = pack8(o);
        }
#pragma unroll
        for (int h = 0; h < 2; ++h) *(LAS u32x4*)(VS + ((4 + h) * 64 + tok) * 72 + sub * 8) = rd[6 + h];
    }
#pragma unroll
    for (int i = 0; i < 12; ++i) rc[i] = *(const u32x4*)(prow + 1280 + i * 64 + sub * 8);
    __syncthreads();
    vt_write(c, 0, 4, c.wsb(WS_VA), b * 4, tt);
    vt_write(c, 4, 2, c.wsb(WS_VD), b * 2, tt);
    __syncthreads();
    {
        const float* qg = in[I_DQN] + l * 32 + (sub & 3) * 8; const float* kg = in[I_DKN] + l * 32 + (sub & 3) * 8;
        bf16_t* QC = c.wsb(WS_QC); bf16_t* KC = c.wsb(WS_KC);
#pragma unroll
        for (int h = 0; h < 4; ++h) {
            float o[8];
            norm8<2>(rc[h], qg, 1.0f / 32.0f, 0.17677669529663687f * LOG2E, o);
            *(u32x4*)(QC + ((size_t)(b * 4 + h) * SEQ + t) * 64 + sub * 8) = pack8(o);
            norm8<2>(rc[4 + h], kg, 1.0f / 32.0f, 1.0f, o);
            *(u32x4*)(KC + ((size_t)(b * 4 + h) * NTILE + tt) * 4096 + (sub * 64 + tok) * 8) = pack8(o);
            *(LAS u32x4*)(VS + (h * 64 + tok) * 72 + sub * 8) = rc[8 + h];
        }
    }
    asm volatile("" ::: "memory"); __builtin_amdgcn_sched_barrier(0);
    {
        const int lane = c.lane, l15 = lane & 15, fq = lane >> 4;
        if (c.wave < 4) {
            const int h = c.wave, bh = b * 4 + h; const bf16_t* Wuq = c.wsb(WS_WUQ) + (size_t)(h * 96 + l15) * 256 + 8 * fq;
            f32x4 acc[4][6];
#pragma unroll
            for (int mt = 0; mt < 4; ++mt)
#pragma unroll
                for (int nt = 0; nt < 6; ++nt) acc[mt][nt] = (f32x4){0.f, 0.f, 0.f, 0.f};
#pragma unroll 2
            for (int ks = 0; ks < 8; ++ks) {
                bf16x8 af[6], bfr[4];
#pragma unroll
                for (int nt = 0; nt < 6; ++nt) af[nt] = *(const bf16x8*)(Wuq + (size_t)(16 * nt) * 256 + 32 * ks);
#pragma unroll
                for (int mt = 0; mt < 4; ++mt) bfr[mt] = *(const LAS bf16x8*)(CQ + (16 * mt + l15) * 264 + 32 * ks + 8 * fq);
#pragma unroll
                for (int mt = 0; mt < 4; ++mt)
#pragma unroll
                    for (int nt = 0; nt < 6; ++nt) acc[mt][nt] = __builtin_amdgcn_mfma_f32_16x16x32_bf16(af[nt], bfr[mt], acc[mt][nt], 0, 0, 0);
            }
            asm volatile("" ::: "memory"); __builtin_amdgcn_sched_barrier(0);
            const float* gq = in[I_MLAQN] + l * 96 + 4 * fq; const float sc = 0.10206207261596577f * LOG2E;
#pragma unroll
            for (int mt = 0; mt < 4; ++mt) {
                const int tokl = 16 * mt + l15, tq = tt * 64 + tokl;
                const float rsq = RSQ[tokl]; float s = 0.f;
#pragma unroll
                for (int nt = 0; nt < 6; ++nt) { acc[mt][nt] = acc[mt][nt] * rsq; s += (acc[mt][nt][0] * acc[mt][nt][0] + acc[mt][nt][1] * acc[mt][nt][1]) + (acc[mt][nt][2] * acc[mt][nt][2] + acc[mt][nt][3] * acc[mt][nt][3]); }
                s += __shfl_xor(s, 16); s += __shfl_xor(s, 32);
                const float rh = 1.0f / sqrtf(s * (1.0f / 96.0f) + EPS);
#pragma unroll
                for (int nt = 0; nt < 6; ++nt) { const f32x4 g = *(const f32x4*)(gq + 16 * nt); acc[mt][nt] = acc[mt][nt] * g * rh; }
#pragma unroll
                for (int r = 0; r < 4; ++r) { const float2 cs = tab[tq * 16 + 4 * fq + r]; const float x1 = acc[mt][4][r], x2 = acc[mt][5][r]; acc[mt][4][r] = x1 * cs.x - x2 * cs.y; acc[mt][5][r] = x1 * cs.y + x2 * cs.x; }
                bf16_t* qo = c.wsb(WS_QB) + ((size_t)bh * SEQ + tq) * 96 + 4 * fq;
#pragma unroll
                for (int nt = 0; nt < 6; ++nt) { u32x2 w; w.x = pk2(acc[mt][nt][0] * sc, acc[mt][nt][1] * sc); w.y = pk2(acc[mt][nt][2] * sc, acc[mt][nt][3] * sc); *(u32x2*)(qo + 16 * nt) = w; }
                asm volatile("" ::: "memory"); __builtin_amdgcn_sched_barrier(0);
            }
        } else {
            const int h = c.wave - 4, bh = b * 4 + h; const bf16_t* Wukv = c.wsb(WS_WUKV) + (size_t)(h * 128 + l15) * 128 + 8 * fq;
            const float* gk = in[I_MLAKN] + l * 96 + 4 * fq;
#pragma unroll
            for (int half = 0; half < 2; ++half) {
                f32x4 acc[4][4];
#pragma unroll
                for (int mt = 0; mt < 4; ++mt)
#pragma unroll
                    for (int nt = 0; nt < 4; ++nt) acc[mt][nt] = (f32x4){0.f, 0.f, 0.f, 0.f};
#pragma unroll 2
                for (int ks = 0; ks < 4; ++ks) {
                    bf16x8 af[4], bfr[4];
#pragma unroll
                    for (int nt = 0; nt < 4; ++nt) af[nt] = *(const bf16x8*)(Wukv + (size_t)(64 * half + 16 * nt) * 128 + 32 * ks);
#pragma unroll
                    for (int mt = 0; mt < 4; ++mt) bfr[mt] = *(const LAS bf16x8*)(CKV + (16 * mt + l15) * 136 + 32 * ks + 8 * fq);
#pragma unroll
                    for (int mt = 0; mt < 4; ++mt)
#pragma unroll
                        for (int nt = 0; nt < 4; ++nt) acc[mt][nt] = __builtin_amdgcn_mfma_f32_16x16x32_bf16(af[nt], bfr[mt], acc[mt][nt], 0, 0, 0);
                }
                asm volatile("" ::: "memory"); __builtin_amdgcn_sched_barrier(0);
#pragma unroll
                for (int mt = 0; mt < 4; ++mt) {
                    const int tokl = 16 * mt + l15, tq = tt * 64 + tokl;
                    const float rskv = RSKV[tokl];
#pragma unroll
                    for (int nt = 0; nt < 4; ++nt) acc[mt][nt] = acc[mt][nt] * rskv;
                    if (half == 0) {
                        f32x4 kr1 = *(const LAS f32x4*)(KR + tokl * 32 + 4 * fq), kr2 = *(const LAS f32x4*)(KR + tokl * 32 + 16 + 4 * fq);
                        float s = (kr1[0] * kr1[0] + kr1[1] * kr1[1]) + (kr1[2] * kr1[2] + kr1[3] * kr1[3]) + (kr2[0] * kr2[0] + kr2[1] * kr2[1]) + (kr2[2] * kr2[2] + kr2[3] * kr2[3]);
#pragma unroll
                        for (int nt = 0; nt < 4; ++nt) s += (acc[mt][nt][0] * acc[mt][nt][0] + acc[mt][nt][1] * acc[mt][nt][1]) + (acc[mt][nt][2] * acc[mt][nt][2] + acc[mt][nt][3] * acc[mt][nt][3]);
                        s += __shfl_xor(s, 16); s += __shfl_xor(s, 32);
                        const float rh = 1.0f / sqrtf(s * (1.0f / 96.0f) + EPS);
#pragma unroll
                        for (int nt = 0; nt < 4; ++nt) { const f32x4 g = *(const f32x4*)(gk + 16 * nt); acc[mt][nt] = acc[mt][nt] * g * rh; }
                        kr1 = kr1 * *(const f32x4*)(gk + 64) * rh; kr2 = kr2 * *(const f32x4*)(gk + 80) * rh;
#pragma unroll
                        for (int r = 0; r < 4; ++r) { const float2 cs = tab[tq * 16 + 4 * fq + r]; const float x1 = kr1[r], x2 = kr2[r]; kr1[r] = x1 * cs.x - x2 * cs.y; kr2[r] = x1 * cs.y + x2 * cs.x; }
                        bf16_t* kt = c.wsb(WS_KB) + ((size_t)bh * NTILE + tt) * 6144 + tokl * 8 + (fq & 1) * 4;
#pragma unroll
                        for (int nt = 0; nt < 4; ++nt) { u32x2 w; w.x = pk2(acc[mt][nt][0], acc[mt][nt][1]); w.y = pk2(acc[mt][nt][2], acc[mt][nt][3]); *(u32x2*)(kt + (2 * nt + (fq >> 1)) * 512) = w; }
                        { u32x2 w; w.x = pk2(kr1[0], kr1[1]); w.y = pk2(kr1[2], kr1[3]); *(u32x2*)(kt + (8 + (fq >> 1)) * 512) = w;
                          w.x = pk2(kr2[0], kr2[1]); w.y = pk2(kr2[2], kr2[3]); *(u32x2*)(kt + (10 + (fq >> 1)) * 512) = w; }
                    } else {
#pragma unroll
                        for (int nt = 0; nt < 4; ++nt) { u32x2 w; w.x = pk2(acc[mt][nt][0], acc[mt][nt][1]); w.y = pk2(acc[mt][nt][2], acc[mt][nt][3]); *(LAS u32x2*)(VS + ((4 + h) * 64 + tokl) * 72 + 16 * nt + 4 * fq) = w; }
                    }
                    asm volatile("" ::: "memory"); __builtin_amdgcn_sched_barrier(0);
                }
            }
        }
    }
    __syncthreads();
    vt_write(c, 0, 4, c.wsb(WS_VC), b * 4, tt);
    vt_write(c, 4, 4, c.wsb(WS_VB), b * 4, tt);
    __syncthreads();
}

namespace att {
constexpr int SLOT_K = 12288, SLOT = 20480, LUT_OFF = 69632, PARK_OFF = 73728;
struct Args { const bf16_t* Q; const bf16_t* K; const bf16_t* V; bf16_t* Y; int ycol, kv_shift, nkvh; const float* lut_src; const float* lam_src; float lam_init; const float* gq; const float* gk; int ng; float sqrtd; };
__device__ __forceinline__ int crow(int r, int hi) { return (r & 3) + 8 * (r >> 2) + 4 * hi; }
__device__ __forceinline__ int iclamp(int v, int lo, int hi) { return v < lo ? lo : (v > hi ? hi : v); }
__device__ __forceinline__ void glds16(const bf16_t* src, LAS unsigned char* dst) { __builtin_amdgcn_global_load_lds((const unsigned*)src, (LAS unsigned*)dst, 16, 0, 0); }

__device__ __forceinline__ float max2f(float a, float b) { return __builtin_amdgcn_fmed3f(a, b, __builtin_inff()); }
template <int MODE, int DQK>
__device__ __forceinline__ void unit(const Args& a, int bh, int qb, LAS unsigned char* lds, const int tid) {
    constexpr int NQF = DQK / 16, NMAP = (MODE == 1) ? 2 : 1, FPM = NQF / NMAP, NKP = DQK / 8, NP = NKP + 8, NPW = (NP + 7) / 8, KT_ELEMS = DQK * 64;
    constexpr float THR = 5.0f;
    const int lane = tid & 63, r32 = lane & 31, hi = lane >> 5, w = __builtin_amdgcn_readfirstlane(tid >> 6);
    const int b = bh >> 2, h = bh & 3, kvh = b * a.nkvh + (h >> a.kv_shift);
    const int qrow = qb * 256 + 32 * w + r32;
    int t_lo = 0, t_hi = NTILE, my_lo = 0, my_hi = NTILE, myr = 0;
    if (MODE == 2) { const int r0 = qb * 4; t_lo = iclamp(r0 - 4, 0, 120); t_hi = iclamp(r0 + 3 - 4, 0, 120) + 8; myr = r0 + (w >> 1); my_lo = iclamp(myr - 4, 0, 120); my_hi = my_lo + 8; }
    const int NT = t_hi - t_lo;
    LAS float* lut = (LAS float*)(lds + LUT_OFF);
    if (MODE == 1) {
        for (int i = tid; i < 257; i += NTHREADS) { const int rel = i - 128, n = rel < 0 ? -rel : rel;
            int large = 8 + (int)(logf((float)(n < 1 ? 1 : n) / 8.0f) / 2.772588722239781f * 8.0f); large = large > 15 ? 15 : large;
            const int bucket = (rel > 0 ? 16 : 0) + (n < 8 ? n : large);
            lut[i] = a.lut_src[bucket * 4 + h] * LOG2E; }
    }
    if (MODE == 2) { for (int i = tid; i < 465; i += NTHREADS) lut[i] = a.lut_src[h * 465 + i] * LOG2E; }
    bf16x8 qf[NQF];
    { const bf16_t* qp = a.Q + ((size_t)bh * SEQ + qrow) * DQK + 8 * hi;
#pragma unroll
      for (int d0 = 0; d0 < NQF; ++d0) qf[d0] = *(const bf16x8*)(qp + 16 * d0); }
    float mrun[NMAP], lrun[NMAP]; f32x16 o[NMAP][2]; f32x16 negm = f32x16{};
#pragma unroll
    for (int mp = 0; mp < NMAP; ++mp) { mrun[mp] = 0.f; lrun[mp] = 0.f; o[mp][0] = f32x16{}; o[mp][1] = f32x16{}; }
    bool started = false;
    const bf16_t* Kt = a.K + (size_t)kvh * NTILE * KT_ELEMS; const bf16_t* Vt = a.V + (size_t)kvh * NTILE * 4096;
#define ATT_ISSUE(t, slot) do { _Pragma("unroll") for (int j_ = 0; j_ < NPW; ++j_) { int p_ = w + 8 * j_; if (p_ >= NP) p_ -= 8; \
        if (p_ < NKP) glds16(Kt + (size_t)(t) * KT_ELEMS + p_ * 512 + lane * 8, lds + (slot) * SLOT + p_ * 1024); \
        else glds16(Vt + (size_t)(t) * 4096 + (p_ - NKP) * 512 + lane * 8, lds + (slot) * SLOT + SLOT_K + (p_ - NKP) * 1024); } } while (0)
    ATT_ISSUE(t_lo, 0);
    if (NT > 1) ATT_ISSUE(t_lo + 1, 1);
    int slot = 0;
    for (int i = 0; i < NT; ++i) {
        if (i + 1 < NT) { if constexpr (NPW == 2) asm volatile("s_waitcnt vmcnt(2)" ::: "memory"); else asm volatile("s_waitcnt vmcnt(3)" ::: "memory"); }
        else asm volatile("s_waitcnt vmcnt(0)" ::: "memory");
        asm volatile("s_waitcnt lgkmcnt(0)" ::: "memory"); __builtin_amdgcn_s_barrier(); asm volatile("" ::: "memory");
        if (i + 2 < NT) { const int s2 = slot >= 1 ? slot - 1 : 2; ATT_ISSUE(t_lo + i + 2, s2); }
        const int t = t_lo + i;
        if (MODE != 2 || (t >= my_lo && t < my_hi)) {
            const LAS unsigned char* ks = lds + slot * SLOT + hi * 1024 + r32 * 16;
            const LAS unsigned char* vs = lds + slot * SLOT + SLOT_K + hi * 1024 + r32 * 16;
#pragma unroll
            for (int mp = 0; mp < NMAP; ++mp) {
                bf16x8 kf[2 * FPM];
#pragma unroll
                for (int d = 0; d < FPM; ++d) { const int d0 = mp * FPM + d; kf[2 * d] = *(const LAS bf16x8*)(ks + d0 * 2048); kf[2 * d + 1] = *(const LAS bf16x8*)(ks + d0 * 2048 + 512); }
                f32x16 c0, c1; const float mneg = -mrun[mp];
                if (MODE == 0) { c0 = negm; c1 = negm; }
                if (MODE == 1) {
                    const int qw0 = qb * 256 + 32 * w, d_lo = 64 * t - (qw0 + 31), d_hi = 64 * t + 63 - qw0;
                    if (d_hi <= -128 || d_lo >= 128) { const float v = lut[d_lo >= 128 ? 256 : 0] + mneg;
#pragma unroll
                        for (int r = 0; r < 16; ++r) c0[r] = v;
                        c1 = c0; }
                    else {
#pragma unroll
                        for (int r = 0; r < 16; ++r) { const int rel = 64 * t + crow(r, hi) - qrow; c0[r] = lut[iclamp(rel, -128, 128) + 128] + mneg; c1[r] = lut[iclamp(rel + 32, -128, 128) + 128] + mneg; } }
                }
                if (MODE == 2) {
                    const int qc = 32 * (w & 1) + r32, qs = iclamp(qc - 8, 0, 48), dr = t - myr + 7;
#pragma unroll
                    for (int r = 0; r < 16; ++r) { const int kc = crow(r, hi), kc2 = kc + 32;
                        const bool v1 = (kc >= qs) && (kc < qs + 16), v2 = (kc2 >= qs) && (kc2 < qs + 16);
                        c0[r] = v1 ? lut[dr * 31 + (kc - qc + 15)] + mneg : -1e30f; c1[r] = v2 ? lut[dr * 31 + (kc2 - qc + 15)] + mneg : -1e30f; }
                }
                __builtin_amdgcn_sched_barrier(0);
                f32x16 p0 = __builtin_amdgcn_mfma_f32_32x32x16_bf16(kf[0], qf[mp * FPM], c0, 0, 0, 0);
                f32x16 p1 = __builtin_amdgcn_mfma_f32_32x32x16_bf16(kf[1], qf[mp * FPM], c1, 0, 0, 0);
#pragma unroll
                for (int d = 1; d < FPM; ++d) { p0 = __builtin_amdgcn_mfma_f32_32x32x16_bf16(kf[2 * d], qf[mp * FPM + d], p0, 0, 0, 0); p1 = __builtin_amdgcn_mfma_f32_32x32x16_bf16(kf[2 * d + 1], qf[mp * FPM + d], p1, 0, 0, 0); }
                bf16x8 vf[8];
#pragma unroll
                for (int q8 = 0; q8 < 8; ++q8) vf[q8] = *(const LAS bf16x8*)(vs + (q8 & 3) * 2048 + (q8 >> 2) * 512);
                __builtin_amdgcn_sched_barrier(0);
                float ma = max2f(p0[0], p1[0]), mb = max2f(p0[1], p1[1]);
#pragma unroll
                for (int r = 2; r < 16; r += 2) { ma = max2f(ma, max2f(p0[r], p1[r])); mb = max2f(mb, max2f(p0[r + 1], p1[r + 1])); }
                float rm = max2f(ma, mb);
                { auto rr = __builtin_amdgcn_permlane32_swap(__float_as_uint(rm), __float_as_uint(rm), false, false); rm = max2f(__uint_as_float(rr[0]), __uint_as_float(rr[1])); }
                if (!started || __any(rm > THR)) {
                    const float dl = started ? fmaxf(rm, 0.f) : rm;
                    mrun[mp] += dl;
#pragma unroll
                    for (int r = 0; r < 16; ++r) { p0[r] -= dl; p1[r] -= dl; }
                    const float alpha = __builtin_amdgcn_exp2f(-dl);
                    lrun[mp] *= alpha; o[mp][0] = o[mp][0] * alpha; o[mp][1] = o[mp][1] * alpha;
                    if (MODE == 0) {
#pragma unroll
                        for (int r = 0; r < 16; ++r) negm[r] = -mrun[mp];
                    }
                }
                float rs0 = 0.f, rs1 = 0.f;
#pragma unroll
                for (int r = 0; r < 16; ++r) { p0[r] = __builtin_amdgcn_exp2f(p0[r]); p1[r] = __builtin_amdgcn_exp2f(p1[r]); rs0 += p0[r]; rs1 += p1[r]; }
                lrun[mp] += rs0 + rs1;
                u32x4 pw[4];
#pragma unroll
                for (int j = 0; j < 4; ++j) { pw[0][j] = pk2(p0[2 * j], p0[2 * j + 1]); pw[1][j] = pk2(p0[8 + 2 * j], p0[9 + 2 * j]); pw[2][j] = pk2(p1[2 * j], p1[2 * j + 1]); pw[3][j] = pk2(p1[8 + 2 * j], p1[9 + 2 * j]); }
#pragma unroll
                for (int k4 = 0; k4 < 4; ++k4) {
                    o[mp][0] = __builtin_amdgcn_mfma_f32_32x32x16_bf16(vf[k4], __builtin_bit_cast(bf16x8, pw[k4]), o[mp][0], 0, 0, 0);
                    o[mp][1] = __builtin_amdgcn_mfma_f32_32x32x16_bf16(vf[4 + k4], __builtin_bit_cast(bf16x8, pw[k4]), o[mp][1], 0, 0, 0); }
            }
            started = true;
        }
        slot = slot == 2 ? 0 : slot + 1;
    }
#undef ATT_ISSUE
#pragma unroll
    for (int mp = 0; mp < NMAP; ++mp) lrun[mp] += __shfl_xor(lrun[mp], 32);
    f32x16 val[2];
    if (MODE == 1) {
        float s1 = 0.f, s2 = 0.f;
        for (int i = 0; i < 32; ++i) { s1 += a.lam_src[i] * a.lam_src[32 + i]; s2 += a.lam_src[64 + i] * a.lam_src[96 + i]; }
        const float lam = expf(s1) - expf(s2) + a.lam_init;
        const float i0 = 1.0f / lrun[0], i1 = lam / lrun[NMAP - 1];
        val[0] = o[0][0] * i0 - o[NMAP - 1][0] * i1; val[1] = o[0][1] * i0 - o[NMAP - 1][1] * i1;
        float s = 0.f;
#pragma unroll
        for (int r = 0; r < 16; ++r) s += val[0][r] * val[0][r] + val[1][r] * val[1][r];
        s += __shfl_xor(s, 32);
        const float rn = 1.0f / sqrtf(s * (1.0f / 64.0f) + EPS);
        val[0] = val[0] * rn; val[1] = val[1] * rn;
    } else { const float i0 = 1.0f / lrun[0]; val[0] = o[0][0] * i0; val[1] = o[0][1] * i0; }
    bf16_t* yp = a.Y + ((size_t)(b * SEQ + qrow)) * DM + a.ycol + h * 64 + 4 * hi;
#pragma unroll
    for (int db = 0; db < 2; ++db)
#pragma unroll
        for (int g = 0; g < 4; ++g) { u32x2 wv; wv.x = pk2(val[db][4 * g], val[db][4 * g + 1]); wv.y = pk2(val[db][4 * g + 2], val[db][4 * g + 3]); *(u32x2*)(yp + 32 * db + 8 * g) = wv; }
    asm volatile("s_waitcnt lgkmcnt(0)" ::: "memory"); __builtin_amdgcn_s_barrier(); asm volatile("" ::: "memory");
}

#define ATT_WAITV(n) asm volatile("s_waitcnt vmcnt(" #n ") lgkmcnt(0)\n\ts_barrier" ::: "memory")
__device__ __forceinline__ void wait_bar_n(int n) {
    if (n == 0) ATT_WAITV(0); else if (n == 1) ATT_WAITV(1); else if (n == 2) ATT_WAITV(2); else if (n == 3) ATT_WAITV(3); else ATT_WAITV(4);
}
template <int DQK> struct PipeCfg {
    static constexpr int KSLOT = DQK * 128, VSLOT = 8192, KRING = 0, VRING = 3 * KSLOT, NKP = DQK / 8, NKW = (NKP + 7) / 8, KT_ELEMS = DQK * 64;
};
struct PipeState { float mrun, lrun, cb; f32x16 negm; };
__device__ __forceinline__ void bias_tile(f32x16& C0, f32x16& C1, const LAS float* lut, int t, int qrow, int hi, float mrun) {
#pragma unroll
    for (int r = 0; r < 16; ++r) { const int rel = 64 * t + crow(r, hi) - qrow; C0[r] = lut[iclamp(rel, -128, 128) + 128] - mrun; C1[r] = lut[iclamp(rel + 32, -128, 128) + 128] - mrun; }
}
template <int DQK, int F0, int NF, bool BIAS, bool NOMAX>
__device__ __forceinline__ void pipe_step(int t, f32x16& C0, f32x16& C1, f32x16& P0, f32x16& P1, f32x16 (&o)[2], bf16x8 (&kf)[2 * NF], const bf16x8 (&qf)[NF],
                                          PipeState& st, LAS unsigned char* lds, const bf16_t* Kt, const bf16_t* Vt, int lane, int w, int frag_off,
                                          const LAS float* lut, int qw0, int qrow, int hi, float cL, float cR) {
    typedef PipeCfg<DQK> Cf;
    constexpr int NKF = 2 * NF, NT = NTILE, GPG = (8 + NKF - 1) / NKF;
    constexpr float THR = 5.0f;
    const int sv_prev = (t - 1) & 3, sk_next = (t + 1) % 3;
    const LAS unsigned char* vs = lds + Cf::VRING + sv_prev * Cf::VSLOT + frag_off;
    const LAS unsigned char* kn = lds + Cf::KRING + sk_next * Cf::KSLOT + frag_off + F0 * 2048;
    bf16x8 vf[8]; u32x4 pw[4]; float sacc = 0.f;
    bool near = false;
    if (BIAS) {
        const int d_lo = 64 * t - (qw0 + 31), d_hi = 64 * t + 63 - qw0;
        near = !(d_hi <= -128 || d_lo >= 128);
        if (!near) { const float ct = d_lo >= 128 ? cR : cL;
            if (ct != st.cb) { st.cb = ct;
#pragma unroll
                for (int r = 0; r < 16; ++r) st.negm[r] = ct - st.mrun; } }
    }
    __builtin_amdgcn_sched_barrier(0);
#pragma unroll
    for (int g = 0; g < NKF; ++g) {
        if (g >= NKF - 4) { const int q8 = g - (NKF - 4); vf[q8] = *(const LAS bf16x8*)(vs + q8 * 2048); }
        __builtin_amdgcn_sched_barrier(0);
        const int d = g >> 1;
        if (d == 0) {
            if ((g & 1) == 0) C0 = __builtin_amdgcn_mfma_f32_32x32x16_bf16(kf[g], qf[d], st.negm, 0, 0, 0); else C1 = __builtin_amdgcn_mfma_f32_32x32x16_bf16(kf[g], qf[d], st.negm, 0, 0, 0);
        } else { if ((g & 1) == 0) C0 = __builtin_amdgcn_mfma_f32_32x32x16_bf16(kf[g], qf[d], C0, 0, 0, 0); else C1 = __builtin_amdgcn_mfma_f32_32x32x16_bf16(kf[g], qf[d], C1, 0, 0, 0); }
#pragma unroll
        for (int gg = 0; gg < GPG; ++gg) { const int grp = g * GPG + gg;
            if (grp < 8) {
                if (grp < 4) { sacc += (P0[4 * grp] + P0[4 * grp + 1]) + (P0[4 * grp + 2] + P0[4 * grp + 3]); pw[grp >> 1][2 * (grp & 1)] = pk2(P0[4 * grp], P0[4 * grp + 1]); pw[grp >> 1][2 * (grp & 1) + 1] = pk2(P0[4 * grp + 2], P0[4 * grp + 3]); }
                else { const int e = 4 * (grp - 4); sacc += (P1[e] + P1[e + 1]) + (P1[e + 2] + P1[e + 3]); pw[grp >> 1][2 * (grp & 1)] = pk2(P1[e], P1[e + 1]); pw[grp >> 1][2 * (grp & 1) + 1] = pk2(P1[e + 2], P1[e + 3]); }
                asm volatile("" : "+v"(sacc)); asm volatile("" : "+v"(pw[grp >> 1]));
            } }
        __builtin_amdgcn_sched_barrier(0);
    }
    st.lrun += sacc;
    if (BIAS && near) {
#pragma unroll
        for (int r = 0; r < 16; ++r) { const int rel = 64 * t + crow(r, hi) - qrow; C0[r] += lut[iclamp(rel, -128, 128) + 128] - st.cb; C1[r] += lut[iclamp(rel + 32, -128, 128) + 128] - st.cb; }
    }
    if (t + 3 < NT) {
#pragma unroll
        for (int j = 0; j < Cf::NKW; ++j) { int p = w + 8 * j; if (p >= Cf::NKP) p -= 8;
            glds16(Kt + (size_t)(t + 3) * Cf::KT_ELEMS + p * 512 + lane * 8, lds + Cf::KRING + (t % 3) * Cf::KSLOT + p * 1024); }
    }
    if (t + 2 < NT) glds16(Vt + (size_t)(t + 2) * 4096 + w * 512 + lane * 8, lds + Cf::VRING + ((t + 2) & 3) * Cf::VSLOT + w * 1024);
    float alpha = 1.0f; bool resc = false;
    if (!NOMAX) {
        int ia = max(max(__float_as_int(C0[0]), __float_as_int(C0[1])), __float_as_int(C1[0])), ib = max(max(__float_as_int(C0[2]), __float_as_int(C0[3])), __float_as_int(C1[1]));
        ia = max(max(ia, __float_as_int(C1[2])), __float_as_int(C1[3]));
#pragma unroll
        for (int r = 4; r < 16; r += 4) { ia = max(max(ia, __float_as_int(C0[r])), __float_as_int(C0[r + 1])); ib = max(max(ib, __float_as_int(C0[r + 2])), __float_as_int(C0[r + 3]));
            ia = max(max(ia, __float_as_int(C1[r])), __float_as_int(C1[r + 1])); ib = max(max(ib, __float_as_int(C1[r + 2])), __float_as_int(C1[r + 3])); }
        int im = max(ia, ib);
        { auto rr = __builtin_amdgcn_permlane32_swap((unsigned)im, (unsigned)im, false, false); im = max((int)rr[0], (int)rr[1]); }
        if (__builtin_expect(__any(im > __float_as_int(THR)), 0)) {
            const float rm = __int_as_float(im), dl = rm > 0.f ? rm : 0.f;
            st.mrun += dl;
#pragma unroll
            for (int r = 0; r < 16; ++r) { C0[r] -= dl; C1[r] -= dl; }
#pragma unroll
            for (int r = 0; r < 16; ++r) st.negm[r] = st.cb - st.mrun;
            alpha = __builtin_amdgcn_exp2f(-dl); st.lrun *= alpha; resc = true;
        }
    }
    __builtin_amdgcn_sched_barrier(0);
#pragma unroll
    for (int g = 0; g < 8; ++g) {
        if (t + 1 < NT) {
            constexpr int G0 = (NKF >= 12) ? 1 : 2;
            if (g >= G0 && 2 * (g - G0) < NKF) { const int f = g - G0; kf[2 * f] = *(const LAS bf16x8*)(kn + f * 2048); kf[2 * f + 1] = *(const LAS bf16x8*)(kn + f * 2048 + 512); }
        }
        if (g < 2) { vf[4 + 2 * g] = *(const LAS bf16x8*)(vs + (2 * g) * 2048 + 512); vf[5 + 2 * g] = *(const LAS bf16x8*)(vs + (2 * g + 1) * 2048 + 512); }
        __builtin_amdgcn_sched_barrier(0);
        const int k4 = g & 3, db = g >> 2;
        o[db] = __builtin_amdgcn_mfma_f32_32x32x16_bf16(vf[g], __builtin_bit_cast(bf16x8, pw[k4]), o[db], 0, 0, 0);
        if (g < 4) {
#pragma unroll
            for (int e = 0; e < 4; ++e) C0[4 * g + e] = __builtin_amdgcn_exp2f(C0[4 * g + e]);
        } else {
#pragma unroll
            for (int e = 0; e < 4; ++e) C1[4 * (g - 4) + e] = __builtin_amdgcn_exp2f(C1[4 * (g - 4) + e]);
        }
        if (g < 4) asm volatile("" : "+v"(C0)); else asm volatile("" : "+v"(C1));
        __builtin_amdgcn_sched_barrier(0);
    }
    wait_bar_n((t + 1 < NT ? 1 : 0) + (t + 3 < NT ? Cf::NKW : 0) + (t + 2 < NT ? 1 : 0));
    if (resc) { o[0] = o[0] * alpha; o[1] = o[1] * alpha; }
}
template <int DQK, int F0, int NF, bool BIAS, bool NOMAX>
__device__ __forceinline__ void pipe_run(const Args& a, int bh, int qb, LAS unsigned char* lds, const int tid, f32x16 (&o)[2], float& lsum) {
    typedef PipeCfg<DQK> Cf;
    constexpr int NKF = 2 * NF, NT = NTILE;
    const int lane = tid & 63, r32 = lane & 31, hi = lane >> 5, w = __builtin_amdgcn_readfirstlane(tid >> 6);
    const int b = bh >> 2, h = bh & 3, kvh = b * a.nkvh + (h >> a.kv_shift);
    const int qw0 = qb * 256 + 32 * w, qrow = qw0 + r32, frag_off = hi * 1024 + r32 * 16;
    const bf16_t* Kt = a.K + (size_t)kvh * NTILE * Cf::KT_ELEMS; const bf16_t* Vt = a.V + (size_t)kvh * NTILE * 4096;
    const LAS float* lut = (const LAS float*)(lds + LUT_OFF);
#define PIPE_DMA_K(t, slot) do { _Pragma("unroll") for (int j_ = 0; j_ < Cf::NKW; ++j_) { int p_ = w + 8 * j_; if (p_ >= Cf::NKP) p_ -= 8; \
        glds16(Kt + (size_t)(t) * Cf::KT_ELEMS + p_ * 512 + lane * 8, lds + Cf::KRING + (slot) * Cf::KSLOT + p_ * 1024); } } while (0)
#define PIPE_DMA_V(t, slot) glds16(Vt + (size_t)(t) * 4096 + w * 512 + lane * 8, lds + Cf::VRING + (slot) * Cf::VSLOT + w * 1024)
    PIPE_DMA_K(0, 0); PIPE_DMA_V(0, 0); PIPE_DMA_K(1, 1); PIPE_DMA_V(1, 1); PIPE_DMA_K(2, 2);
    bf16x8 qf[NF];
    { const bf16_t* qp = a.Q + ((size_t)bh * SEQ + qrow) * DQK + 8 * hi + 16 * F0;
#pragma unroll
      for (int d0 = 0; d0 < NF; ++d0) qf[d0] = *(const bf16x8*)(qp + 16 * d0); }
    PipeState st; st.mrun = 0.f; st.lrun = 0.f; st.cb = 0.f; st.negm = f32x16{};
    o[0] = f32x16{}; o[1] = f32x16{};
    f32x16 pA0, pA1, pB0, pB1; bf16x8 kf[NKF];
    if (Cf::NKW == 1) ATT_WAITV(4); else asm volatile("s_waitcnt vmcnt(6) lgkmcnt(0)\n\ts_barrier" ::: "memory");
    float cL = 0.f, cR = 0.f;
    if (BIAS) { cL = __int_as_float(__builtin_amdgcn_readfirstlane(__float_as_int(lut[0]))); cR = __int_as_float(__builtin_amdgcn_readfirstlane(__float_as_int(lut[256]))); }
    {
        const LAS unsigned char* k0 = lds + Cf::KRING + frag_off + F0 * 2048;
#pragma unroll
        for (int g = 0; g < NKF; ++g) kf[g] = *(const LAS bf16x8*)(k0 + (g >> 1) * 2048 + (g & 1) * 512);
        pA0 = f32x16{}; pA1 = f32x16{};
        if (BIAS) bias_tile(pA0, pA1, lut, 0, qrow, hi, 0.f);
#pragma unroll
        for (int d = 0; d < NF; ++d) { pA0 = __builtin_amdgcn_mfma_f32_32x32x16_bf16(kf[2 * d], qf[d], pA0, 0, 0, 0); pA1 = __builtin_amdgcn_mfma_f32_32x32x16_bf16(kf[2 * d + 1], qf[d], pA1, 0, 0, 0); }
        float rm = 0.f;
        if (!NOMAX) {
            rm = fmaxf(pA0[0], pA1[0]);
#pragma unroll
            for (int r = 1; r < 16; ++r) rm = fmaxf(rm, fmaxf(pA0[r], pA1[r]));
            { auto rr = __builtin_amdgcn_permlane32_swap(__float_as_uint(rm), __float_as_uint(rm), false, false); rm = fmaxf(__uint_as_float(rr[0]), __uint_as_float(rr[1])); }
        }
        st.mrun = rm;
#pragma unroll
        for (int r = 0; r < 16; ++r) { pA0[r] = __builtin_amdgcn_exp2f(pA0[r] - rm); pA1[r] = __builtin_amdgcn_exp2f(pA1[r] - rm); st.negm[r] = -rm; }
    }
    ATT_WAITV(0);
    PIPE_DMA_K(3, 0); PIPE_DMA_V(2, 2);
    {   const LAS unsigned char* k1 = lds + Cf::KRING + Cf::KSLOT + frag_off + F0 * 2048;
#pragma unroll
        for (int g = 0; g < NKF; ++g) kf[g] = *(const LAS bf16x8*)(k1 + (g >> 1) * 2048 + (g & 1) * 512); }
    if (Cf::NKW == 1) ATT_WAITV(2); else ATT_WAITV(3);
    int t = 1;
    for (; t + 1 < NT; t += 2) {
        pipe_step<DQK, F0, NF, BIAS, NOMAX>(t, pB0, pB1, pA0, pA1, o, kf, qf, st, lds, Kt, Vt, lane, w, frag_off, lut, qw0, qrow, hi, cL, cR);
        pipe_step<DQK, F0, NF, BIAS, NOMAX>(t + 1, pA0, pA1, pB0, pB1, o, kf, qf, st, lds, Kt, Vt, lane, w, frag_off, lut, qw0, qrow, hi, cL, cR);
    }
    pipe_step<DQK, F0, NF, BIAS, NOMAX>(NT - 1, pB0, pB1, pA0, pA1, o, kf, qf, st, lds, Kt, Vt, lane, w, frag_off, lut, qw0, qrow, hi, cL, cR);
    {
        float sacc = 0.f;
#pragma unroll
        for (int r = 0; r < 16; ++r) sacc += pB0[r] + pB1[r];
        st.lrun += sacc;
        u32x4 pw[4];
#pragma unroll
        for (int j = 0; j < 4; ++j) { pw[0][j] = pk2(pB0[2 * j], pB0[2 * j + 1]); pw[1][j] = pk2(pB0[8 + 2 * j], pB0[9 + 2 * j]); pw[2][j] = pk2(pB1[2 * j], pB1[2 * j + 1]); pw[3][j] = pk2(pB1[8 + 2 * j], pB1[9 + 2 * j]); }
        const LAS unsigned char* vs = lds + Cf::VRING + ((NT - 1) & 3) * Cf::VSLOT + frag_off;
#pragma unroll
        for (int k4 = 0; k4 < 4; ++k4)
#pragma unroll
            for (int db = 0; db < 2; ++db) { const bf16x8 vfr = *(const LAS bf16x8*)(vs + k4 * 2048 + db * 512);
                o[db] = __builtin_amdgcn_mfma_f32_32x32x16_bf16(vfr, __builtin_bit_cast(bf16x8, pw[k4]), o[db], 0, 0, 0); }
    }
#undef PIPE_DMA_K
#undef PIPE_DMA_V
    lsum = st.lrun + __shfl_xor(st.lrun, 32);
    asm volatile("s_waitcnt lgkmcnt(0)\n\ts_barrier" ::: "memory");
}
__device__ __forceinline__ void store_rows(const Args& a, int bh, int qb, int tid, const f32x16 (&val)[2]) {
    const int lane = tid & 63, r32 = lane & 31, hi = lane >> 5, w = __builtin_amdgcn_readfirstlane(tid >> 6), b = bh >> 2, h = bh & 3, qrow = qb * 256 + 32 * w + r32;
    bf16_t* yp = a.Y + ((size_t)(b * SEQ + qrow)) * DM + a.ycol + h * 64 + 4 * hi;
#pragma unroll
    for (int db = 0; db < 2; ++db)
#pragma unroll
        for (int g = 0; g < 4; ++g) { u32x2 wv; wv.x = pk2(val[db][4 * g], val[db][4 * g + 1]); wv.y = pk2(val[db][4 * g + 2], val[db][4 * g + 3]); *(u32x2*)(yp + 32 * db + 8 * g) = wv; }
}
__device__ __forceinline__ float score_bound(const Args& a, int tid) {
    const int lane = tid & 63; float bq = 0.f, bk = 0.f;
    for (int i = lane; i < a.ng; i += 64) { bq = fmaxf(bq, fabsf(a.gq[i])); bk = fmaxf(bk, fabsf(a.gk[i])); }
#pragma unroll
    for (int o = 1; o < 64; o <<= 1) { bq = fmaxf(bq, __shfl_xor(bq, o)); bk = fmaxf(bk, __shfl_xor(bk, o)); }
    return __int_as_float(__builtin_amdgcn_readfirstlane(__float_as_int(a.sqrtd * LOG2E * bq * bk)));
}
constexpr float NOMAX_BOUND = 40.0f;
template <int DQK>
__device__ __forceinline__ void unit_plain(const Args& a, int bh, int qb, LAS unsigned char* lds, const int tid) {
    f32x16 o[2]; float l;
    if (score_bound(a, tid) <= NOMAX_BOUND) pipe_run<DQK, 0, DQK / 16, false, true>(a, bh, qb, lds, tid, o, l);
    else pipe_run<DQK, 0, DQK / 16, false, false>(a, bh, qb, lds, tid, o, l);
    const float i0 = 1.0f / l; o[0] = o[0] * i0; o[1] = o[1] * i0;
    store_rows(a, bh, qb, tid, o);
}
__device__ __forceinline__ void unit_diff(const Args& a, int bh, int qb, LAS unsigned char* lds, const int tid) {
    const int h = bh & 3;
    LAS float* lut = (LAS float*)(lds + LUT_OFF);
    for (int i = tid; i < 257; i += NTHREADS) { const int rel = i - 128, n = rel < 0 ? -rel : rel;
        int large = 8 + (int)(logf((float)(n < 1 ? 1 : n) / 8.0f) / 2.772588722239781f * 8.0f); large = large > 15 ? 15 : large;
        const int bucket = (rel > 0 ? 16 : 0) + (n < 8 ? n : large);
        lut[i] = a.lut_src[bucket * 4 + h] * LOG2E; }
    f32x16 va[2], ob[2]; float la, lb;
    float bmax = 0.f; for (int i = 0; i < 32; ++i) bmax = fmaxf(bmax, fabsf(a.lut_src[i * 4 + h]));
    const bool nomax = score_bound(a, tid) + bmax * LOG2E <= NOMAX_BOUND;
    LAS float* park = (LAS float*)(lds + PARK_OFF) + (tid >> 6) * 2048 + (tid & 63);
    if (nomax) pipe_run<64, 0, 2, true, true>(a, bh, qb, lds, tid, va, la); else pipe_run<64, 0, 2, true, false>(a, bh, qb, lds, tid, va, la);
    { const float i0 = 1.0f / la;
#pragma unroll
      for (int r = 0; r < 16; ++r) { park[r * 64] = va[0][r] * i0; park[(16 + r) * 64] = va[1][r] * i0; } }
    if (nomax) pipe_run<64, 2, 2, true, true>(a, bh, qb, lds, tid, ob, lb); else pipe_run<64, 2, 2, true, false>(a, bh, qb, lds, tid, ob, lb);
#pragma unroll
    for (int r = 0; r < 16; ++r) { va[0][r] = park[r * 64]; va[1][r] = park[(16 + r) * 64]; }
    float s1 = 0.f, s2 = 0.f;
    for (int i = 0; i < 32; ++i) { s1 += a.lam_src[i] * a.lam_src[32 + i]; s2 += a.lam_src[64 + i] * a.lam_src[96 + i]; }
    const float lam = expf(s1) - expf(s2) + a.lam_init, i1 = lam / lb;
    va[0] = va[0] - ob[0] * i1; va[1] = va[1] - ob[1] * i1;
    float s = 0.f;
#pragma unroll
    for (int r = 0; r < 16; ++r) s += va[0][r] * va[0][r] + va[1][r] * va[1][r];
    s += __shfl_xor(s, 32);
    const float rn = 1.0f / sqrtf(s * (1.0f / 64.0f) + EPS);
    va[0] = va[0] * rn; va[1] = va[1] * rn;
    store_rows(a, bh, qb, tid, va);
}
}

__device__ __forceinline__ void attention_phase(const Ctx& c, int l) {
    bf16_t* Y = c.wsb(WS_R);
    for (int u = c.bid; u < 1024; u += c.G) {
        const int type = u >> 8, v = u & 255, bh = v & 7, qb = v >> 3;
        int tid_u = c.tid; asm volatile("" : "+v"(tid_u));
        if (type == 0 && EN(8)) { att::Args a{c.wsb(WS_QC), c.wsb(WS_KC), c.wsb(WS_VC), Y, 512, 0, 4, c.kp->in[I_T5], c.kp->in[I_DLAM] + l * 128, lambda_init(l), c.kp->in[I_DQN] + l * 32, c.kp->in[I_DKN] + l * 32, 32, 5.656854249f}; att::unit_diff(a, bh, qb, c.lds, tid_u); }
        else if (type == 1 && EN(9)) { att::Args a{c.wsb(WS_QB), c.wsb(WS_KB), c.wsb(WS_VB), Y, 256, 0, 4, nullptr, nullptr, 0.f, c.kp->in[I_MLAQN] + l * 96, c.kp->in[I_MLAKN] + l * 96, 96, 9.797958971f}; att::unit_plain<96>(a, bh, qb, c.lds, tid_u); }
        else if (type == 2 && EN(10)) { att::Args a{c.wsb(WS_QD), c.wsb(WS_KD), c.wsb(WS_VD), Y, 768, 1, 2, nullptr, nullptr, 0.f, c.kp->in[I_GQN] + l * 64, c.kp->in[I_GKN] + l * 64, 64, 8.0f}; att::unit_plain<64>(a, bh, qb, c.lds, tid_u); }
        else if (type == 3 && EN(11)) { att::Args a{c.wsb(WS_QA), c.wsb(WS_KA), c.wsb(WS_VA), Y, 0, 0, 4, c.kp->in[I_NARPB] + l * 4 * 465, nullptr, 0.f, nullptr, nullptr, 0, 0.f}; att::unit<2, 64>(a, bh, qb, c.lds, tid_u); }
    }
}

__device__ __forceinline__ void ynorm_phase(const Ctx& c) {
    const int gw = c.bid * NWAVES + c.wave, NGW = c.G * NWAVES; bf16_t* Y = c.wsb(WS_R);
    for (int row = gw; row < MROWS; row += NGW) {
        u32x4* yr = (u32x4*)(Y + (size_t)row * DM + c.lane * 16);
        const u32x4 u0 = yr[0], u1 = yr[1]; float v[16]; unpack8(u0, v); unpack8(u1, v + 8);
        float s = 0.f;
#pragma unroll
        for (int j = 0; j < 16; ++j) s += v[j] * v[j];
        s += __shfl_xor(s, 1); s += __shfl_xor(s, 2); s += __shfl_xor(s, 4); s += __shfl_xor(s, 8);
        const float rs = 1.0f / sqrtf(s * (1.0f / 256.0f) + EPS);
        if ((c.lane >> 4) != 2) {
#pragma unroll
            for (int j = 0; j < 16; ++j) v[j] *= rs;
            yr[0] = pack8(v); yr[1] = pack8(v + 8);
        }
    }
}
__device__ __forceinline__ void final_phase(const Ctx& c) {
    const int gw = c.bid * NWAVES + c.wave, NGW = c.G * NWAVES; float* X = c.kp->out; const float* ss3 = c.ssp(2); const float* gf = c.kp->in[I_FINN] + DM;
    for (int row = gw; row < MROWS; row += NGW) {
        const float rs = 1.0f / sqrtf(pg8::sum16(ss3 + (size_t)row * 16) * (1.0f / DM) + EPS);
        f32x4* xr = (f32x4*)(X + (size_t)row * DM) + c.lane;
#pragma unroll
        for (int j = 0; j < 4; ++j) { const f32x4 g = *((const f32x4*)gf + c.lane + 64 * j); xr[64 * j] = xr[64 * j] * g * rs; }
    }
}

constexpr int N_PHASES = 21;
__device__ __forceinline__ void run_kind(const Ctx& c, int kind, int l) {
    using namespace pg8;
    const int G = c.G, bid = c.bid;
    switch (kind) {
        case 0: case 7: if (EN(0)) {
            const bool second = kind == 7;
            Gemm g{c.wsb(WS_XB), c.wsb(second ? WS_WGU2 : WS_WGU1), MROWS, 2 * DFF, DM}; StaticOrder S; S.init(MROWS, 2 * DFF, G, bid);
            RowScale rsc; if (second) { rsc.ss1 = nullptr; rsc.ssp = c.ssp(1); rsc.ssgp = nullptr; } else if (l == 0) { rsc.ss1 = c.ss0(); rsc.ssp = nullptr; rsc.ssgp = nullptr; } else { rsc.ss1 = nullptr; rsc.ssp = c.ssp(2); rsc.ssgp = c.ssp(3); }
            LAS float* rstab = (LAS float*)(c.lds + LDS_RSTAB);
            { Unit u; for (int ui = 0; S.next(ui, u); ++ui) if (c.tid < BM) rstab[ui * BM + c.tid] = rsc.get(u.pm * BM + c.tid); }
            __syncthreads();
            EpiSwiGLU E{c.wsb(WS_R), rstab};
            gemm_phase<EpiSwiGLU, StaticOrder, true, true>(c.lds, g, S, E, c.tid);
        } break;
        case 1: case 8: if (EN(1)) {
            const bool second = kind == 8;
            Gemm g{c.wsb(WS_R), c.wsb(second ? WS_WD2 : WS_WD1), MROWS, DM, DFF}; StaticOrder S; S.init(MROWS, DM, G, bid);
            EpiResid E;
            E.alpha = 0.5f; E.out = c.kp->out; E.outb = c.wsb(WS_XB);
            if (second) { E.base = c.kp->out; E.bss = nullptr; E.bg = nullptr; E.ss_out = c.ssp(2); E.gf = c.kp->in[I_FINN] + l * DM; E.ssg_out = c.ssp(3); }
            else { E.ss_out = c.ssp(0); E.gf = nullptr; E.ssg_out = nullptr;
                   if (l == 0) { E.base = c.kp->in[I_X]; E.bss = nullptr; E.bg = nullptr; } else { E.base = c.kp->out; E.bss = c.ssp(2); E.bg = c.kp->in[I_FINN] + (l - 1) * DM; } }
            gemm_phase<EpiResid, StaticOrder, true, true>(c.lds, g, S, E, c.tid);
        } break;
        case 2: if (EN(2)) {
            Gemm g{c.wsb(WS_XB), c.wsb(WS_WIN), MROWS, NIN, DM}; StaticOrder S; S.init(MROWS, NIN, G, bid);
            RowScale rsc{nullptr, c.ssp(0), nullptr};
            LAS float* rstab = (LAS float*)(c.lds + LDS_RSTAB);
            { Unit u; for (int ui = 0; S.next(ui, u); ++ui) if (c.tid < BM) rstab[ui * BM + c.tid] = rsc.get(u.pm * BM + c.tid); }
            __syncthreads();
            EpiScaleBf16 E{c.wsb(WS_R), NIN, rstab};
            gemm_phase<EpiScaleBf16, StaticOrder, true, true>(c.lds, g, S, E, c.tid);
        } break;
        case 3: if (EN(3)) for (int T = bid; T < MROWS / 64; T += G) prep_unit(c, l, T); break;
        case 4: if (EN(4)) attention_phase(c, l); break;
        case 5: if (EN(5)) ynorm_phase(c); break;
        case 6: if (EN(6)) {
            Gemm g{c.wsb(WS_R), c.wsb(WS_WOUT), MROWS, DM, DM}; StaticOrder S; S.init(MROWS, DM, G, bid);
            EpiResid E; E.base = c.kp->out; E.bss = nullptr; E.bg = nullptr; E.alpha = 1.0f; E.out = c.kp->out; E.outb = c.wsb(WS_XB); E.ss_out = c.ssp(1); E.gf = nullptr; E.ssg_out = nullptr;
            gemm_phase<EpiResid, StaticOrder, true, true>(c.lds, g, S, E, c.tid);
        } break;
        default: break;
    }
}

__global__ void __launch_bounds__(NTHREADS, 2) fwd_megakernel(Params p) {
    extern __shared__ __attribute__((aligned(16))) unsigned char lds_raw[];
    cg::grid_group grid = cg::this_grid();
    const int ph_lo = p.ph_lo, ph_hi = p.ph_hi;
    const int wave_id = __builtin_amdgcn_readfirstlane((int)threadIdx.x >> 6);
    {
        volatile LAS unsigned* st0 = (volatile LAS unsigned*)((LAS unsigned char*)lds_raw + LDS_MISC);
        if (threadIdx.x < 4) st0[threadIdx.x] = 0u;
        __syncthreads();
        (void)xcd_barrier_post((unsigned*)p.ws, st0);
    }
    for (int ph = ph_lo; ph < ph_hi; ++ph) {
        if (ph == ph_lo + 1) grid.sync();
        else if (ph > ph_lo + 1) { XcdBarrier xb; xb.bar = (unsigned*)((KParams)__builtin_amdgcn_kernarg_segment_ptr())->ws; xb.x = xb_xcc_id(); xb.st = (volatile LAS unsigned*)((LAS unsigned char*)lds_raw + LDS_MISC); xcd_barrier(xb); }
        KParams kp = (KParams)__builtin_amdgcn_kernarg_segment_ptr();
        asm volatile("" : "+s"(kp));
        int lane_; asm volatile("v_mbcnt_lo_u32_b32 %0, -1, 0\n\tv_mbcnt_hi_u32_b32 %0, -1, %0" : "=v"(lane_));
        int tid_ = wave_id * 64 + lane_, bid_ = blockIdx.x, G_ = gridDim.x; unsigned lds_ = (unsigned)(uintptr_t)(LAS unsigned char*)lds_raw;
        asm volatile("" : "+v"(tid_)); asm volatile("" : "+s"(bid_)); asm volatile("" : "+s"(G_)); asm volatile("" : "+s"(lds_));
        Ctx c; c.kp = kp; c.lds = (LAS unsigned char*)(uintptr_t)lds_; c.tid = tid_; c.lane = c.tid & 63; c.wave = __builtin_amdgcn_readfirstlane(c.tid >> 6); c.G = G_; c.bid = bid_;
        if (ph == 0) { if (EN(16)) prologue(c); }
        else if (ph == 10) { if (EN(18)) wconv_layer(c, 1); }
        else if (ph == 20) { if (EN(17)) final_phase(c); }
        else { const int l = ph > 10 ? 1 : 0; run_kind(c, ph - 1 - 10 * l, l); if (MK_DUP >= 0 && ph - 1 - 10 * l == MK_DUP) { __syncthreads(); run_kind(c, ph - 1 - 10 * l, l); } }
    }
}

extern "C" void kernel_launch(void* const* d_in, const int* in_sizes, int n_in, void* d_out, int out_size, void* d_ws, size_t ws_size, hipStream_t stream) {
    static int grid = 0;
    if (grid == 0) {
        if (n_in != 32 || out_size != MROWS * DM || ws_size < WS_END) { fprintf(stderr, "kernel_launch: unexpected shapes (n_in %d, out %d, ws %zu)\n", n_in, out_size, ws_size); grid = -1; return; }
        int dev = 0, cus = 0, per_cu = 0;
        hipGetDevice(&dev); hipDeviceGetAttribute(&cus, hipDeviceAttributeMultiprocessorCount, dev);
        hipFuncSetAttribute((const void*)fwd_megakernel, hipFuncAttributeMaxDynamicSharedMemorySize, LDS_BYTES);
        hipOccupancyMaxActiveBlocksPerMultiprocessor(&per_cu, (const void*)fwd_megakernel, NTHREADS, LDS_BYTES);
        if (per_cu < 1) { fprintf(stderr, "kernel_launch: occupancy query says %d blocks per CU\n", per_cu); per_cu = 1; }
        (void)hipGetLastError();
        grid = cus * 1;
    }
    if (grid < 0) return;
    if (hipMemsetAsync((char*)d_ws + WS_BAR, 0, BAR_ZERO_BYTES, stream) != hipSuccess) { fprintf(stderr, "kernel_launch: memset of barrier words failed\n"); return; }
    Params p{};
    for (int i = 0; i < 32; ++i) p.in[i] = (const float*)d_in[i];
    p.out = (float*)d_out; p.ws = (unsigned char*)d_ws;
#if MK_SPLIT
    for (int ph = 0; ph < N_PHASES; ++ph) {
        p.ph_lo = ph; p.ph_hi = ph + 1; void* args[] = {&p};
        hipError_t e = hipLaunchCooperativeKernel((const void*)fwd_megakernel, dim3(grid), dim3(NTHREADS), args, LDS_BYTES, stream);
        if (e != hipSuccess) { fprintf(stderr, "cooperative launch failed: %s (grid %d)\n", hipGetErrorString(e), grid); break; }
    }
#else
    p.ph_lo = 0; p.ph_hi = N_PHASES; void* args[] = {&p};
    hipError_t e = hipLaunchCooperativeKernel((const void*)fwd_megakernel, dim3(grid), dim3(NTHREADS), args, LDS_BYTES, stream);
    if (e != hipSuccess) fprintf(stderr, "cooperative launch failed: %s (grid %d)\n", hipGetErrorString(e), grid);
#endif
}
```
